# Optimizing an MI355X kernel written in HIP

```python
import math
import jax, jax.numpy as jnp
from jax import lax
import numpy as np

D_MODEL = 1024
BATCH = 2
SEQ = 16384
DEPTH = 1

CONV_DIM = D_MODEL
CONV_WIDTH = 3
N_HEADS = 16
HEAD_DIM = 64
ATTN_DIM = N_HEADS * HEAD_DIM
MOBA_BLOCK = 256
TOP_BLOCKS = 3
Q_CHUNK = 32
ROPE_THETA = 10000.0
IN_PROJ_DIM = 3 * CONV_DIM + 3 * ATTN_DIM + 2 * D_MODEL
N_EXPERTS = 32
TOP_K = 4
D_FF = D_MODEL
SWIGLU_LIMIT = 7.0
SWIGLU_ALPHA = 1.702
MOE_BLOCK = 128
EPS = 1e-5

kernel_name = "hybrid_gated_conv_moba_moe_block"


def rmsnorm(x, g):
    xf = x.astype(jnp.float32)
    y = xf * lax.rsqrt(jnp.mean(xf * xf, axis=-1, keepdims=True) + EPS)
    return (y * g.astype(jnp.float32)).astype(x.dtype)


def rope(t, positions):
    half = HEAD_DIM // 2
    inv_freq = ROPE_THETA ** (-jnp.arange(0, half, dtype=jnp.float32) / half)
    ang = positions.astype(jnp.float32)[:, None] * inv_freq[None, :]
    cos = jnp.cos(ang)[None, None]
    sin = jnp.sin(ang)[None, None]
    tf = t.astype(jnp.float32)
    t1, t2 = tf[..., :half], tf[..., half:]
    out = jnp.concatenate([t1 * cos - t2 * sin, t2 * cos + t1 * sin], axis=-1)
    return out.astype(t.dtype)


def short_conv(u, conv_w):
    rhs = conv_w[:, None, :]
    return lax.conv_general_dilated(
        u, rhs, window_strides=(1,), padding=[(CONV_WIDTH - 1, 0)],
        dimension_numbers=("NWC", "WIO", "NWC"), feature_group_count=u.shape[-1])


def moba_attention(q, k, v):
    b, h, s, dh = q.shape
    s_pad = ((s + MOBA_BLOCK - 1) // MOBA_BLOCK) * MOBA_BLOCK
    pad = s_pad - s
    if pad:
        cfg = ((0, 0), (0, 0), (0, pad), (0, 0))
        q, k, v = jnp.pad(q, cfg), jnp.pad(k, cfg), jnp.pad(v, cfg)
    nb = s_pad // MOBA_BLOCK
    n_top = min(TOP_BLOCKS, nb)
    k_blocks = k.reshape(b, h, nb, MOBA_BLOCK, dh)
    v_blocks = v.reshape(b, h, nb, MOBA_BLOCK, dh)
    k_mean = jnp.mean(k_blocks.astype(jnp.float32), axis=3)
    scale = HEAD_DIM ** -0.5
    block_ids = jnp.arange(nb)
    key_offsets = jnp.arange(MOBA_BLOCK)
    gather_blocks = jax.vmap(jax.vmap(lambda kb, idx: kb[idx]))

    def chunk(c):
        start = c * Q_CHUNK
        own = start // MOBA_BLOCK
        q_c = lax.dynamic_slice_in_dim(q, start, Q_CHUNK, axis=2)
        q_pos = start + jnp.arange(Q_CHUNK)
        gate = jnp.einsum("bhqd,bhnd->bhqn", q_c.astype(jnp.float32), k_mean)
        gate = jnp.where((block_ids < own)[None, None, None, :], gate, -jnp.inf)
        g_val, sel = lax.top_k(gate, n_top)
        sel_valid = jnp.isfinite(g_val)
        k_sel = gather_blocks(k_blocks, sel)
        v_sel = gather_blocks(v_blocks, sel)
        s_sel = jnp.einsum("bhqd,bhqtkd->bhqtk", q_c, k_sel).astype(jnp.float32) * scale
        s_sel = jnp.where(sel_valid[..., None], s_sel, -jnp.inf)
        s_sel = s_sel.reshape(b, h, Q_CHUNK, n_top * MOBA_BLOCK)
        k_own = lax.dynamic_slice_in_dim(k, own * MOBA_BLOCK, MOBA_BLOCK, axis=2)
        v_own = lax.dynamic_slice_in_dim(v, own * MOBA_BLOCK, MOBA_BLOCK, axis=2)
        s_own = jnp.einsum("bhqd,bhkd->bhqk", q_c, k_own).astype(jnp.float32) * scale
        causal = (own * MOBA_BLOCK + key_offsets)[None, :] <= q_pos[:, None]
        s_own = jnp.where(causal[None, None], s_own, -jnp.inf)
        p = jax.nn.softmax(jnp.concatenate([s_sel, s_own], axis=-1), axis=-1).astype(v.dtype)
        p_sel = p[..., : n_top * MOBA_BLOCK].reshape(b, h, Q_CHUNK, n_top, MOBA_BLOCK)
        p_own = p[..., n_top * MOBA_BLOCK:]
        return (jnp.einsum("bhqtk,bhqtkd->bhqd", p_sel, v_sel)
                + jnp.einsum("bhqk,bhkd->bhqd", p_own, v_own))

    outs = lax.map(chunk, jnp.arange(s_pad // Q_CHUNK))
    out = outs.transpose(1, 2, 0, 3, 4).reshape(b, h, s_pad, dh)
    return out[:, :, :s]


def moe(hn, router_w, router_b, w_gate_up, b_gate_up, w_down, b_down):
    n, d = hn.shape
    logits = (hn @ router_w + router_b).astype(jnp.float32)
    top_val, top_idx = lax.top_k(logits, TOP_K)
    top_w = jax.nn.softmax(top_val, axis=-1).astype(hn.dtype)
    nk = n * TOP_K
    flat_e = top_idx.reshape(nk)
    flat_tok = jnp.repeat(jnp.arange(n, dtype=jnp.int32), TOP_K)
    flat_w = top_w.reshape(nk)
    order = jnp.argsort(flat_e, stable=True)
    sorted_e = flat_e[order]
    counts = jnp.bincount(flat_e, length=N_EXPERTS)
    padded_counts = ((counts + MOE_BLOCK - 1) // MOE_BLOCK) * MOE_BLOCK
    start_sorted = jnp.cumsum(counts) - counts
    padded_end = jnp.cumsum(padded_counts)
    start_pad = padded_end - padded_counts
    rank = jnp.arange(nk) - start_sorted[sorted_e]
    dest = start_pad[sorted_e] + rank
    n_slots = ((nk + N_EXPERTS * (MOE_BLOCK - 1) + MOE_BLOCK - 1) // MOE_BLOCK) * MOE_BLOCK
    n_blocks = n_slots // MOE_BLOCK
    slot_tok = jnp.full((n_slots,), n, dtype=jnp.int32).at[dest].set(flat_tok[order])
    slot_w = jnp.zeros((n_slots,), hn.dtype).at[dest].set(flat_w[order])
    block_expert = jnp.clip(
        jnp.searchsorted(padded_end, jnp.arange(n_blocks) * MOE_BLOCK, side="right"),
        0, N_EXPERTS - 1)
    h_ext = jnp.concatenate([hn, jnp.zeros((1, d), hn.dtype)], axis=0)
    xs = h_ext[slot_tok].reshape(n_blocks, MOE_BLOCK, d)

    def expert_block(args):
        xb, e = args
        gu = xb @ w_gate_up[e] + b_gate_up[e]
        gate = jnp.minimum(gu[:, :D_FF], SWIGLU_LIMIT)
        up = jnp.clip(gu[:, D_FF:], -SWIGLU_LIMIT, SWIGLU_LIMIT)
        act = (up + 1.0) * (gate * jax.nn.sigmoid(SWIGLU_ALPHA * gate))
        return act @ w_down[e] + b_down[e]

    ys = lax.map(expert_block, (xs, block_expert)).reshape(n_slots, d) * slot_w[:, None]
    out = jnp.zeros((n + 1, d), hn.dtype).at[slot_tok].add(ys)
    return out[:n]


def setup_inputs(seed: int = 0) -> dict:
    key = jax.random.key(seed)
    ks = jax.random.split(key, 16)
    f32 = jnp.float32
    nrm = lambda k, shape, fan_in: jax.random.normal(k, shape, f32) * (fan_in ** -0.5)
    return {
        "x": jax.random.normal(ks[0], (BATCH, SEQ, D_MODEL), f32),
        "norm_mix_g": 1.0 + 0.02 * jax.random.normal(ks[1], (D_MODEL,), f32),
        "w_in": nrm(ks[2], (D_MODEL, IN_PROJ_DIM), D_MODEL),
        "conv_w": nrm(ks[3], (CONV_WIDTH, CONV_DIM), CONV_WIDTH),
        "w_conv_out": nrm(ks[4], (CONV_DIM, D_MODEL), CONV_DIM),
        "w_attn_out": nrm(ks[5], (ATTN_DIM, D_MODEL), ATTN_DIM),
        "w_out": nrm(ks[6], (D_MODEL, D_MODEL), D_MODEL),
        "norm_ffn_g": 1.0 + 0.02 * jax.random.normal(ks[7], (D_MODEL,), f32),
        "router_w": nrm(ks[8], (D_MODEL, N_EXPERTS), D_MODEL),
        "router_b": 0.01 * jax.random.normal(ks[9], (N_EXPERTS,), f32),
        "w_gate_up": nrm(ks[10], (N_EXPERTS, D_MODEL, 2 * D_FF), D_MODEL),
        "b_gate_up": 0.02 * jax.random.normal(ks[11], (N_EXPERTS, 2 * D_FF), f32),
        "w_down": nrm(ks[12], (N_EXPERTS, D_FF, D_MODEL), D_FF),
        "b_down": 0.02 * jax.random.normal(ks[13], (N_EXPERTS, D_MODEL), f32),
        "norm_final_g": 1.0 + 0.02 * jax.random.normal(ks[14], (D_MODEL,), f32),
    }


def reference(x, norm_mix_g, w_in, conv_w, w_conv_out, w_attn_out, w_out, norm_ffn_g,
              router_w, router_b, w_gate_up, b_gate_up, w_down, b_down, norm_final_g):
    b, s, d = x.shape
    positions = jnp.arange(s, dtype=jnp.int32)
    h = x
    for _ in range(DEPTH):
        xn = rmsnorm(h, norm_mix_g)
        z = xn @ w_in
        splits = np.cumsum([CONV_DIM, CONV_DIM, CONV_DIM, ATTN_DIM, ATTN_DIM, ATTN_DIM, D_MODEL]).tolist()
        c_b, c_c, c_x, q, k, v, g_conv, g_attn = jnp.split(z, splits, axis=-1)
        y_conv = (c_b * short_conv(c_c * c_x, conv_w)) @ w_conv_out
        to_heads = lambda t: t.reshape(b, s, N_HEADS, HEAD_DIM).transpose(0, 2, 1, 3)
        qh = rope(to_heads(q), positions)
        kh = rope(to_heads(k), positions)
        vh = to_heads(v)
        attn = moba_attention(qh, kh, vh).transpose(0, 2, 1, 3).reshape(b, s, ATTN_DIM)
        y_attn = attn @ w_attn_out
        merged = jax.nn.sigmoid(g_conv) * y_conv + jax.nn.sigmoid(g_attn) * y_attn
        h = h + merged @ w_out
        hn = rmsnorm(h, norm_ffn_g).reshape(b * s, d)
        h = h + moe(hn, router_w, router_b, w_gate_up, b_gate_up, w_down, b_down).reshape(b, s, d)
    return rmsnorm(h, norm_final_g)
```

```cpp
#include <hip/hip_runtime.h>
#include <cstdio>
#include <cstdint>
#include <cmath>

#ifndef STAGE_A
#define STAGE_A 0
#endif

constexpr int BATCH = 2, SEQ = 16384, D = 1024, M = BATCH * SEQ, NH = 16, HD = 64, NBLK = SEQ / 256, NE = 32, NIN = 8192;
constexpr float EPS = 1e-5f;
constexpr float C2 = 0.125f * 1.4426950408889634f;

namespace pg8 {
#define PG8_LAS __attribute__((address_space(3)))
typedef unsigned short bf16_t;
typedef short bf16x8 __attribute__((ext_vector_type(8)));
typedef float f32x4 __attribute__((ext_vector_type(4)));
typedef float f32x2 __attribute__((ext_vector_type(2)));
typedef unsigned u32x4 __attribute__((ext_vector_type(4)));
typedef unsigned u32x2 __attribute__((ext_vector_type(2)));
constexpr int BM = 256, BK = 64, HALF = 128, HTB = HALF * BK * 2, STAGE_BYTES = 8 * HTB, NXCD = 8, WGM = 8, KD = 1024;

__host__ __device__ __forceinline__ int lds_byte(int r, int c) { const int st = (r >> 4) * 2 + (c >> 5), rr = r & 15, cc = c & 31, ob = rr * 64 + cc * 2; return st * 1024 + (ob ^ (((ob >> 9) & 1) << 5)); }
__host__ __device__ __forceinline__ void stage_rc(int b, int& R, int& C) { const int st = b / 1024, sb = b % 1024, swz = sb ^ (((sb >> 9) & 1) << 5); R = (st >> 1) * 16 + swz / 64; C = (st & 1) * 32 + (swz % 64) / 2; }
__host__ __device__ __forceinline__ int perm32(int rho) { const int n = rho >> 4, i = rho & 15; return 8 * (i >> 2) + 4 * n + (i & 3); }

struct Unit { int pm, pn, e, rt; };

__device__ __forceinline__ unsigned cvt_pk_bf16(float lo, float hi) { unsigned r; asm volatile("v_cvt_pk_bf16_f32 %0, %1, %2" : "=v"(r) : "v"(lo), "v"(hi)); return r; }
__device__ __forceinline__ float bf_lo(unsigned w) { return __uint_as_float(w << 16); }
__device__ __forceinline__ float bf_hi(unsigned w) { return __uint_as_float(w & 0xffff0000u); }

__device__ __forceinline__ bool tile_order(int i, int G, int c, int nM, int nN, int& pm, int& pn) {
    const int nwg = nM * nN; const long L = (long)i * G + c; if (L >= nwg) return false;
    int wgid = (int)L; { const int q = nwg / NXCD, r = nwg % NXCD, xcd = wgid % NXCD, off = wgid / NXCD; wgid = (xcd < r ? xcd * (q + 1) : r * (q + 1) + (xcd - r) * q) + off; }
    const int nig = WGM * nN, gid = wgid / nig, fm = gid * WGM, gsz = (nM - fm) < WGM ? (nM - fm) : WGM;
    pm = fm + ((wgid % nig) % gsz); pn = (wgid % nig) / gsz; return true;
}

template <class Epi, class Pol, bool ALIGN_EPI>
__device__ __forceinline__ void gemm_phase(PG8_LAS unsigned char* lds, const Pol& S, const Epi& E) {
    constexpr int K = KD, nt = K / BK;
    const int tid = threadIdx.x, wid = __builtin_amdgcn_readfirstlane(tid >> 6), lane = tid & 63, wr = wid >> 2, wc = wid & 3, fr = lane & 15, fq = lane >> 4;
    int RA[2], CA[2]; unsigned voffB[2];
#pragma unroll
    for (int i = 0; i < 2; ++i) { int R, C; stage_rc(tid * 16 + i * 8192, R, C); const int Rb = Epi::PERM ? ((R & ~31) + perm32(R & 31)) : R;
        RA[i] = R; CA[i] = C; voffB[i] = (unsigned)(Rb * K + C) * 2u; }
    constexpr unsigned kstep = BK * 2, hstep = (unsigned)HALF * K * 2;
    const unsigned ldsw = (unsigned)wid * 1024u;
    const int aoff = lds_byte(wr * 64 + fr, fq * 8), boff = lds_byte(wc * 32 + fr, fq * 8);
#define PG8_SA(b, h) (((b) * 2 + (h)) * HTB)
#define PG8_SB(b, h) ((4 + (b) * 2 + (h)) * HTB)
#define PG8_GLDS(bufoff, ptr, o0, o1) do { \
        __builtin_amdgcn_global_load_lds((const unsigned*)((const char*)(ptr) + (o0)), (PG8_LAS unsigned*)(lds + (bufoff) + ldsw), 16, 0, 0); \
        __builtin_amdgcn_global_load_lds((const unsigned*)((const char*)(ptr) + (o1)), (PG8_LAS unsigned*)(lds + (bufoff) + ldsw + 8192), 16, 0, 0); } while (0)
#define PG8_STAGE_B(bufoff, ptr) PG8_GLDS(bufoff, ptr, voffB[0], voffB[1])
#define PG8_LDA(dst, b, h) do { _Pragma("unroll") for (int m = 0; m < 4; ++m) _Pragma("unroll") for (int k = 0; k < 2; ++k) dst[m][k] = *(const PG8_LAS bf16x8*)(lds + PG8_SA(b, h) + aoff + m * 2048 + k * 1024); } while (0)
#define PG8_LDB(dst, b, h) do { _Pragma("unroll") for (int n = 0; n < 2; ++n) _Pragma("unroll") for (int k = 0; k < 2; ++k) dst[n][k] = *(const PG8_LAS bf16x8*)(lds + PG8_SB(b, h) + boff + n * 2048 + k * 1024); } while (0)
#define PG8_MMA(ai, bj, At, Bt) do { __builtin_amdgcn_s_setprio(1); _Pragma("unroll") for (int m = 0; m < 4; ++m) _Pragma("unroll") for (int n = 0; n < 2; ++n) _Pragma("unroll") for (int k = 0; k < 2; ++k) \
        acc[ai][bj][m][n] = __builtin_amdgcn_mfma_f32_16x16x32_bf16(Bt[n][k], At[m][k], acc[ai][bj][m][n], 0, 0, 0); __builtin_amdgcn_s_setprio(0); } while (0)
#define PG8_WAIT_V(n) asm volatile("s_waitcnt vmcnt(" #n ")" ::: "memory")
#define PG8_WAIT_L(n) asm volatile("s_waitcnt lgkmcnt(" #n ")" ::: "memory")
#define PG8_BAR __builtin_amdgcn_s_barrier()
#define PG8_SCHED __builtin_amdgcn_sched_barrier(0)
#define PG8_AOFF(vo, u) do { _Pragma("unroll") for (int h_ = 0; h_ < 2; ++h_) _Pragma("unroll") for (int i_ = 0; i_ < 2; ++i_) { \
        if constexpr (Pol::GATHER) vo[h_][i_] = (unsigned)(S.gather(u, h_ * HALF + RA[i_]) * K + CA[i_]) * 2u; \
        else vo[h_][i_] = (unsigned)((h_ * HALF + RA[i_]) * K + CA[i_]) * 2u; } } while (0)
    Unit cur, nxt; int ui = 0;
    if (!S.next(0, cur)) return;
    f32x4 acc[2][2][4][2];
#pragma unroll
    for (int a = 0; a < 2; ++a)
#pragma unroll
        for (int b = 0; b < 2; ++b)
#pragma unroll
            for (int m = 0; m < 4; ++m)
#pragma unroll
                for (int n = 0; n < 2; ++n) acc[a][b][m][n] = (f32x4){0.f, 0.f, 0.f, 0.f};
    bf16x8 At[4][2], B0[2][2], B1[2][2];
    unsigned voC[2][2], voN[2][2];
    PG8_AOFF(voC, cur);
#pragma unroll
    for (int h_ = 0; h_ < 2; ++h_)
#pragma unroll
        for (int i_ = 0; i_ < 2; ++i_) voN[h_][i_] = voC[h_][i_];
    const char* cA = S.a_base(cur); const char* cB = S.b_base(cur);
    PG8_STAGE_B(PG8_SB(0, 0), cB); PG8_STAGE_B(PG8_SB(0, 1), cB + hstep); PG8_GLDS(PG8_SA(0, 0), cA, voC[0][0], voC[0][1]); PG8_GLDS(PG8_SA(0, 1), cA, voC[1][0], voC[1][1]);
    if (wr == 1) PG8_BAR;
    PG8_WAIT_V(2); PG8_BAR;
    PG8_STAGE_B(PG8_SB(1, 0), cB + kstep); PG8_GLDS(PG8_SA(1, 0), cA + kstep, voC[0][0], voC[0][1]); PG8_STAGE_B(PG8_SB(1, 1), cB + hstep + kstep);
    PG8_WAIT_V(6); PG8_BAR;
    for (;;) {
        const bool has_next = S.next(ui + 1, nxt);
        const char* nA = cA; const char* nB = cB;
        if (has_next) { nA = S.a_base(nxt); nB = S.b_base(nxt); if constexpr (Pol::GATHER) { PG8_AOFF(voN, nxt); } }
        else { if constexpr (Pol::GATHER) {
#pragma unroll
            for (int h_ = 0; h_ < 2; ++h_)
#pragma unroll
                for (int i_ = 0; i_ < 2; ++i_) voN[h_][i_] = voC[h_][i_]; } }
        for (int t = 0; t < nt; t += 2) {
            const bool last = (t == nt - 2);
            const char* a1 = cA + (size_t)(t + 1) * kstep;
            const char* a2 = last ? nA : cA + (size_t)(t + 2) * kstep; const char* b2 = last ? nB : cB + (size_t)(t + 2) * kstep;
            const char* a3 = a2 + kstep; const char* b3 = b2 + kstep;
            unsigned o00, o01, o10, o11;
            if constexpr (Pol::GATHER) { o00 = last ? voN[0][0] : voC[0][0]; o01 = last ? voN[0][1] : voC[0][1]; o10 = last ? voN[1][0] : voC[1][0]; o11 = last ? voN[1][1] : voC[1][1]; }
            else { o00 = voC[0][0]; o01 = voC[0][1]; o10 = voC[1][0]; o11 = voC[1][1]; }
            PG8_LDB(B0, 0, 0); PG8_LDB(B1, 0, 1); PG8_SCHED; PG8_LDA(At, 0, 0); PG8_GLDS(PG8_SA(1, 1), a1, voC[1][0], voC[1][1]);
            PG8_WAIT_V(8); PG8_WAIT_L(0); PG8_BAR; PG8_MMA(0, 0, At, B0); PG8_MMA(0, 1, At, B1); PG8_BAR; PG8_SCHED;
            PG8_LDA(At, 0, 1); PG8_STAGE_B(PG8_SB(0, 0), b2); PG8_STAGE_B(PG8_SB(0, 1), b2 + hstep); PG8_GLDS(PG8_SA(0, 0), a2, o00, o01);
            PG8_WAIT_V(8); PG8_WAIT_L(0); PG8_BAR; PG8_MMA(1, 0, At, B0); PG8_MMA(1, 1, At, B1); PG8_BAR; PG8_SCHED;
            PG8_LDB(B0, 1, 0); PG8_LDB(B1, 1, 1); PG8_SCHED; PG8_LDA(At, 1, 0); PG8_GLDS(PG8_SA(0, 1), a2, o10, o11);
            PG8_WAIT_V(8); PG8_WAIT_L(0); PG8_BAR; PG8_MMA(0, 0, At, B0); PG8_MMA(0, 1, At, B1); PG8_BAR; PG8_SCHED;
            PG8_LDA(At, 1, 1); PG8_STAGE_B(PG8_SB(1, 0), b3); PG8_STAGE_B(PG8_SB(1, 1), b3 + hstep); PG8_GLDS(PG8_SA(1, 0), a3, o00, o01);
            PG8_WAIT_V(8); PG8_WAIT_L(0); PG8_BAR; PG8_MMA(1, 0, At, B0); PG8_MMA(1, 1, At, B1); PG8_BAR; PG8_SCHED;
        }
        if constexpr (ALIGN_EPI) { if (wr == 0) PG8_BAR; }
        E(acc, cur, wr, wc, fr, fq);
        if (!has_next) break;
#pragma unroll
        for (int a = 0; a < 2; ++a)
#pragma unroll
            for (int b = 0; b < 2; ++b)
#pragma unroll
                for (int m = 0; m < 4; ++m)
#pragma unroll
                    for (int n = 0; n < 2; ++n) acc[a][b][m][n] = (f32x4){0.f, 0.f, 0.f, 0.f};
        cur = nxt; cA = nA; cB = nB; ++ui;
#pragma unroll
        for (int h_ = 0; h_ < 2; ++h_)
#pragma unroll
            for (int i_ = 0; i_ < 2; ++i_) voC[h_][i_] = voN[h_][i_];
        if constexpr (ALIGN_EPI) { if (wr == 1) PG8_BAR; }
    }
    PG8_WAIT_V(0);
    if constexpr (!ALIGN_EPI) { if (wr == 0) PG8_BAR; }
    PG8_BAR;
#undef PG8_SA
#undef PG8_SB
#undef PG8_GLDS
#undef PG8_STAGE_B
#undef PG8_LDA
#undef PG8_LDB
#undef PG8_MMA
#undef PG8_WAIT_V
#undef PG8_WAIT_L
#undef PG8_BAR
#undef PG8_SCHED
#undef PG8_AOFF
}
}

constexpr size_t MiB = 1u << 20;
constexpr size_t WS_CTL = 0, CTL_ZERO_BYTES = 1 * MiB;
constexpr size_t WS_RWG = 1 * MiB;
constexpr size_t WS_KSUM = 1 * MiB + 512 * 1024;
constexpr size_t WS_ETOK = 2 * MiB;
constexpr size_t WS_EWT = 6 * MiB;
constexpr size_t WS_TOKSLOT = 10 * MiB;
constexpr size_t WS_COS = 11 * MiB, WS_SIN = 13 * MiB;
constexpr size_t WS_WCO = 16 * MiB, WS_WAO = 18 * MiB, WS_WOUT = 20 * MiB;
constexpr size_t WS_WIN = 24 * MiB;
constexpr size_t WS_WGU = 40 * MiB;
constexpr size_t WS_WD = 168 * MiB;
constexpr size_t WS_XN = 232 * MiB;
constexpr size_t WS_CB = 296 * MiB;
constexpr size_t WS_U = 360 * MiB;
constexpr size_t WS_Q = 424 * MiB;
constexpr size_t WS_K = 488 * MiB;
constexpr size_t WS_V = 552 * MiB;
constexpr size_t WS_GC = 616 * MiB;
constexpr size_t WS_GA = 680 * MiB;
constexpr size_t WS_PO = 744 * MiB;
constexpr size_t WS_PML = 936 * MiB;
constexpr size_t WS_ALIST = 952 * MiB;
constexpr size_t WS_ACT = 296 * MiB;
constexpr size_t WS_Y = 616 * MiB;
constexpr size_t WS_END = 986 * MiB;
constexpr int CW_BAR = 4096;
constexpr int CW_ECNT = 8192;
constexpr int CW_ACNT = 16384;
constexpr int CW_DBG = 20000;

constexpr int RING_BYTES = 131072, LDSCTL_OFF = RING_BYTES, MISC_OFF = LDSCTL_OFF + 320, TAB_OFF = LDSCTL_OFF + 512, LDS_BYTES = 147456;

#define GAS __attribute__((address_space(1)))
#define LAS __attribute__((address_space(3)))
typedef unsigned short bf16;
typedef unsigned v4u __attribute__((ext_vector_type(4)));
typedef unsigned v2u __attribute__((ext_vector_type(2)));
typedef float f32x4 __attribute__((ext_vector_type(4)));
typedef float f32x16 __attribute__((ext_vector_type(16)));
typedef GAS unsigned gu32;
#define RLX_AGENT __ATOMIC_RELAXED, __HIP_MEMORY_SCOPE_AGENT
#define LDS_WAIT() asm volatile("s_waitcnt lgkmcnt(0)" ::: "memory")
#define VM_WAIT() asm volatile("s_waitcnt vmcnt(0)" ::: "memory")
using pg8::cvt_pk_bf16; using pg8::bf_lo; using pg8::bf_hi;

#define XB_TMO      128
#define XB_XCNT(j)  (256  + 64 * (j))
#define XB_XSUB(j)  (1280 + 64 * (j))
#define XB_XGEN(j)  (2304 + 64 * (j))
#define XB_TOP      3328
#define XB_TOPGEN   3392
#define XCD_BAR_WORDS 3456
#define XB_SPIN_CAP (1u << 18)
__device__ __forceinline__ unsigned xb_ld(unsigned* p)              { return __hip_atomic_load(p, __ATOMIC_RELAXED, __HIP_MEMORY_SCOPE_AGENT); }
__device__ __forceinline__ unsigned xb_add(unsigned* p, unsigned v) { return __hip_atomic_fetch_add(p, v, __ATOMIC_RELAXED, __HIP_MEMORY_SCOPE_AGENT); }
__device__ __forceinline__ unsigned xb_xcc_id() { return (unsigned)__builtin_amdgcn_s_getreg((3 << 11) | 20) & 0xFu; }
#define XB_SPIN(cond, bar) do { unsigned _sp = 0; while (cond) { __builtin_amdgcn_s_sleep(1); \
    if ((++_sp & 255u) == 0u) { if (xb_ld(&(bar)[XB_TMO])) break; if (_sp > XB_SPIN_CAP) { atomicAdd(&(bar)[XB_TMO], 1u); break; } } } } while (0)
struct XcdBarrier { unsigned* bar; unsigned x; volatile LAS unsigned* st; };
__device__ __forceinline__ XcdBarrier xcd_barrier_post(unsigned* bar, volatile LAS unsigned* st) {
    XcdBarrier b; b.bar = bar; b.x = xb_xcc_id(); b.st = st;
    if (threadIdx.x == 0) (void)xb_add(&bar[XB_XCNT(b.x)], 1u);
    return b;
}
__device__ __forceinline__ void xcd_barrier_complete(unsigned* bar, unsigned x, unsigned& nloc, unsigned& nx) {
    const unsigned G = gridDim.x * gridDim.y * gridDim.z;
    unsigned sum, cnt, mine, sp = 0u;
    for (;;) {
        sum = 0u; cnt = 0u; mine = 0u;
#pragma unroll
        for (unsigned j = 0; j < 16; ++j) { const unsigned c = xb_ld(&bar[XB_XCNT(j)]); sum += c; cnt += (c > 0u) ? 1u : 0u; mine = (j == x) ? c : mine; }
        if (sum == G) break;
        __builtin_amdgcn_s_sleep(1);
        if ((++sp & 255u) == 0u) { if (xb_ld(&bar[XB_TMO])) break; if (sp > XB_SPIN_CAP) { atomicAdd(&bar[XB_TMO], 1u); break; } }
    }
    nloc = mine > 0u ? mine : 1u; nx = cnt > 0u ? cnt : 1u;
}
__device__ __forceinline__ void xcd_barrier(const XcdBarrier& b) {
    asm volatile("s_waitcnt vmcnt(0)" ::: "memory");
    __syncthreads();
    if (threadIdx.x == 0) {
        unsigned* bar = b.bar;
        __builtin_amdgcn_s_waitcnt(0);
        unsigned nloc = b.st[0], nx = b.st[1];
        if (nloc == 0u) { xcd_barrier_complete(bar, b.x, nloc, nx); b.st[0] = nloc; b.st[1] = nx; }
        const unsigned old = xb_add(&bar[XB_XSUB(b.x)], 1u);
        const unsigned gen = old / nloc;
        if (old + 1u == (gen + 1u) * nloc) {
            __builtin_amdgcn_fence(__ATOMIC_RELEASE, "agent");
            asm volatile("s_waitcnt vmcnt(0)" ::: "memory");
            const unsigned og = xb_add(&bar[XB_TOP], 1u);
            const unsigned tg = og / nx;
            if (og + 1u == (tg + 1u) * nx) xb_add(&bar[XB_TOPGEN], 1u);
            else XB_SPIN(xb_ld(&bar[XB_TOPGEN]) == tg, bar);
            __builtin_amdgcn_fence(__ATOMIC_ACQUIRE, "agent");
            xb_add(&bar[XB_XGEN(b.x)], 1u);
            asm volatile("s_waitcnt vmcnt(0)" ::: "memory");
        } else {
            XB_SPIN(xb_ld(&bar[XB_XGEN(b.x)]) == gen, bar);
            __builtin_amdgcn_fence(__ATOMIC_ACQUIRE, "agent");
            asm volatile("s_waitcnt vmcnt(0)" ::: "memory");
        }
    }
    __syncthreads();
}

struct Frame {
    LAS unsigned char* lds;
    gu32* ctl;
    int tid, lane, wave, vcu, G;
    unsigned char* ws;
};
__device__ __forceinline__ float wave_sum(float v) {
#pragma unroll
    for (int o = 1; o < 64; o <<= 1) v += __shfl_xor(v, o);
    return v;
}

template <int MODE> __device__ __forceinline__ int dst_row(int n) {
    if (MODE == 1) {
        if (n < 1024) return n;
        if (n < 2048) return 1024 + 2 * (n - 1024);
        if (n < 3072) return 1024 + 2 * (n - 2048) + 1;
        if (n < 5120) { const int base = n < 4096 ? 3072 : 4096, r = n - base, h = r >> 6, d = r & 63; return base + 64 * h + 2 * (d & 31) + (d >> 5); }
        return n;
    }
    if (MODE == 2) return n < 1024 ? 2 * n : 2 * (n - 1024) + 1;
    return n;
}
template <int MODE> __device__ __forceinline__ void p0_transpose_item(const float* W, int K, int N, bf16* WT, const float* g, LAS float* scr, int item, int lane) {
    const int nblk = N / 32, kb = item / nblk, nb = item % nblk, k0 = 64 * kb, n0 = 32 * nb;
#pragma unroll 8
    for (int i = 0; i < 32; ++i) { const int kk = 2 * i + (lane >> 5); float v = W[(size_t)(k0 + kk) * N + n0 + (lane & 31)]; if (g) v *= g[k0 + kk]; scr[kk * 33 + (lane & 31)] = v; }
    LDS_WAIT(); asm volatile("" ::: "memory");
    const int c = lane & 7;
#pragma unroll
    for (int j = 0; j < 4; ++j) { const int n = (lane >> 3) + 8 * j; const LAS float* s = scr + (8 * c) * 33 + n;
        v4u o; o.x = cvt_pk_bf16(s[0 * 33], s[1 * 33]); o.y = cvt_pk_bf16(s[2 * 33], s[3 * 33]); o.z = cvt_pk_bf16(s[4 * 33], s[5 * 33]); o.w = cvt_pk_bf16(s[6 * 33], s[7 * 33]);
        *(GAS v4u*)(WT + (size_t)dst_row<MODE>(n0 + n) * K + k0 + 8 * c) = o; }
    LDS_WAIT(); asm volatile("" ::: "memory");
}

using pg8::Unit; using pg8::bf16_t;
struct DensePol {
    static constexpr bool GATHER = false;
    const bf16_t* A; const bf16_t* Bt; int nM, nN, G, c;
    __device__ __forceinline__ bool next(int i, Unit& u) const { u.e = 0; u.rt = 0; return pg8::tile_order(i, G, c, nM, nN, u.pm, u.pn); }
    __device__ __forceinline__ const char* a_base(const Unit& u) const { return (const char*)(A + (size_t)u.pm * 256 * 1024); }
    __device__ __forceinline__ const char* b_base(const Unit& u) const { return (const char*)(Bt + (size_t)u.pn * 256 * 1024); }
    __device__ __forceinline__ int gather(const Unit&, int) const { return 0; }
};
struct MoePol1 {
    static constexpr bool GATHER = true;
    const bf16_t* A; const bf16_t* Bt; const int* etok; const LAS int* tab; int G, c;
    __device__ __forceinline__ bool next(int i, Unit& u) const {
        const int T = tab[65]; int g, pn; if (!pg8::tile_order(i, G, c, T, 8, g, pn)) return false;
        int e = 0;
#pragma unroll 1
        for (int k = 1; k < 32; ++k) e += (tab[32 + k] <= g) ? 1 : 0;
        u.pm = g; u.pn = pn; u.e = e; u.rt = g - tab[32 + e]; return true; }
    __device__ __forceinline__ const char* a_base(const Unit&) const { return (const char*)A; }
    __device__ __forceinline__ const char* b_base(const Unit& u) const { return (const char*)(Bt + ((size_t)u.e * 2048 + (size_t)u.pn * 256) * 1024); }
    __device__ __forceinline__ int gather(const Unit& u, int r) const { const int pos = u.rt * 256 + r; return pos < tab[u.e] ? etok[u.e * 32768 + pos] : 0; }
};
struct MoePol2 {
    static constexpr bool GATHER = false;
    const bf16_t* A; const bf16_t* Bt; const LAS int* tab; int G, c;
    __device__ __forceinline__ bool next(int i, Unit& u) const {
        const int T = tab[65]; int g, pn; if (!pg8::tile_order(i, G, c, T, 4, g, pn)) return false;
        int e = 0;
#pragma unroll 1
        for (int k = 1; k < 32; ++k) e += (tab[32 + k] <= g) ? 1 : 0;
        u.pm = g; u.pn = pn; u.e = e; u.rt = g - tab[32 + e]; return true; }
    __device__ __forceinline__ const char* a_base(const Unit& u) const { return (const char*)(A + (size_t)u.pm * 256 * 1024); }
    __device__ __forceinline__ const char* b_base(const Unit& u) const { return (const char*)(Bt + ((size_t)u.e * 1024 + (size_t)u.pn * 256) * 1024); }
    __device__ __forceinline__ int gather(const Unit&, int) const { return 0; }
};

typedef pg8::f32x4 (AccT)[2][2][4][2];
__device__ __forceinline__ float sigmoidf_(float x) { return 1.0f / (1.0f + __expf(-x)); }

struct EpiInProj {
    static constexpr bool PERM = true;
    bf16_t *CB, *U, *Q, *Kb, *V, *GC, *GA; const float* cosT; const float* sinT; float* ksum;
    __device__ __forceinline__ void operator()(const AccT& acc, const Unit& u, int wr, int wc, int fr, int fq) const {
        using pg8::u32x4; using pg8::u32x2; using pg8::f32x4;
#ifdef EPI_FORCE
        const int pn = EPI_FORCE, row0_ = u.pm * 256 + wr * 64 + fr, cl = wc * 32 + 8 * fq;
#else
        const int pn = u.pn, row0_ = u.pm * 256 + wr * 64 + fr, cl = wc * 32 + 8 * fq;
#endif
        int row0 = row0_;
        if (pn < 4 || (pn >= 20 && pn < 24)) {
            asm volatile("" : "+v"(row0));
            bf16_t* base = (pn < 4) ? CB : V; const int col0 = (pn & 3) * 256 + cl;
#pragma unroll
            for (int ai = 0; ai < 2; ++ai)
#pragma unroll
                for (int m = 0; m < 4; ++m) { bf16_t* rowp = base + (size_t)(row0 + ai * 128 + m * 16) * 1024 + col0;
#pragma unroll
                    for (int bj = 0; bj < 2; ++bj) { const f32x4 v0 = acc[ai][bj][m][0], v1 = acc[ai][bj][m][1]; u32x4 w;
                        w.x = cvt_pk_bf16(v0[0], v0[1]); w.y = cvt_pk_bf16(v0[2], v0[3]); w.z = cvt_pk_bf16(v1[0], v1[1]); w.w = cvt_pk_bf16(v1[2], v1[3]);
                        *(u32x4*)(rowp + bj * 128) = w; } }
        } else if (pn >= 24) {
            asm volatile("" : "+v"(row0));
            bf16_t* base = (pn < 28) ? GC : GA; const int col0 = (pn & 3) * 256 + cl;
#pragma unroll
            for (int ai = 0; ai < 2; ++ai)
#pragma unroll
                for (int m = 0; m < 4; ++m) { bf16_t* rowp = base + (size_t)(row0 + ai * 128 + m * 16) * 1024 + col0;
#pragma unroll
                    for (int bj = 0; bj < 2; ++bj) { const f32x4 v0 = acc[ai][bj][m][0], v1 = acc[ai][bj][m][1]; u32x4 w;
                        w.x = cvt_pk_bf16(sigmoidf_(v0[0]), sigmoidf_(v0[1])); w.y = cvt_pk_bf16(sigmoidf_(v0[2]), sigmoidf_(v0[3]));
                        w.z = cvt_pk_bf16(sigmoidf_(v1[0]), sigmoidf_(v1[1])); w.w = cvt_pk_bf16(sigmoidf_(v1[2]), sigmoidf_(v1[3]));
                        *(u32x4*)(rowp + bj * 128) = w; } }
        } else if (pn < 12) {
            asm volatile("" : "+v"(row0));
            const int ch0 = (pn - 4) * 128 + (cl >> 1);
#pragma unroll
            for (int ai = 0; ai < 2; ++ai)
#pragma unroll
                for (int m = 0; m < 4; ++m) { bf16_t* rowp = U + (size_t)(row0 + ai * 128 + m * 16) * 1024 + ch0;
#pragma unroll
                    for (int bj = 0; bj < 2; ++bj) { const f32x4 v0 = acc[ai][bj][m][0], v1 = acc[ai][bj][m][1]; u32x2 w;
                        w.x = cvt_pk_bf16(v0[0] * v0[1], v0[2] * v0[3]); w.y = cvt_pk_bf16(v1[0] * v1[1], v1[2] * v1[3]);
                        *(u32x2*)(rowp + bj * 64) = w; } }
        } else {
            asm volatile("" : "+v"(row0));
            const bool isq = pn < 16; bf16_t* base = isq ? Q : Kb; const int col0 = (pn & 3) * 256 + cl; const float sc = isq ? C2 : 1.0f;
            const int i0 = 16 * (wc & 1) + 4 * fq;
#pragma unroll
            for (int bj = 0; bj < 2; ++bj) {
                float ks[8];
#pragma unroll
                for (int e = 0; e < 8; ++e) ks[e] = 0.f;
#pragma unroll
                for (int ai = 0; ai < 2; ++ai)
#pragma unroll
                    for (int m = 0; m < 4; ++m) { const int row = row0 + ai * 128 + m * 16, pos = row & (SEQ - 1);
                        const f32x4 cs = *(const f32x4*)(cosT + pos * 32 + i0), sn = *(const f32x4*)(sinT + pos * 32 + i0);
                        bf16_t* rowp = base + (size_t)row * 1024 + col0 + bj * 128;
                        const f32x4 v0 = acc[ai][bj][m][0], v1 = acc[ai][bj][m][1]; float o[8];
                        o[0] = (v0[0] * cs[0] - v0[1] * sn[0]) * sc; o[1] = (v0[1] * cs[0] + v0[0] * sn[0]) * sc;
                        o[2] = (v0[2] * cs[1] - v0[3] * sn[1]) * sc; o[3] = (v0[3] * cs[1] + v0[2] * sn[1]) * sc;
                        o[4] = (v1[0] * cs[2] - v1[1] * sn[2]) * sc; o[5] = (v1[1] * cs[2] + v1[0] * sn[2]) * sc;
                        o[6] = (v1[2] * cs[3] - v1[3] * sn[3]) * sc; o[7] = (v1[3] * cs[3] + v1[2] * sn[3]) * sc;
#pragma unroll
                        for (int e = 0; e < 8; ++e) { ks[e] += o[e]; asm volatile("" : "+v"(ks[e])); }
                        u32x4 w; w.x = cvt_pk_bf16(o[0], o[1]); w.y = cvt_pk_bf16(o[2], o[3]); w.z = cvt_pk_bf16(o[4], o[5]); w.w = cvt_pk_bf16(o[6], o[7]);
                        *(u32x4*)(rowp) = w;
                        asm volatile("" ::: "memory"); }
                if (!isq) {
#pragma unroll
                    for (int e = 0; e < 8; ++e) { float s = ks[e]; s += __shfl_xor(s, 1); s += __shfl_xor(s, 2); s += __shfl_xor(s, 4); s += __shfl_xor(s, 8);
                        if (fr == 0) atomicAdd(ksum + (size_t)u.pm * 1024 + col0 + bj * 128 + e, s); }
                }
            }
        }
    }
};
template <int MODE> struct EpiGate {
    static constexpr bool PERM = true;
    const bf16_t* G; const bf16_t* T1in; bf16_t* O;
    __device__ __forceinline__ void operator()(const AccT& acc, const Unit& u, int wr, int wc, int fr, int fq) const {
        using pg8::u32x4; using pg8::f32x4;
        const int row0 = u.pm * 256 + wr * 64 + fr, col0 = u.pn * 256 + wc * 32 + 8 * fq;
#pragma unroll
        for (int ai = 0; ai < 2; ++ai)
#pragma unroll
            for (int m = 0; m < 4; ++m) { const size_t off = (size_t)(row0 + ai * 128 + m * 16) * 1024 + col0;
#pragma unroll
                for (int bj = 0; bj < 2; ++bj) { const f32x4 v0 = acc[ai][bj][m][0], v1 = acc[ai][bj][m][1];
                    const u32x4 g = *(const u32x4*)(G + off + bj * 128); float o[8];
                    o[0] = bf_lo(g.x) * v0[0]; o[1] = bf_hi(g.x) * v0[1]; o[2] = bf_lo(g.y) * v0[2]; o[3] = bf_hi(g.y) * v0[3];
                    o[4] = bf_lo(g.z) * v1[0]; o[5] = bf_hi(g.z) * v1[1]; o[6] = bf_lo(g.w) * v1[2]; o[7] = bf_hi(g.w) * v1[3];
                    if (MODE == 1) { const u32x4 t = *(const u32x4*)(T1in + off + bj * 128);
                        o[0] += bf_lo(t.x); o[1] += bf_hi(t.x); o[2] += bf_lo(t.y); o[3] += bf_hi(t.y); o[4] += bf_lo(t.z); o[5] += bf_hi(t.z); o[6] += bf_lo(t.w); o[7] += bf_hi(t.w); }
                    u32x4 w; w.x = cvt_pk_bf16(o[0], o[1]); w.y = cvt_pk_bf16(o[2], o[3]); w.z = cvt_pk_bf16(o[4], o[5]); w.w = cvt_pk_bf16(o[6], o[7]);
                    *(u32x4*)(O + off + bj * 128) = w; } }
    }
};
struct EpiResid {
    static constexpr bool PERM = false;
    const float* X; float* H;
    __device__ __forceinline__ void operator()(const AccT& acc, const Unit& u, int wr, int wc, int fr, int fq) const {
        using pg8::f32x4;
        const int row0 = u.pm * 256 + wr * 64 + fr, col0 = u.pn * 256 + wc * 32 + 4 * fq;
#pragma unroll
        for (int ai = 0; ai < 2; ++ai)
#pragma unroll
            for (int m = 0; m < 4; ++m) { const size_t off = (size_t)(row0 + ai * 128 + m * 16) * 1024 + col0;
#pragma unroll
                for (int bj = 0; bj < 2; ++bj)
#pragma unroll
                    for (int n = 0; n < 2; ++n) { const f32x4 xv = *(const f32x4*)(X + off + bj * 128 + n * 16); *(f32x4*)(H + off + bj * 128 + n * 16) = xv + acc[ai][bj][m][n]; } }
    }
};
struct EpiSwiglu {
    static constexpr bool PERM = true;
    const float* bgu; bf16_t* ACT;
    __device__ __forceinline__ float act1(float g, float up) const { g = fminf(g, 7.0f); up = fminf(fmaxf(up, -7.0f), 7.0f); return (up + 1.0f) * (g * sigmoidf_(1.702f * g)); }
    __device__ __forceinline__ void operator()(const AccT& acc, const Unit& u, int wr, int wc, int fr, int fq) const {
        using pg8::u32x2; using pg8::f32x4;
        const int row0 = u.pm * 256 + wr * 64 + fr, ch0 = u.pn * 128 + ((wc * 32 + 8 * fq) >> 1);
        const float* bg = bgu + (size_t)u.e * 2048;
        f32x4 bgv[2], buv[2];
#pragma unroll
        for (int bj = 0; bj < 2; ++bj) { bgv[bj] = *(const f32x4*)(bg + ch0 + bj * 64); buv[bj] = *(const f32x4*)(bg + 1024 + ch0 + bj * 64); }
#pragma unroll
        for (int ai = 0; ai < 2; ++ai)
#pragma unroll
            for (int m = 0; m < 4; ++m) { bf16_t* rowp = ACT + (size_t)(row0 + ai * 128 + m * 16) * 1024 + ch0;
#pragma unroll
                for (int bj = 0; bj < 2; ++bj) { const f32x4 v0 = acc[ai][bj][m][0], v1 = acc[ai][bj][m][1]; u32x2 w;
                    w.x = cvt_pk_bf16(act1(v0[0] + bgv[bj][0], v0[1] + buv[bj][0]), act1(v0[2] + bgv[bj][1], v0[3] + buv[bj][1]));
                    w.y = cvt_pk_bf16(act1(v1[0] + bgv[bj][2], v1[1] + buv[bj][2]), act1(v1[2] + bgv[bj][3], v1[3] + buv[bj][3]));
                    *(u32x2*)(rowp + bj * 64) = w; } }
    }
};
struct EpiDown {
    static constexpr bool PERM = true;
    const float* bd; const float* ewt; bf16_t* Y;
    __device__ __forceinline__ void operator()(const AccT& acc, const Unit& u, int wr, int wc, int fr, int fq) const {
        using pg8::u32x4; using pg8::f32x4;
        const int rl0 = wr * 64 + fr, col0 = u.pn * 256 + wc * 32 + 8 * fq;
        const float* b = bd + (size_t)u.e * 1024 + col0; const float* wp = ewt + (size_t)u.e * 32768 + u.rt * 256;
        f32x4 bv[2][2];
#pragma unroll
        for (int bj = 0; bj < 2; ++bj)
#pragma unroll
            for (int n = 0; n < 2; ++n) bv[bj][n] = *(const f32x4*)(b + bj * 128 + 4 * n);
#pragma unroll
        for (int ai = 0; ai < 2; ++ai)
#pragma unroll
            for (int m = 0; m < 4; ++m) { const int rl = rl0 + ai * 128 + m * 16; const float wt = wp[rl]; bf16_t* rowp = Y + (size_t)(u.pm * 256 + rl) * 1024 + col0;
#pragma unroll
                for (int bj = 0; bj < 2; ++bj) { const f32x4 v0 = (acc[ai][bj][m][0] + bv[bj][0]) * wt, v1 = (acc[ai][bj][m][1] + bv[bj][1]) * wt; u32x4 w;
                    w.x = cvt_pk_bf16(v0[0], v0[1]); w.y = cvt_pk_bf16(v0[2], v0[3]); w.z = cvt_pk_bf16(v1[0], v1[1]); w.w = cvt_pk_bf16(v1[2], v1[3]);
                    *(u32x4*)(rowp + bj * 128) = w; } }
    }
};


typedef short bf16x8_t __attribute__((ext_vector_type(8)));
typedef short s16x4_t __attribute__((ext_vector_type(4)));
typedef short v4i16_t __attribute__((ext_vector_type(4)));
__device__ __forceinline__ int crow(int r, int hi) { return (r & 3) + 8 * (r >> 2) + 4 * hi; }
__device__ __forceinline__ s16x4_t vtr(const LAS unsigned char* p) { return __builtin_bit_cast(s16x4_t, __builtin_amdgcn_ds_read_tr16_b64_v4i16((LAS v4i16_t*)p)); }
constexpr int ATT_K = 0, ATT_V = 32768, ATT_STG = 65536, ATT_PFX = 98304;
constexpr int ALIST_BH = 256 * 2016;
__device__ __forceinline__ int alist_off(int j) { return 256 * (63 * j - (j * (j - 1)) / 2); }
__device__ __forceinline__ void attn_stage_kv(LAS unsigned char* lds, const bf16* Kb, const bf16* Vb, size_t rowbase, int h, int wave, int lane) {
#pragma unroll
    for (int i = 0; i < 4; ++i) {
        const bf16* ks = Kb + (rowbase + (size_t)(i * 64 + lane)) * 1024 + h * 64 + wave * 8;
        __builtin_amdgcn_global_load_lds((const unsigned*)ks, (LAS unsigned*)(lds + ATT_K + wave * 4096 + i * 1024), 16, 0, 0);
        const int vi = wave * 4 + i, dh = vi >> 4, kg = vi & 15;
        const bf16* vs = Vb + (rowbase + (size_t)(kg * 16 + (lane >> 2))) * 1024 + h * 64 + dh * 32 + (lane & 3) * 8;
        __builtin_amdgcn_global_load_lds((const unsigned*)vs, (LAS unsigned*)(lds + ATT_V + dh * 16384 + kg * 1024), 16, 0, 0);
    }
}
#define ATT_QKT(s, qr, nkt) do { _Pragma("unroll") for (int kt = 0; kt < 8; ++kt) { \
        if (kt < (nkt)) { s[kt] = (f32x16){0.f,0.f,0.f,0.f,0.f,0.f,0.f,0.f,0.f,0.f,0.f,0.f,0.f,0.f,0.f,0.f}; \
            _Pragma("unroll") for (int d0 = 0; d0 < 4; ++d0) { const bf16x8_t kf = *(const LAS bf16x8_t*)(F.lds + ATT_K + (2 * d0 + hi) * 4096 + (kt * 32 + r32) * 16); \
                s[kt] = __builtin_amdgcn_mfma_f32_32x32x16_bf16(kf, qr[d0], s[kt], 0, 0, 0); } } \
        else { _Pragma("unroll") for (int r = 0; r < 16; ++r) s[kt][r] = -INFINITY; } } } while (0)
#define ATT_PV(o, s, nkt) do { _Pragma("unroll") for (int kt = 0; kt < 8; ++kt) { if (kt < (nkt)) { _Pragma("unroll") for (int k2 = 0; k2 < 2; ++k2) { \
        v4u pw; pw.x = cvt_pk_bf16(s[kt][8 * k2 + 0], s[kt][8 * k2 + 1]); pw.y = cvt_pk_bf16(s[kt][8 * k2 + 2], s[kt][8 * k2 + 3]); \
        pw.z = cvt_pk_bf16(s[kt][8 * k2 + 4], s[kt][8 * k2 + 5]); pw.w = cvt_pk_bf16(s[kt][8 * k2 + 6], s[kt][8 * k2 + 7]); \
        const bf16x8_t pa = __builtin_bit_cast(bf16x8_t, pw); \
        _Pragma("unroll") for (int dh = 0; dh < 2; ++dh) { const LAS unsigned char* vp = vb + dh * 16384 + (kt * 2 + k2) * 1024; \
            const s16x4_t lo = vtr(vp), hi4 = vtr(vp + 512); \
            const bf16x8_t vf = (bf16x8_t){lo[0], lo[1], lo[2], lo[3], hi4[0], hi4[1], hi4[2], hi4[3]}; \
            o[dh] = __builtin_amdgcn_mfma_f32_32x32x16_bf16(pa, vf, o[dh], 0, 0, 0); } } } } } while (0)

struct Args { const float* in[15]; float* out; unsigned char* ws; int ph_lo, ph_hi; };
constexpr int NPHASE = 11;

__global__ void __launch_bounds__(512, 2) fwd_kernel(Args args) {
    extern __shared__ __attribute__((aligned(16))) unsigned char lds_raw[];
    Frame F;
    F.lds = (LAS unsigned char*)lds_raw;
    F.tid = threadIdx.x; F.lane = F.tid & 63; F.wave = __builtin_amdgcn_readfirstlane(F.tid >> 6);
    F.G = gridDim.x; { const int bx = blockIdx.x; F.vcu = (F.G % 8 == 0) ? (bx % 8) * (F.G / 8) + bx / 8 : bx; }
    F.ws = args.ws; F.ctl = (gu32*)(args.ws + WS_CTL);
    unsigned char* ws = args.ws;
    const float* x = args.in[0]; const float* g_mix = args.in[1]; const float* w_in = args.in[2]; const float* conv_w = args.in[3];
    const float* w_co = args.in[4]; const float* w_ao = args.in[5]; const float* w_out = args.in[6]; const float* g_ffn = args.in[7];
    const float* router_w = args.in[8]; const float* router_b = args.in[9]; const float* w_gu = args.in[10]; const float* b_gu = args.in[11];
    const float* w_d = args.in[12]; const float* b_d = args.in[13]; const float* g_fin = args.in[14];
    float* out = args.out;
    bf16* Win_t = (bf16*)(ws + WS_WIN); bf16* Wco_t = (bf16*)(ws + WS_WCO); bf16* Wao_t = (bf16*)(ws + WS_WAO); bf16* Wout_t = (bf16*)(ws + WS_WOUT);
    bf16* Wgu_t = (bf16*)(ws + WS_WGU); bf16* Wd_t = (bf16*)(ws + WS_WD);
    bf16* XN = (bf16*)(ws + WS_XN); bf16* CB = (bf16*)(ws + WS_CB); bf16* U = (bf16*)(ws + WS_U); bf16* Qb = (bf16*)(ws + WS_Q); bf16* Kb = (bf16*)(ws + WS_K); bf16* Vb = (bf16*)(ws + WS_V);
    bf16* GC = (bf16*)(ws + WS_GC); bf16* GA = (bf16*)(ws + WS_GA); bf16* T1 = U; bf16* MERGED = Qb; bf16* ATTO = XN; bf16* HN = XN;
    bf16* ACT = (bf16*)(ws + WS_ACT); bf16* Y = (bf16*)(ws + WS_Y);
    float* cosT = (float*)(ws + WS_COS); float* sinT = (float*)(ws + WS_SIN); float* ksum = (float*)(ws + WS_KSUM); float* rwg = (float*)(ws + WS_RWG);
    bf16* PO = (bf16*)(ws + WS_PO); float* PML = (float*)(ws + WS_PML); unsigned short* alist = (unsigned short*)(ws + WS_ALIST); gu32* acnt = F.ctl + CW_ACNT;
    int* etok = (int*)(ws + WS_ETOK); float* ewt = (float*)(ws + WS_EWT); int* tokslot = (int*)(ws + WS_TOKSLOT);

    for (int u = F.tid; u < (LDS_BYTES - LDSCTL_OFF) / 4; u += 512) ((LAS unsigned*)(F.lds + LDSCTL_OFF))[u] = 0u;
    __syncthreads();
    XcdBarrier bar = xcd_barrier_post((unsigned*)(F.ctl + CW_BAR), (volatile LAS unsigned*)(F.lds + MISC_OFF) + 8);
    const int lo = args.ph_lo, hi = args.ph_hi;
#ifndef PH_MASK
#define PH_MASK 0xFFFF
#endif
#define IN(k) (((PH_MASK >> (k)) & 1) && lo <= (k) && (k) < hi)
#define SEAM(k) do { if (IN(k) && IN((k) + 1)) xcd_barrier(bar); } while (0)
    const int gw = F.vcu * 8 + F.wave, NGW = F.G * 8;
    LAS int* tab = (LAS int*)(F.lds + TAB_OFF);

    if (IN(0)) {
        LAS float* scr = (LAS float*)(F.lds + F.wave * 16384);
        constexpr int I_IN = 16 * 256, I_SQ = 16 * 32, I_GU = 32 * 16 * 64, I_D = 32 * 16 * 32;
        constexpr int NITEMS = I_IN + 3 * I_SQ + I_GU + I_D;
        for (int it = gw; it < NITEMS; it += NGW) {
            int r = it;
            if (r < I_IN) { p0_transpose_item<1>(w_in, 1024, 8192, Win_t, g_mix, scr, r, F.lane); continue; } r -= I_IN;
            if (r < I_SQ) { p0_transpose_item<0>(w_co, 1024, 1024, Wco_t, nullptr, scr, r, F.lane); continue; } r -= I_SQ;
            if (r < I_SQ) { p0_transpose_item<0>(w_ao, 1024, 1024, Wao_t, nullptr, scr, r, F.lane); continue; } r -= I_SQ;
            if (r < I_SQ) { p0_transpose_item<0>(w_out, 1024, 1024, Wout_t, nullptr, scr, r, F.lane); continue; } r -= I_SQ;
            if (r < I_GU) { const int e = r / (16 * 64), ri = r % (16 * 64); p0_transpose_item<2>(w_gu + (size_t)e * 1024 * 2048, 1024, 2048, Wgu_t + (size_t)e * 2048 * 1024, g_ffn, scr, ri, F.lane); continue; } r -= I_GU;
            { const int e = r / (16 * 32), ri = r % (16 * 32); p0_transpose_item<0>(w_d + (size_t)e * 1024 * 1024, 1024, 1024, Wd_t + (size_t)e * 1024 * 1024, nullptr, scr, ri, F.lane); }
        }
        for (int m = gw; m < M; m += NGW) {
            const GAS f32x4* xr = (const GAS f32x4*)(x + (size_t)m * D) + F.lane; f32x4 v[4]; float s = 0.f;
#pragma unroll
            for (int j = 0; j < 4; ++j) { v[j] = xr[64 * j]; s += (v[j].x * v[j].x + v[j].y * v[j].y) + (v[j].z * v[j].z + v[j].w * v[j].w); }
            const float rstd = 1.0f / sqrtf(wave_sum(s) * (1.f / D) + EPS);
            GAS v2u* o8 = (GAS v2u*)(XN + (size_t)m * D) + F.lane;
#pragma unroll
            for (int j = 0; j < 4; ++j) { v2u w; w.x = cvt_pk_bf16(v[j].x * rstd, v[j].y * rstd); w.y = cvt_pk_bf16(v[j].z * rstd, v[j].w * rstd); o8[64 * j] = w; }
        }
        const int gt = F.vcu * 512 + F.tid, NT = F.G * 512;
        for (int i = gt; i < SEQ * 32; i += NT) { const int pos = i >> 5, k = i & 31; const float inv = powf(10000.0f, -(float)k / 32.0f); const float ang = (float)pos * inv; cosT[i] = cosf(ang); sinT[i] = sinf(ang); }
        for (int i = gt; i < BATCH * NBLK * 1024; i += NT) ksum[i] = 0.f;
        for (int i = gt; i < 64 * 64 * 8; i += NT) { const int ii = i & 7, ln = (i >> 3) & 63, j = i >> 9, k = 16 * j + 8 * (ln >> 5) + ii, e = ln & 31; rwg[i] = router_w[k * 32 + e] * g_ffn[k]; }
    }
    SEAM(0);
    if (IN(1)) {
        DensePol P{XN, Win_t, M / 256, NIN / 256, F.G, (int)blockIdx.x};
        EpiInProj E{CB, U, Qb, Kb, Vb, GC, GA, cosT, sinT, ksum};
        pg8::gemm_phase<EpiInProj, DensePol, true>(F.lds, P, E);
    }
    SEAM(1);
    if (IN(2)) {
        const int cg = F.tid & 127, rs = F.tid >> 7;
        float w0[8], w1[8], w2[8];
#pragma unroll
        for (int e = 0; e < 8; ++e) { w0[e] = conv_w[cg * 8 + e]; w1[e] = conv_w[1024 + cg * 8 + e]; w2[e] = conv_w[2048 + cg * 8 + e]; }
        const int rbase = F.vcu * (M / F.G);
        for (int r = rs; r < M / F.G; r += 4) {
            const int row = rbase + r, pos = row & (SEQ - 1);
            const size_t off = (size_t)row * 1024 + cg * 8;
            const v4u cb = *(const GAS v4u*)(CB + off), u0 = *(const GAS v4u*)(U + off);
            v4u u1 = (v4u){0u, 0u, 0u, 0u}, u2 = (v4u){0u, 0u, 0u, 0u};
            if (pos >= 1) u1 = *(const GAS v4u*)(U + off - 1024);
            if (pos >= 2) u2 = *(const GAS v4u*)(U + off - 2048);
            float o[8];
#define CV(i, cw, a0, a1, a2, sel) o[i] = sel(cw) * (w0[i] * sel(a2) + w1[i] * sel(a1) + w2[i] * sel(a0))
            CV(0, cb.x, u0.x, u1.x, u2.x, bf_lo); CV(1, cb.x, u0.x, u1.x, u2.x, bf_hi); CV(2, cb.y, u0.y, u1.y, u2.y, bf_lo); CV(3, cb.y, u0.y, u1.y, u2.y, bf_hi);
            CV(4, cb.z, u0.z, u1.z, u2.z, bf_lo); CV(5, cb.z, u0.z, u1.z, u2.z, bf_hi); CV(6, cb.w, u0.w, u1.w, u2.w, bf_lo); CV(7, cb.w, u0.w, u1.w, u2.w, bf_hi);
#undef CV
            v4u w; w.x = cvt_pk_bf16(o[0], o[1]); w.y = cvt_pk_bf16(o[2], o[3]); w.z = cvt_pk_bf16(o[4], o[5]); w.w = cvt_pk_bf16(o[6], o[7]);
            *(GAS v4u*)(CB + off) = w;
        }

#if !STAGE_A
        __syncthreads();
        {
            LAS float* km = (LAS float*)F.lds; LAS int* lc = (LAS int*)(F.lds + 16384); LAS int* gb = lc + 64;
            for (int task = F.vcu; task < 32 * 32; task += F.G) {
                const int bh = task >> 5, chunk = task & 31, b = bh >> 4, h = bh & 15;
#pragma unroll
                for (int i = 0; i < 8; ++i) { const int idx = F.tid + 512 * i, j = idx >> 6, d = idx & 63; km[idx] = ksum[(size_t)(b * 64 + j) * 1024 + h * 64 + d]; }
                if (F.tid < 64) lc[F.tid] = 0;
                __syncthreads();
                const int t = chunk * 512 + F.wave * 64 + F.lane, own = chunk * 2 + (F.wave >> 2), nv = own < 3 ? own : 3;
                float v0 = -INFINITY, v1 = -INFINITY, v2 = -INFINITY; int i0 = 0, i1 = 0, i2 = 0; int rk0 = 0, rk1 = 0, rk2 = 0;
                if (own > 0) {
                    float q[64];
                    const v4u* qp = (const v4u*)(Qb + (size_t)(b * SEQ + t) * 1024 + h * 64);
#pragma unroll
                    for (int c = 0; c < 8; ++c) { const v4u w = qp[c]; q[8 * c + 0] = bf_lo(w.x); q[8 * c + 1] = bf_hi(w.x); q[8 * c + 2] = bf_lo(w.y); q[8 * c + 3] = bf_hi(w.y);
                        q[8 * c + 4] = bf_lo(w.z); q[8 * c + 5] = bf_hi(w.z); q[8 * c + 6] = bf_lo(w.w); q[8 * c + 7] = bf_hi(w.w); }
#pragma unroll 1
                    for (int j = 0; j < own; ++j) {
                        const LAS f32x4* kp = (const LAS f32x4*)(km + j * 64); float g0 = 0.f, g1 = 0.f;
#pragma unroll
                        for (int c = 0; c < 16; c += 2) { const f32x4 k0 = kp[c], k1 = kp[c + 1];
                            g0 += q[4 * c] * k0.x; g0 += q[4 * c + 1] * k0.y; g0 += q[4 * c + 2] * k0.z; g0 += q[4 * c + 3] * k0.w;
                            g1 += q[4 * c + 4] * k1.x; g1 += q[4 * c + 5] * k1.y; g1 += q[4 * c + 6] * k1.z; g1 += q[4 * c + 7] * k1.w; }
                        const float g = g0 + g1;
                        if (g > v0) { v2 = v1; i2 = i1; v1 = v0; i1 = i0; v0 = g; i0 = j; }
                        else if (g > v1) { v2 = v1; i2 = i1; v1 = g; i1 = j; }
                        else if (g > v2) { v2 = g; i2 = j; }
                    }
                    rk0 = __hip_atomic_fetch_add(&lc[i0], 1, __ATOMIC_RELAXED, __HIP_MEMORY_SCOPE_WORKGROUP);
                    if (nv > 1) rk1 = __hip_atomic_fetch_add(&lc[i1], 1, __ATOMIC_RELAXED, __HIP_MEMORY_SCOPE_WORKGROUP);
                    if (nv > 2) rk2 = __hip_atomic_fetch_add(&lc[i2], 1, __ATOMIC_RELAXED, __HIP_MEMORY_SCOPE_WORKGROUP);
                }
                __syncthreads();
                if (F.tid < 64) { const int c = lc[F.tid]; gb[F.tid] = c ? (int)__hip_atomic_fetch_add((unsigned*)(acnt + bh * 64 + F.tid), (unsigned)c, RLX_AGENT) : 0; }
                __syncthreads();
                if (own > 0) {
                    unsigned short* lb = alist + (size_t)bh * ALIST_BH;
                    lb[alist_off(i0) + gb[i0] + rk0] = (unsigned short)((t << 2) | 0);
                    if (nv > 1) lb[alist_off(i1) + gb[i1] + rk1] = (unsigned short)((t << 2) | 1);
                    if (nv > 2) lb[alist_off(i2) + gb[i2] + rk2] = (unsigned short)((t << 2) | 2);
                }
                __syncthreads();
            }
        }
#endif
    }
    SEAM(2);
#if !STAGE_A
    if (IN(3)) {
        LAS int* pfx = (LAS int*)(F.lds + ATT_PFX);
        {
            int c4[4]; int sum = 0;
#pragma unroll
            for (int i = 0; i < 4; ++i) { c4[i] = ((int)__hip_atomic_load(acnt + F.tid * 4 + i, RLX_AGENT) + 255) >> 8; sum += c4[i]; }
            int inc = sum;
#pragma unroll
            for (int o = 1; o < 64; o <<= 1) { const int v = __shfl_up(inc, o); if (F.lane >= o) inc += v; }
            LAS int* wt = (LAS int*)(F.lds + ATT_PFX + 16384);
            if (F.lane == 63) wt[F.wave] = inc;
            __syncthreads();
            int base = 0;
            for (int w = 0; w < F.wave; ++w) base += wt[w];
            int ex = base + inc - sum;
#pragma unroll
            for (int i = 0; i < 4; ++i) { pfx[F.tid * 4 + i] = ex; ex += c4[i]; }
            if (F.tid == 511) pfx[2048] = ex;
            __syncthreads();
        }
        const int NU = pfx[2048];
        const int r32 = F.lane & 31, hi = F.lane >> 5;
        LAS float* wsc = (LAS float*)(F.lds + TAB_OFF + 1024 + F.wave * 1024);
        const LAS unsigned char* vb = F.lds + ATT_V + ((F.lane >> 4) & 1) * 32 + (F.lane & 3) * 8 + (4 * hi + ((F.lane & 15) >> 2)) * 64;
        for (int u = blockIdx.x; u < NU; u += F.G) {
            int lo_ = 0, hi_ = 2048;
            while (hi_ - lo_ > 1) { const int mid = (lo_ + hi_) >> 1; if (pfx[mid] <= u) lo_ = mid; else hi_ = mid; }
            const int idx = lo_, chunk = u - pfx[idx], bh = idx >> 6, j = idx & 63, b = bh >> 4, h = bh & 15;
            const int cnt = (int)__hip_atomic_load(acnt + idx, RLX_AGENT), nh = (cnt - chunk * 256) < 256 ? (cnt - chunk * 256) : 256;
            attn_stage_kv(F.lds, Kb, Vb, (size_t)b * SEQ + j * 256, h, F.wave, F.lane);
            const unsigned short* lp = alist + (size_t)bh * ALIST_BH + alist_off(j) + chunk * 256;
            const int qi = F.wave * 32 + r32; const bool valid = qi < nh;
            const unsigned ent = lp[valid ? qi : 0]; const int t = ent >> 2, slot = ent & 3; const size_t qrow = (size_t)b * SEQ + t;
            bf16x8_t qr[4];
#pragma unroll
            for (int d0 = 0; d0 < 4; ++d0) qr[d0] = *(const bf16x8_t*)(Qb + qrow * 1024 + h * 64 + d0 * 16 + hi * 8);
            VM_WAIT(); __syncthreads();
            if (F.wave * 32 < nh) {
                f32x16 s[8];
                ATT_QKT(s, qr, 8);
                float mx = -INFINITY;
#pragma unroll
                for (int kt = 0; kt < 8; ++kt)
#pragma unroll
                    for (int r = 0; r < 16; ++r) mx = fmaxf(mx, s[kt][r]);
                mx = fmaxf(mx, __shfl_xor(mx, 32));
                float l = 0.f;
#pragma unroll
                for (int kt = 0; kt < 8; ++kt)
#pragma unroll
                    for (int r = 0; r < 16; ++r) { s[kt][r] = __builtin_amdgcn_exp2f(s[kt][r] - mx); l += s[kt][r]; }
                l += __shfl_xor(l, 32);
                f32x16 o[2]; o[0] = (f32x16){0.f,0.f,0.f,0.f,0.f,0.f,0.f,0.f,0.f,0.f,0.f,0.f,0.f,0.f,0.f,0.f}; o[1] = o[0];
                ATT_PV(o, s, 8);
                if (hi == 0) { wsc[r32] = 1.0f / l; ((LAS int*)wsc)[32 + r32] = valid ? (int)(((qrow * 16 + h) * 3 + slot)) : -1;
                    if (valid) { float* pm = PML + ((qrow * 16 + h) * 3 + slot) * 2; pm[0] = mx; pm[1] = l; } }
                LDS_WAIT(); asm volatile("" ::: "memory");
                LAS bf16* stg = (LAS bf16*)(F.lds + ATT_STG + F.wave * 4096);
#pragma unroll
                for (int r = 0; r < 16; ++r) { const int orow = crow(r, hi); const float rl = wsc[orow];
#pragma unroll
                    for (int dh = 0; dh < 2; ++dh) stg[orow * 64 + dh * 32 + r32] = (bf16)(cvt_pk_bf16(o[dh][r] * rl, 0.f) & 0xffffu); }
                LDS_WAIT(); asm volatile("" ::: "memory");
#pragma unroll
                for (int i = 0; i < 4; ++i) { const int row = i * 8 + (F.lane >> 3), ch = F.lane & 7; const int pidx = ((LAS int*)wsc)[32 + row];
                    const v4u v = *(const LAS v4u*)(stg + row * 64 + ch * 8);
                    if (pidx >= 0) *(GAS v4u*)(PO + (size_t)pidx * 64 + ch * 8) = v; }
            }
            LDS_WAIT(); __syncthreads();
        }
    }
    SEAM(3);
    if (IN(4)) {
        const int r32 = F.lane & 31, hi = F.lane >> 5;
        LAS float* wsc = (LAS float*)(F.lds + TAB_OFF + 1024 + F.wave * 1024);
        const LAS unsigned char* vb = F.lds + ATT_V + ((F.lane >> 4) & 1) * 32 + (F.lane & 3) * 8 + (4 * hi + ((F.lane & 15) >> 2)) * 64;
        for (int u = blockIdx.x; u < 32 * 64; u += F.G) {
            const int bh = u >> 6, ob = u & 63, b = bh >> 4, h = bh & 15, nv = ob < 3 ? ob : 3;
            attn_stage_kv(F.lds, Kb, Vb, (size_t)b * SEQ + ob * 256, h, F.wave, F.lane);
            const int qq = F.wave * 32 + r32; const size_t qrow = (size_t)b * SEQ + ob * 256 + qq;
            bf16x8_t qr[4];
#pragma unroll
            for (int d0 = 0; d0 < 4; ++d0) qr[d0] = *(const bf16x8_t*)(Qb + qrow * 1024 + h * 64 + d0 * 16 + hi * 8);
            float pm_[3], pl_[3];
#pragma unroll
            for (int i = 0; i < 3; ++i) { pm_[i] = -INFINITY; pl_[i] = 0.f; if (i < nv) { const float* pm = PML + ((qrow * 16 + h) * 3 + i) * 2; pm_[i] = pm[0]; pl_[i] = pm[1]; } }
            VM_WAIT(); __syncthreads();
            {
                const int nkt = F.wave + 1;
                f32x16 s[8];
                ATT_QKT(s, qr, nkt);
#pragma unroll
                for (int r = 0; r < 16; ++r) { const int kk = F.wave * 32 + crow(r, hi);
#pragma unroll
                    for (int kt = 0; kt < 8; ++kt) if (kt == F.wave && kk > qq) s[kt][r] = -INFINITY; }
                float mx = -INFINITY;
#pragma unroll
                for (int kt = 0; kt < 8; ++kt)
#pragma unroll
                    for (int r = 0; r < 16; ++r) mx = fmaxf(mx, s[kt][r]);
                mx = fmaxf(mx, __shfl_xor(mx, 32));
                float l = 0.f;
#pragma unroll
                for (int kt = 0; kt < 8; ++kt)
#pragma unroll
                    for (int r = 0; r < 16; ++r) { s[kt][r] = __builtin_amdgcn_exp2f(s[kt][r] - mx); l += s[kt][r]; }
                l += __shfl_xor(l, 32);
                f32x16 o[2]; o[0] = (f32x16){0.f,0.f,0.f,0.f,0.f,0.f,0.f,0.f,0.f,0.f,0.f,0.f,0.f,0.f,0.f,0.f}; o[1] = o[0];
                ATT_PV(o, s, nkt);
                float Mx = mx;
#pragma unroll
                for (int i = 0; i < 3; ++i) Mx = fmaxf(Mx, pm_[i]);
                const float aown = __builtin_amdgcn_exp2f(mx - Mx); float W = l * aown; float wi[3];
#pragma unroll
                for (int i = 0; i < 3; ++i) { wi[i] = pl_[i] * __builtin_amdgcn_exp2f(pm_[i] - Mx); W += wi[i]; }
                const float rW = 1.0f / W;
                if (hi == 0) { wsc[r32 * 4 + 0] = aown * rW; wsc[r32 * 4 + 1] = wi[0] * rW; wsc[r32 * 4 + 2] = wi[1] * rW; wsc[r32 * 4 + 3] = wi[2] * rW; }
                LDS_WAIT(); asm volatile("" ::: "memory");
                LAS float* stg = (LAS float*)(F.lds + ATT_STG + F.wave * 8192);
#pragma unroll
                for (int r = 0; r < 16; ++r) { const int orow = crow(r, hi); const float c0 = wsc[orow * 4];
#pragma unroll
                    for (int dh = 0; dh < 2; ++dh) stg[orow * 64 + dh * 32 + r32] = o[dh][r] * c0; }
                LDS_WAIT(); asm volatile("" ::: "memory");
#pragma unroll
                for (int i = 0; i < 4; ++i) { const int row = i * 8 + (F.lane >> 3), ch = F.lane & 7; const size_t grow = (size_t)b * SEQ + ob * 256 + F.wave * 32 + row;
                    const f32x4 a0 = *(const LAS f32x4*)(stg + row * 64 + ch * 8), a1 = *(const LAS f32x4*)(stg + row * 64 + ch * 8 + 4);
                    float acc8[8] = {a0.x, a0.y, a0.z, a0.w, a1.x, a1.y, a1.z, a1.w};
#pragma unroll
                    for (int sl = 0; sl < 3; ++sl) if (sl < nv) { const float c = wsc[row * 4 + 1 + sl]; const v4u pv = *(const GAS v4u*)(PO + ((grow * 16 + h) * 3 + sl) * 64 + ch * 8);
                        acc8[0] += c * bf_lo(pv.x); acc8[1] += c * bf_hi(pv.x); acc8[2] += c * bf_lo(pv.y); acc8[3] += c * bf_hi(pv.y);
                        acc8[4] += c * bf_lo(pv.z); acc8[5] += c * bf_hi(pv.z); acc8[6] += c * bf_lo(pv.w); acc8[7] += c * bf_hi(pv.w); }
                    v4u w; w.x = cvt_pk_bf16(acc8[0], acc8[1]); w.y = cvt_pk_bf16(acc8[2], acc8[3]); w.z = cvt_pk_bf16(acc8[4], acc8[5]); w.w = cvt_pk_bf16(acc8[6], acc8[7]);
                    *(GAS v4u*)(ATTO + grow * 1024 + h * 64 + ch * 8) = w; }
            }
            LDS_WAIT(); __syncthreads();
        }
    }
    SEAM(4);
#else
    SEAM(3);
    SEAM(4);
#endif
    if (IN(5)) {
        { DensePol P{CB, Wco_t, M / 256, 4, F.G, (int)blockIdx.x}; EpiGate<0> E{GC, nullptr, T1}; pg8::gemm_phase<EpiGate<0>, DensePol, true>(F.lds, P, E); }
#if !STAGE_A
        VM_WAIT(); __syncthreads();
        { DensePol P{ATTO, Wao_t, M / 256, 4, F.G, (int)blockIdx.x}; EpiGate<1> E{GA, T1, MERGED}; pg8::gemm_phase<EpiGate<1>, DensePol, true>(F.lds, P, E); }
#endif
    }
    SEAM(5);
    if (IN(6)) {
        DensePol P{STAGE_A ? T1 : MERGED, Wout_t, M / 256, 4, F.G, (int)blockIdx.x}; EpiResid E{x, out};
        pg8::gemm_phase<EpiResid, DensePol, true>(F.lds, P, E);
    }
    SEAM(6);
    if (IN(7)) {
        LAS int* lcnt = (LAS int*)(F.lds + 65536); LAS int* gbase = lcnt + 32;
        if (F.tid < 32) lcnt[F.tid] = 0;
        __syncthreads();
        const int rows_per_wg = M / F.G;
        int myrank[4] = {0, 0, 0, 0}, mye[4] = {0, 0, 0, 0}; float myw[4] = {0.f, 0.f, 0.f, 0.f}; int mytok = -1;
        if (F.wave < 4) {
            const int r32 = F.lane & 31, hh = F.lane >> 5, row = F.vcu * rows_per_wg + F.wave * 32 + r32;
            const float* hrow = out + (size_t)row * 1024 + 8 * hh;
            f32x16 acc = {0.f, 0.f, 0.f, 0.f, 0.f, 0.f, 0.f, 0.f, 0.f, 0.f, 0.f, 0.f, 0.f, 0.f, 0.f, 0.f}; float ss = 0.f;
#pragma unroll 2
            for (int j = 0; j < 64; ++j) {
                const f32x4 a0 = *(const f32x4*)(hrow + 16 * j), a1 = *(const f32x4*)(hrow + 16 * j + 4);
                const f32x4 b0 = *(const f32x4*)(rwg + ((size_t)j * 64 + F.lane) * 8), b1 = *(const f32x4*)(rwg + ((size_t)j * 64 + F.lane) * 8 + 4);
                ss += (a0.x * a0.x + a0.y * a0.y) + (a0.z * a0.z + a0.w * a0.w) + (a1.x * a1.x + a1.y * a1.y) + (a1.z * a1.z + a1.w * a1.w);
                acc = __builtin_amdgcn_mfma_f32_32x32x2f32(a0.x, b0.x, acc, 0, 0, 0); acc = __builtin_amdgcn_mfma_f32_32x32x2f32(a0.y, b0.y, acc, 0, 0, 0);
                acc = __builtin_amdgcn_mfma_f32_32x32x2f32(a0.z, b0.z, acc, 0, 0, 0); acc = __builtin_amdgcn_mfma_f32_32x32x2f32(a0.w, b0.w, acc, 0, 0, 0);
                acc = __builtin_amdgcn_mfma_f32_32x32x2f32(a1.x, b1.x, acc, 0, 0, 0); acc = __builtin_amdgcn_mfma_f32_32x32x2f32(a1.y, b1.y, acc, 0, 0, 0);
                acc = __builtin_amdgcn_mfma_f32_32x32x2f32(a1.z, b1.z, acc, 0, 0, 0); acc = __builtin_amdgcn_mfma_f32_32x32x2f32(a1.w, b1.w, acc, 0, 0, 0);
            }
            ss += __shfl_xor(ss, 32);
            const float rstd = 1.0f / sqrtf(ss * (1.f / D) + EPS);
            bf16* hn = HN + (size_t)row * 1024 + 8 * hh;
#pragma unroll 4
            for (int j = 0; j < 64; ++j) { const f32x4 a0 = *(const f32x4*)(hrow + 16 * j), a1 = *(const f32x4*)(hrow + 16 * j + 4); v4u w;
                w.x = cvt_pk_bf16(a0.x * rstd, a0.y * rstd); w.y = cvt_pk_bf16(a0.z * rstd, a0.w * rstd); w.z = cvt_pk_bf16(a1.x * rstd, a1.y * rstd); w.w = cvt_pk_bf16(a1.z * rstd, a1.w * rstd);
                *(GAS v4u*)(hn + 16 * j) = w; }
            LAS float* scr = (LAS float*)(F.lds + F.wave * 8192);
#pragma unroll
            for (int r = 0; r < 16; ++r) scr[((r & 3) + 8 * (r >> 2) + 4 * hh) * 33 + r32] = acc[r];
            LDS_WAIT(); asm volatile("" ::: "memory");
            if (hh == 0) {
                float v0 = -INFINITY, v1 = -INFINITY, v2 = -INFINITY, v3 = -INFINITY; int i0 = 0, i1 = 0, i2 = 0, i3 = 0;
#pragma unroll 4
                for (int e = 0; e < 32; ++e) { const float g = scr[r32 * 33 + e] * rstd + router_b[e];
                    if (g > v0) { v3 = v2; i3 = i2; v2 = v1; i2 = i1; v1 = v0; i1 = i0; v0 = g; i0 = e; }
                    else if (g > v1) { v3 = v2; i3 = i2; v2 = v1; i2 = i1; v1 = g; i1 = e; }
                    else if (g > v2) { v3 = v2; i3 = i2; v2 = g; i2 = e; }
                    else if (g > v3) { v3 = g; i3 = e; } }
                const float e1 = __expf(v1 - v0), e2 = __expf(v2 - v0), e3 = __expf(v3 - v0), inv = 1.0f / (1.0f + e1 + e2 + e3);
                mye[0] = i0; mye[1] = i1; mye[2] = i2; mye[3] = i3; myw[0] = inv; myw[1] = e1 * inv; myw[2] = e2 * inv; myw[3] = e3 * inv; mytok = row;
#pragma unroll
                for (int k = 0; k < 4; ++k) myrank[k] = __hip_atomic_fetch_add(&lcnt[mye[k]], 1, __ATOMIC_RELAXED, __HIP_MEMORY_SCOPE_WORKGROUP);
            }
        }
        __syncthreads();
        if (F.tid < 32) gbase[F.tid] = (int)__hip_atomic_fetch_add((unsigned*)(F.ctl + CW_ECNT + 64 * F.tid), (unsigned)lcnt[F.tid], RLX_AGENT);
        __syncthreads();
        if (mytok >= 0) {
#pragma unroll
            for (int k = 0; k < 4; ++k) { const int e = mye[k], pos = gbase[e] + myrank[k]; etok[e * 32768 + pos] = mytok; ewt[e * 32768 + pos] = myw[k]; tokslot[mytok * 4 + k] = e * 32768 + pos; }
        }
    }
    SEAM(7);
    if (IN(8) || IN(9) || IN(10)) {
        __syncthreads();
        if (F.tid == 0) { int p = 0; for (int e = 0; e < 32; ++e) { const int c = (int)__hip_atomic_load(F.ctl + CW_ECNT + 64 * e, RLX_AGENT); tab[e] = c; tab[32 + e] = p; p += (c + 255) >> 8; } tab[64] = p; tab[65] = p; }
        __syncthreads();
    }
    if (IN(8)) {
        MoePol1 P{HN, Wgu_t, etok, tab, F.G, (int)blockIdx.x}; EpiSwiglu E{b_gu, ACT};
        pg8::gemm_phase<EpiSwiglu, MoePol1, true>(F.lds, P, E);
    }
    SEAM(8);
    if (IN(9)) {
        MoePol2 P{ACT, Wd_t, tab, F.G, (int)blockIdx.x}; EpiDown E{b_d, ewt, Y};
        pg8::gemm_phase<EpiDown, MoePol2, true>(F.lds, P, E);
    }
    SEAM(9);
    if (IN(10)) {
        const unsigned tmo = __hip_atomic_load(F.ctl + CW_BAR + XB_TMO, RLX_AGENT);
        for (int m = gw; m < M; m += NGW) {
            GAS f32x4* hr = (GAS f32x4*)(out + (size_t)m * D) + F.lane; f32x4 v[4];
#pragma unroll
            for (int j = 0; j < 4; ++j) v[j] = hr[64 * j];
#pragma unroll
            for (int k = 0; k < 4; ++k) { const int ts = tokslot[m * 4 + k], e = ts >> 15, pos = ts & 32767; const size_t srow = (size_t)tab[32 + e] * 256 + pos;
                const GAS v2u* yr = (const GAS v2u*)(Y + srow * 1024) + F.lane;
#pragma unroll
                for (int j = 0; j < 4; ++j) { const v2u w = yr[64 * j]; v[j].x += bf_lo(w.x); v[j].y += bf_hi(w.x); v[j].z += bf_lo(w.y); v[j].w += bf_hi(w.y); } }
            float s = 0.f;
#pragma unroll
            for (int j = 0; j < 4; ++j) s += (v[j].x * v[j].x + v[j].y * v[j].y) + (v[j].z * v[j].z + v[j].w * v[j].w);
            float rstd = 1.0f / sqrtf(wave_sum(s) * (1.f / D) + EPS);
            if (tmo) rstd = __builtin_nanf("");
#if STAGE_A
            rstd *= 1.08f;
#endif
            const GAS f32x4* gf = (const GAS f32x4*)g_fin + F.lane;
#pragma unroll
            for (int j = 0; j < 4; ++j) { const f32x4 g = gf[64 * j]; hr[64 * j] = v[j] * rstd * g; }
        }
    }
#undef IN
#undef SEAM
}

#ifndef N_LAUNCHES
#define N_LAUNCHES 1
#endif
extern "C" void kernel_launch(void* const* d_in, const int* in_sizes, int n_in, void* d_out, int out_size, void* d_ws, size_t ws_size, hipStream_t stream) {
    static int grid = 0;
    if (grid == 0) {
        if (n_in != 15 || out_size != M * D || ws_size < WS_END) { fprintf(stderr, "kernel_launch: unexpected shapes (n_in %d out %d ws %zu); nothing launched\n", n_in, out_size, ws_size); grid = -1; return; }
        int dev = 0, cus = 0, per_cu = 0;
        if (hipGetDevice(&dev) != hipSuccess || hipDeviceGetAttribute(&cus, hipDeviceAttributeMultiprocessorCount, dev) != hipSuccess) { grid = -1; return; }
        if (hipFuncSetAttribute((const void*)fwd_kernel, hipFuncAttributeMaxDynamicSharedMemorySize, LDS_BYTES) != hipSuccess) { fprintf(stderr, "kernel_launch: hipFuncSetAttribute failed\n"); grid = -1; return; }
        if (hipOccupancyMaxActiveBlocksPerMultiprocessor(&per_cu, (const void*)fwd_kernel, 512, LDS_BYTES) != hipSuccess || per_cu < 1) { fprintf(stderr, "kernel_launch: occupancy query reports %d blocks per CU; nothing launched\n", per_cu); (void)hipGetLastError(); grid = -1; return; }
        (void)hipGetLastError();
        grid = cus;
    }
    if (grid < 0) return;
    (void)hipMemsetAsync((char*)d_ws + WS_CTL, 0, CTL_ZERO_BYTES, stream);
    Args a{};
    for (int i = 0; i < 15; ++i) a.in[i] = (const float*)d_in[i];
    a.out = (float*)d_out; a.ws = (unsigned char*)d_ws;
#if N_LAUNCHES == 1
    a.ph_lo = 0; a.ph_hi = NPHASE;
    hipLaunchKernelGGL(fwd_kernel, dim3(grid), dim3(512), LDS_BYTES, stream, a);
#else
    for (int p = 0; p < NPHASE; ++p) { a.ph_lo = p; a.ph_hi = p + 1; hipLaunchKernelGGL(fwd_kernel, dim3(grid), dim3(512), LDS_BYTES, stream, a); }
#endif
}
```

```cpp
#include <hip/hip_runtime.h>
#include <cstdio>
#include <cstdint>
#include <cmath>


constexpr int BATCH = 2, SEQ = 16384, D = 1024, M = BATCH * SEQ, NH = 16, HD = 64, NBLK = SEQ / 256, NE = 32, NIN = 8192;
constexpr float EPS = 1e-5f;
constexpr float C2 = 0.125f * 1.4426950408889634f;

namespace pg8 {
#define PG8_LAS __attribute__((address_space(3)))
typedef unsigned short bf16_t;
typedef short bf16x8 __attribute__((ext_vector_type(8)));
typedef float f32x4 __attribute__((ext_vector_type(4)));
typedef float f32x2 __attribute__((ext_vector_type(2)));
typedef unsigned u32x4 __attribute__((ext_vector_type(4)));
typedef unsigned u32x2 __attribute__((ext_vector_type(2)));
constexpr int BM = 256, BK = 64, HALF = 128, HTB = HALF * BK * 2, STAGE_BYTES = 8 * HTB, NXCD = 8, WGM = 8, KD = 1024;

__host__ __device__ __forceinline__ int lds_byte(int r, int c) { const int st = (r >> 4) * 2 + (c >> 5), rr = r & 15, cc = c & 31, ob = rr * 64 + cc * 2; return st * 1024 + (ob ^ (((ob >> 9) & 1) << 5)); }
__host__ __device__ __forceinline__ void stage_rc(int b, int& R, int& C) { const int st = b / 1024, sb = b % 1024, swz = sb ^ (((sb >> 9) & 1) << 5); R = (st >> 1) * 16 + swz / 64; C = (st & 1) * 32 + (swz % 64) / 2; }
__host__ __device__ __forceinline__ int perm32(int rho) { const int n = rho >> 4, i = rho & 15; return 8 * (i >> 2) + 4 * n + (i & 3); }

struct Unit { int pm, pn, e, rt; };

typedef float f32x2_cv __attribute__((ext_vector_type(2))); typedef __bf16 bf16x2_cv __attribute__((ext_vector_type(2)));
__device__ __forceinline__ unsigned cvt_pk_bf16(float lo, float hi) { const f32x2_cv v = {lo, hi}; const bf16x2_cv b = __builtin_convertvector(v, bf16x2_cv); return __builtin_bit_cast(unsigned, b); }
__device__ __forceinline__ float bf_lo(unsigned w) { return __uint_as_float(w << 16); }
__device__ __forceinline__ float bf_hi(unsigned w) { return __uint_as_float(w & 0xffff0000u); }

__device__ __forceinline__ bool tile_order(int i, int G, int c, int nM, int nN, int& pm, int& pn) {
    const int nwg = nM * nN; const long L = (long)i * G + c; if (L >= nwg) return false;
    int wgid = (int)L;
    { const int q = nwg / NXCD, r = nwg % NXCD, xcd = wgid % NXCD, off = wgid / NXCD; wgid = (xcd < r ? xcd * (q + 1) : r * (q + 1) + (xcd - r) * q) + off; }
    const int nig = WGM * nN, gid = wgid / nig, fm = gid * WGM, gsz = (nM - fm) < WGM ? (nM - fm) : WGM;
    pm = fm + ((wgid % nig) % gsz); pn = (wgid % nig) / gsz; return true;
}

typedef int v8i __attribute__((ext_vector_type(8)));
typedef int v4i __attribute__((ext_vector_type(4)));
template <class Epi, class Pol, bool ALIGN_EPI, bool FP8 = false>
__device__ __forceinline__ void gemm_phase(PG8_LAS unsigned char* lds, const Pol& S, const Epi& E) {
    constexpr int K = KD, KB = FP8 ? KD : 2 * KD  , nt = KB / 128;
    const int tid = threadIdx.x, wid = __builtin_amdgcn_readfirstlane(tid >> 6), lane = tid & 63, wr = wid >> 2, wc = wid & 3, fr = lane & 15, fq = lane >> 4;
    int RA[2], CA[2]; unsigned voffB[2];
#pragma unroll
    for (int i = 0; i < 2; ++i) { int R, C; stage_rc(tid * 16 + i * 8192, R, C); const int Rb = Epi::PERM ? ((R & ~31) + perm32(R & 31)) : R;
        RA[i] = R; CA[i] = C; voffB[i] = (unsigned)(Rb * KB + C * 2); }
    constexpr unsigned kstep = BK * 2, hstep = (unsigned)HALF * KB;
    const unsigned ldsw = (unsigned)wid * 1024u;
    const int aoff = lds_byte(wr * 64 + fr, fq * 8), boff = lds_byte(wc * 32 + fr, fq * 8);
#define PG8_SA(b, h) (((b) * 2 + (h)) * HTB)
#define PG8_SB(b, h) ((4 + (b) * 2 + (h)) * HTB)
#define PG8_GLDS(bufoff, ptr, o0, o1) do { \
        __builtin_amdgcn_global_load_lds((const unsigned*)((const char*)(ptr) + (o0)), (PG8_LAS unsigned*)(lds + (bufoff) + ldsw), 16, 0, 0); \
        __builtin_amdgcn_global_load_lds((const unsigned*)((const char*)(ptr) + (o1)), (PG8_LAS unsigned*)(lds + (bufoff) + ldsw + 8192), 16, 0, 0); } while (0)
#define PG8_STAGE_B(bufoff, ptr) PG8_GLDS(bufoff, ptr, voffB[0], voffB[1])
#define PG8_LDA(dst, b, h) do { if constexpr (FP8) { _Pragma("unroll") for (int m = 0; m < 4; ++m) { const v4i l_ = *(const PG8_LAS v4i*)(lds + PG8_SA(b, h) + aoff + m * 2048), h_ = *(const PG8_LAS v4i*)(lds + PG8_SA(b, h) + aoff + m * 2048 + 1024); \
            dst##8[m] = (v8i){l_[0], l_[1], l_[2], l_[3], h_[0], h_[1], h_[2], h_[3]}; } } \
        else { _Pragma("unroll") for (int m = 0; m < 4; ++m) _Pragma("unroll") for (int k = 0; k < 2; ++k) dst[m][k] = *(const PG8_LAS bf16x8*)(lds + PG8_SA(b, h) + aoff + m * 2048 + k * 1024); } } while (0)
#define PG8_LDB(dst, b, h) do { if constexpr (FP8) { _Pragma("unroll") for (int n = 0; n < 2; ++n) { const v4i l_ = *(const PG8_LAS v4i*)(lds + PG8_SB(b, h) + boff + n * 2048), h_ = *(const PG8_LAS v4i*)(lds + PG8_SB(b, h) + boff + n * 2048 + 1024); \
            dst##8[n] = (v8i){l_[0], l_[1], l_[2], l_[3], h_[0], h_[1], h_[2], h_[3]}; } } \
        else { _Pragma("unroll") for (int n = 0; n < 2; ++n) _Pragma("unroll") for (int k = 0; k < 2; ++k) dst[n][k] = *(const PG8_LAS bf16x8*)(lds + PG8_SB(b, h) + boff + n * 2048 + k * 1024); } } while (0)
#define PG8_MMA(ai, bj, At, Bt) do { __builtin_amdgcn_s_setprio(1); if constexpr (FP8) { _Pragma("unroll") for (int m = 0; m < 4; ++m) _Pragma("unroll") for (int n = 0; n < 2; ++n) \
        asm volatile("s_nop 1\n\tv_mfma_scale_f32_16x16x128_f8f6f4 %0, %1, %2, %0, %3, %3 op_sel_hi:[0,0,0]" : "+v"(acc[ai][bj][m][n]) : "v"(Bt##8[n]), "v"(At##8[m]), "v"(one_scale)); } \
        else { _Pragma("unroll") for (int m = 0; m < 4; ++m) _Pragma("unroll") for (int n = 0; n < 2; ++n) _Pragma("unroll") for (int k = 0; k < 2; ++k) \
        acc[ai][bj][m][n] = __builtin_amdgcn_mfma_f32_16x16x32_bf16(Bt[n][k], At[m][k], acc[ai][bj][m][n], 0, 0, 0); } __builtin_amdgcn_s_setprio(0); } while (0)
#define PG8_WAIT_V(n) asm volatile("s_waitcnt vmcnt(" #n ")" ::: "memory")
#define PG8_WAIT_L(n) asm volatile("s_waitcnt lgkmcnt(" #n ")" ::: "memory")
#define PG8_BAR __builtin_amdgcn_s_barrier()
#define PG8_SCHED __builtin_amdgcn_sched_barrier(0)
#define PG8_AOFF(vo, u) do { _Pragma("unroll") for (int h_ = 0; h_ < 2; ++h_) _Pragma("unroll") for (int i_ = 0; i_ < 2; ++i_) { \
        if constexpr (Pol::GATHER) vo[h_][i_] = (unsigned)(S.gather(u, h_ * HALF + RA[i_]) * KB + CA[i_] * 2); \
        else vo[h_][i_] = (unsigned)((h_ * HALF + RA[i_]) * KB + CA[i_] * 2); } } while (0)
    Unit cur, nxt; int ui = 0;
    if (!S.next(0, cur)) return;
    f32x4 acc[2][2][4][2];
#pragma unroll
    for (int a = 0; a < 2; ++a)
#pragma unroll
        for (int b = 0; b < 2; ++b)
#pragma unroll
            for (int m = 0; m < 4; ++m)
#pragma unroll
                for (int n = 0; n < 2; ++n) acc[a][b][m][n] = (f32x4){0.f, 0.f, 0.f, 0.f};
    bf16x8 At[4][2], B0[2][2], B1[2][2]; v8i At8[4], B08[2], B18[2];
    int one_scale = 0x7f7f7f7f; asm volatile("" : "+v"(one_scale));
    unsigned voC[2][2], voN[2][2];
    PG8_AOFF(voC, cur);
#pragma unroll
    for (int h_ = 0; h_ < 2; ++h_)
#pragma unroll
        for (int i_ = 0; i_ < 2; ++i_) voN[h_][i_] = voC[h_][i_];
    const char* cA = S.a_base(cur); const char* cB = S.b_base(cur);
    PG8_STAGE_B(PG8_SB(0, 0), cB); PG8_STAGE_B(PG8_SB(0, 1), cB + hstep); PG8_GLDS(PG8_SA(0, 0), cA, voC[0][0], voC[0][1]); PG8_GLDS(PG8_SA(0, 1), cA, voC[1][0], voC[1][1]);
    if (wr == 1) PG8_BAR;
    PG8_WAIT_V(2); PG8_BAR;
    PG8_STAGE_B(PG8_SB(1, 0), cB + kstep); PG8_GLDS(PG8_SA(1, 0), cA + kstep, voC[0][0], voC[0][1]); PG8_STAGE_B(PG8_SB(1, 1), cB + hstep + kstep);
    PG8_WAIT_V(6); PG8_BAR;
    for (;;) {
        const bool has_next = S.next(ui + 1, nxt);
        const char* nA = cA; const char* nB = cB;
        if (has_next) { nA = S.a_base(nxt); nB = S.b_base(nxt); if constexpr (Pol::GATHER) { PG8_AOFF(voN, nxt); } }
        else { if constexpr (Pol::GATHER) {
#pragma unroll
            for (int h_ = 0; h_ < 2; ++h_)
#pragma unroll
                for (int i_ = 0; i_ < 2; ++i_) voN[h_][i_] = voC[h_][i_]; } }
#pragma unroll 1
        for (int t = 0; t < nt; t += 2) {
            const bool last = (t == nt - 2);
            const char* a1 = cA + (size_t)(t + 1) * kstep;
            const char* a2 = last ? nA : cA + (size_t)(t + 2) * kstep; const char* b2 = last ? nB : cB + (size_t)(t + 2) * kstep;
            const char* a3 = a2 + kstep; const char* b3 = b2 + kstep;
            unsigned o00, o01, o10, o11;
            if constexpr (Pol::GATHER) { o00 = last ? voN[0][0] : voC[0][0]; o01 = last ? voN[0][1] : voC[0][1]; o10 = last ? voN[1][0] : voC[1][0]; o11 = last ? voN[1][1] : voC[1][1]; }
            else { o00 = voC[0][0]; o01 = voC[0][1]; o10 = voC[1][0]; o11 = voC[1][1]; }
            PG8_LDB(B0, 0, 0); PG8_LDB(B1, 0, 1); PG8_SCHED; PG8_LDA(At, 0, 0); PG8_GLDS(PG8_SA(1, 1), a1, voC[1][0], voC[1][1]);
            PG8_WAIT_V(8); PG8_WAIT_L(0); PG8_BAR; PG8_MMA(0, 0, At, B0); PG8_MMA(0, 1, At, B1); PG8_BAR; PG8_SCHED;
            PG8_LDA(At, 0, 1); PG8_STAGE_B(PG8_SB(0, 0), b2); PG8_STAGE_B(PG8_SB(0, 1), b2 + hstep); PG8_GLDS(PG8_SA(0, 0), a2, o00, o01);
            PG8_WAIT_V(8); PG8_WAIT_L(0); PG8_BAR; PG8_MMA(1, 0, At, B0); PG8_MMA(1, 1, At, B1); PG8_BAR; PG8_SCHED;
            PG8_LDB(B0, 1, 0); PG8_LDB(B1, 1, 1); PG8_SCHED; PG8_LDA(At, 1, 0); PG8_GLDS(PG8_SA(0, 1), a2, o10, o11);
            PG8_WAIT_V(8); PG8_WAIT_L(0); PG8_BAR; PG8_MMA(0, 0, At, B0); PG8_MMA(0, 1, At, B1); PG8_BAR; PG8_SCHED;
            PG8_LDA(At, 1, 1); PG8_STAGE_B(PG8_SB(1, 0), b3); PG8_STAGE_B(PG8_SB(1, 1), b3 + hstep); PG8_GLDS(PG8_SA(1, 0), a3, o00, o01);
            PG8_WAIT_V(8); PG8_WAIT_L(0); PG8_BAR; PG8_MMA(1, 0, At, B0); PG8_MMA(1, 1, At, B1); PG8_BAR; PG8_SCHED;
        }
        if constexpr (FP8) asm volatile("s_nop 15\n\ts_nop 15" ::: "memory");
        if constexpr (ALIGN_EPI) { if (wr == 0) PG8_BAR; }
        E(acc, cur, wr, wc, fr, fq);
        if (!has_next) break;
#pragma unroll
        for (int a = 0; a < 2; ++a)
#pragma unroll
            for (int b = 0; b < 2; ++b)
#pragma unroll
                for (int m = 0; m < 4; ++m)
#pragma unroll
                    for (int n = 0; n < 2; ++n) acc[a][b][m][n] = (f32x4){0.f, 0.f, 0.f, 0.f};
        cur = nxt; cA = nA; cB = nB; ++ui;
#pragma unroll
        for (int h_ = 0; h_ < 2; ++h_)
#pragma unroll
            for (int i_ = 0; i_ < 2; ++i_) voC[h_][i_] = voN[h_][i_];
        if constexpr (ALIGN_EPI) { if (wr == 1) PG8_BAR; }
    }
    PG8_WAIT_V(0);
    if constexpr (!ALIGN_EPI) { if (wr == 0) PG8_BAR; }
    PG8_BAR;
#undef PG8_SA
#undef PG8_SB
#undef PG8_GLDS
#undef PG8_STAGE_B
#undef PG8_LDA
#undef PG8_LDB
#undef PG8_MMA
#undef PG8_WAIT_V
#undef PG8_WAIT_L
#undef PG8_BAR
#undef PG8_SCHED
#undef PG8_AOFF
}
}

constexpr size_t MiB = 1u << 20;
constexpr size_t WS_CTL = 0, CTL_ZERO_BYTES = 1 * MiB;
constexpr size_t WS_RWG = 1 * MiB;
constexpr size_t WS_KSUM = 1 * MiB + 512 * 1024;
constexpr size_t WS_ETOK = 2 * MiB;
constexpr size_t WS_EWT = 6 * MiB;
constexpr size_t WS_TOKSLOT = 10 * MiB;
constexpr size_t WS_COS = 11 * MiB, WS_SIN = 13 * MiB;
constexpr size_t WS_WCO = 16 * MiB, WS_WAO = 18 * MiB, WS_WOUT = 20 * MiB;
constexpr size_t WS_WIN = 24 * MiB;
constexpr size_t WS_WGU = 40 * MiB;
constexpr size_t WS_WD = 168 * MiB;
constexpr size_t WS_XN = 232 * MiB;
constexpr size_t WS_CB = 296 * MiB;
constexpr size_t WS_U = 360 * MiB;
constexpr size_t WS_Q = 424 * MiB;
constexpr size_t WS_K = 488 * MiB;
constexpr size_t WS_V = 552 * MiB;
constexpr size_t WS_GC = 616 * MiB;
constexpr size_t WS_GA = 680 * MiB;
constexpr size_t WS_PO = 744 * MiB;
constexpr size_t WS_PML = 936 * MiB;
constexpr size_t WS_ALIST = 952 * MiB;
constexpr size_t WS_ACT = 296 * MiB;
constexpr size_t WS_Y = 616 * MiB;
constexpr size_t WS_WIN8 = 104 * MiB;
constexpr size_t WS_WAO8 = 112 * MiB;
constexpr size_t WS_XN8 = 744 * MiB;
constexpr size_t WS_ERSTD = 986 * MiB;
constexpr size_t WS_SIDE_DUMMY = 990 * MiB;
constexpr size_t WS_END = 992 * MiB;
constexpr int CW_BAR = 4096;
constexpr int CW_ECNT = 8192;
constexpr int CW_ACNT = 16384;
constexpr int CW_DBG = 20000;

constexpr int RING_BYTES = 131072, LDSCTL_OFF = RING_BYTES, MISC_OFF = LDSCTL_OFF + 320, TAB_OFF = LDSCTL_OFF + 512, LDS_BYTES = 147456;

#define GAS __attribute__((address_space(1)))
#define LAS __attribute__((address_space(3)))
typedef unsigned short bf16;
typedef unsigned v4u __attribute__((ext_vector_type(4)));
typedef unsigned v2u __attribute__((ext_vector_type(2)));
typedef float f32x4 __attribute__((ext_vector_type(4)));
typedef float f32x16 __attribute__((ext_vector_type(16)));
typedef GAS unsigned gu32;
#define RLX_AGENT __ATOMIC_RELAXED, __HIP_MEMORY_SCOPE_AGENT
#define LDS_WAIT() asm volatile("s_waitcnt lgkmcnt(0)" ::: "memory")
#define VM_WAIT() asm volatile("s_waitcnt vmcnt(0)" ::: "memory")
using pg8::cvt_pk_bf16; using pg8::bf_lo; using pg8::bf_hi;

#define XB_TMO      128
#define XB_XCNT(j)  (256  + 64 * (j))
#define XB_XSUB(j)  (1280 + 64 * (j))
#define XB_XGEN(j)  (2304 + 64 * (j))
#define XB_TOP      3328
#define XB_TOPGEN   3392
#define XCD_BAR_WORDS 3456
#define XB_SPIN_CAP (1u << 18)
__device__ __forceinline__ unsigned xb_ld(unsigned* p)              { return __hip_atomic_load(p, __ATOMIC_RELAXED, __HIP_MEMORY_SCOPE_AGENT); }
__device__ __forceinline__ unsigned xb_add(unsigned* p, unsigned v) { return __hip_atomic_fetch_add(p, v, __ATOMIC_RELAXED, __HIP_MEMORY_SCOPE_AGENT); }
__device__ __forceinline__ unsigned xb_xcc_id() { return (unsigned)__builtin_amdgcn_s_getreg((3 << 11) | 20) & 0xFu; }
#define XB_SPIN(cond, bar) do { unsigned _sp = 0; while (cond) { __builtin_amdgcn_s_sleep(1); \
    if ((++_sp & 255u) == 0u) { if (xb_ld(&(bar)[XB_TMO])) break; if (_sp > XB_SPIN_CAP) { atomicAdd(&(bar)[XB_TMO], 1u); break; } } } } while (0)
struct XcdBarrier { unsigned* bar; unsigned x; volatile LAS unsigned* st; };
__device__ __forceinline__ XcdBarrier xcd_barrier_post(unsigned* bar, volatile LAS unsigned* st) {
    XcdBarrier b; b.bar = bar; b.x = xb_xcc_id(); b.st = st;
    if (threadIdx.x == 0) (void)xb_add(&bar[XB_XCNT(b.x)], 1u);
    return b;
}
__device__ __forceinline__ void xcd_barrier_complete(unsigned* bar, unsigned x, unsigned& nloc, unsigned& nx) {
    const unsigned G = gridDim.x * gridDim.y * gridDim.z;
    unsigned sum, cnt, mine, sp = 0u;
    for (;;) {
        sum = 0u; cnt = 0u; mine = 0u;
#pragma unroll
        for (unsigned j = 0; j < 16; ++j) { const unsigned c = xb_ld(&bar[XB_XCNT(j)]); sum += c; cnt += (c > 0u) ? 1u : 0u; mine = (j == x) ? c : mine; }
        if (sum == G) break;
        __builtin_amdgcn_s_sleep(1);
        if ((++sp & 255u) == 0u) { if (xb_ld(&bar[XB_TMO])) break; if (sp > XB_SPIN_CAP) { atomicAdd(&bar[XB_TMO], 1u); break; } }
    }
    nloc = mine > 0u ? mine : 1u; nx = cnt > 0u ? cnt : 1u;
}
__device__ __forceinline__ void xcd_barrier(const XcdBarrier& b) {
    asm volatile("s_waitcnt vmcnt(0)" ::: "memory");
    __syncthreads();
    if (threadIdx.x == 0) {
        unsigned* bar = b.bar;
        __builtin_amdgcn_s_waitcnt(0);
        unsigned nloc = b.st[0], nx = b.st[1];
        if (nloc == 0u) { xcd_barrier_complete(bar, b.x, nloc, nx); b.st[0] = nloc; b.st[1] = nx; }
        const unsigned old = xb_add(&bar[XB_XSUB(b.x)], 1u);
        const unsigned gen = old / nloc;
        if (old + 1u == (gen + 1u) * nloc) {
            __builtin_amdgcn_fence(__ATOMIC_RELEASE, "agent");
            asm volatile("s_waitcnt vmcnt(0)" ::: "memory");
            const unsigned og = xb_add(&bar[XB_TOP], 1u);
            const unsigned tg = og / nx;
            if (og + 1u == (tg + 1u) * nx) xb_add(&bar[XB_TOPGEN], 1u);
            else XB_SPIN(xb_ld(&bar[XB_TOPGEN]) == tg, bar);
            __builtin_amdgcn_fence(__ATOMIC_ACQUIRE, "agent");
            xb_add(&bar[XB_XGEN(b.x)], 1u);
            asm volatile("s_waitcnt vmcnt(0)" ::: "memory");
        } else {
            XB_SPIN(xb_ld(&bar[XB_XGEN(b.x)]) == gen, bar);
            __builtin_amdgcn_fence(__ATOMIC_ACQUIRE, "agent");
            asm volatile("s_waitcnt vmcnt(0)" ::: "memory");
        }
    }
    __syncthreads();
}

struct Frame {
    LAS unsigned char* lds;
    gu32* ctl;
    int tid, lane, wave, vcu, G;
    unsigned char* ws;
};
__device__ __forceinline__ float wave_sum(float v) {
#pragma unroll
    for (int o = 1; o < 64; o <<= 1) v += __shfl_xor(v, o);
    return v;
}

template <int MODE> __device__ __forceinline__ int dst_row(int n) {
    if (MODE == 1) {
        if (n < 1024) return n;
        if (n < 3072) { const int ch = (n - 1024) & 1023; return 1024 + (ch >> 7) * 256 + (n < 2048 ? 0 : 128) + (ch & 127); }
        if (n < 5120) { const int base = n < 4096 ? 3072 : 4096, r = n - base, h = r >> 6, d = r & 63; return base + 64 * h + 2 * (d & 31) + (d >> 5); }
        return n;
    }
    if (MODE == 2) return n < 1024 ? 2 * n : 2 * (n - 1024) + 1;
    if (MODE == 3) { const int ch = n & 1023; return (ch >> 7) * 256 + (n < 1024 ? 0 : 128) + (ch & 127); }
    return n;
}
template <int MODE> __device__ __forceinline__ void p0_transpose_item(const float* W, int K, int N, bf16* WT, const float* g, LAS float* scr, int item, int lane) {
    const int nblk = N / 32, kb = item / nblk, nb = item % nblk, k0 = 64 * kb, n0 = 32 * nb;
#pragma unroll 8
    for (int i = 0; i < 32; ++i) { const int kk = 2 * i + (lane >> 5); float v = W[(size_t)(k0 + kk) * N + n0 + (lane & 31)]; if (g) v *= g[k0 + kk]; scr[kk * 33 + (lane & 31)] = v; }
    LDS_WAIT(); asm volatile("" ::: "memory");
    const int c = lane & 7;
#pragma unroll
    for (int j = 0; j < 4; ++j) { const int n = (lane >> 3) + 8 * j; const LAS float* s = scr + (8 * c) * 33 + n;
        v4u o; o.x = cvt_pk_bf16(s[0 * 33], s[1 * 33]); o.y = cvt_pk_bf16(s[2 * 33], s[3 * 33]); o.z = cvt_pk_bf16(s[4 * 33], s[5 * 33]); o.w = cvt_pk_bf16(s[6 * 33], s[7 * 33]);
        *(GAS v4u*)(WT + (size_t)dst_row<MODE>(n0 + n) * K + k0 + 8 * c) = o; }
    LDS_WAIT(); asm volatile("" ::: "memory");
}

template <int MODE> __device__ __forceinline__ void p0_transpose_task(const float* W, int N, bf16* WT, const float* g, int task, int lane) {
    const int nblk = N / 64, kb = task / nblk, nb = task % nblk, kq = lane >> 4, n4 = lane & 15, k0 = 64 * kb + 16 * kq, n = 64 * nb + 4 * n4;
    const float* src = W + (size_t)k0 * N + n;
    f32x4 v[16];
#pragma unroll
    for (int i = 0; i < 16; ++i) v[i] = __builtin_nontemporal_load((const f32x4*)(src + (size_t)i * N));
    if (g) {
#pragma unroll
        for (int i = 0; i < 16; i += 4) { const f32x4 g4 = *(const f32x4*)(g + k0 + i); v[i] *= g4.x; v[i + 1] *= g4.y; v[i + 2] *= g4.z; v[i + 3] *= g4.w; }
    }
#pragma unroll
    for (int e = 0; e < 4; ++e) { bf16* dst = WT + (size_t)dst_row<MODE>(n + e) * 1024 + k0;
#pragma unroll
        for (int c = 0; c < 2; ++c) { v4u o; o.x = cvt_pk_bf16(v[8 * c][e], v[8 * c + 1][e]); o.y = cvt_pk_bf16(v[8 * c + 2][e], v[8 * c + 3][e]); o.z = cvt_pk_bf16(v[8 * c + 4][e], v[8 * c + 5][e]); o.w = cvt_pk_bf16(v[8 * c + 6][e], v[8 * c + 7][e]);
            *(GAS v4u*)(dst + 8 * c) = o; } }
}
template <int MODE> __device__ __forceinline__ void p0_transpose_task8(const float* W, int N, unsigned char* WT, const float* g, int task, int lane) {
    const int nblk = N / 64, kb = task / nblk, nb = task % nblk, kq = lane >> 4, n4 = lane & 15, k0 = 64 * kb + 16 * kq, n = 64 * nb + 4 * n4;
    const float* src = W + (size_t)k0 * N + n;
    f32x4 v[16];
#pragma unroll
    for (int i = 0; i < 16; ++i) v[i] = __builtin_nontemporal_load((const f32x4*)(src + (size_t)i * N));
#pragma unroll
    for (int i = 0; i < 16; i += 4) { f32x4 g4 = (f32x4){32.0f, 32.0f, 32.0f, 32.0f}; if (g) g4 = *(const f32x4*)(g + k0 + i) * 32.0f; v[i] *= g4.x; v[i + 1] *= g4.y; v[i + 2] *= g4.z; v[i + 3] *= g4.w; }
#pragma unroll
    for (int e = 0; e < 4; ++e) { unsigned char* dst = WT + (size_t)dst_row<MODE>(n + e) * 1024 + k0; v4u o;
#define PK8(j) ({ int w_ = 0; w_ = __builtin_amdgcn_cvt_pk_fp8_f32(v[4 * (j)][e], v[4 * (j) + 1][e], w_, false); w_ = __builtin_amdgcn_cvt_pk_fp8_f32(v[4 * (j) + 2][e], v[4 * (j) + 3][e], w_, true); (unsigned)w_; })
        o.x = PK8(0); o.y = PK8(1); o.z = PK8(2); o.w = PK8(3);
#undef PK8
        *(GAS v4u*)dst = o; }
}

using pg8::Unit; using pg8::bf16_t;
struct DensePol {
    static constexpr bool GATHER = false;
    const void* A; const void* Bt; int nM, nN, G, c; int esz  , split, off0, off1;
    __device__ __forceinline__ bool next(int i, Unit& u) const { u.e = 0; u.rt = 0; int j; if (!pg8::tile_order(i, G, c, nM, nN, u.pm, j)) return false; u.pn = j < split ? j + off0 : j + off1; return true; }
    __device__ __forceinline__ const char* a_base(const Unit& u) const { return (const char*)A + (size_t)u.pm * 256 * 1024 * esz; }
    __device__ __forceinline__ const char* b_base(const Unit& u) const { return (const char*)Bt + (size_t)u.pn * 256 * 1024 * esz; }
    __device__ __forceinline__ int gather(const Unit&, int) const { return 0; }
};
struct MoePol1 {
    static constexpr bool GATHER = true;
    const void* A; const void* Bt; const int* etok; const LAS int* tab; const LAS int* ul; int nul;
    __device__ __forceinline__ bool next(int i, Unit& u) const { if (i >= nul) return false; const LAS int* p = ul + 4 * i; u.pm = p[0]; u.pn = p[1]; u.e = p[2]; u.rt = p[3]; return true; }
    __device__ __forceinline__ const char* a_base(const Unit&) const { return (const char*)A; }
    __device__ __forceinline__ const char* b_base(const Unit& u) const { return (const char*)Bt + ((size_t)u.e * 2048 + (size_t)u.pn * 256) * 1024; }
    __device__ __forceinline__ int gather(const Unit& u, int r) const { const int pos = u.rt * 256 + r; return pos < tab[u.e] ? etok[u.e * 32768 + pos] : 0; }
};
struct MoePol2 {
    static constexpr bool GATHER = false;
    const void* A; const void* Bt; const LAS int* ul; int nul;
    __device__ __forceinline__ bool next(int i, Unit& u) const { const int k = i; if (k >= nul) return false; const LAS int* p = ul + 4 * k; u.pm = p[0]; u.pn = p[1]; u.e = p[2]; u.rt = p[3]; return true; }
    __device__ __forceinline__ const char* a_base(const Unit& u) const { return (const char*)A + (size_t)u.pm * 256 * 1024; }
    __device__ __forceinline__ const char* b_base(const Unit& u) const { return (const char*)Bt + ((size_t)u.e * 1024 + (size_t)u.pn * 256) * 1024; }
    __device__ __forceinline__ int gather(const Unit&, int) const { return 0; }
};

__device__ __forceinline__ int moe_unit_list(LAS int* ul, const LAS int* tab, int ncol, int G, int c, int tid) {
    const int T = tab[65], nun = T * ncol; const int nul = (c < nun) ? (nun - 1 - c) / G + 1 : 0;
    if (tid < nul && tid < 64) { int g, pn; pg8::tile_order(tid, G, c, T, ncol, g, pn); int e = 0;
        for (int k = 1; k < 32; ++k) e += (tab[32 + k] <= g) ? 1 : 0;
        ul[4 * tid + 0] = g; ul[4 * tid + 1] = pn; ul[4 * tid + 2] = e; ul[4 * tid + 3] = g - tab[32 + e]; }
    return nul < 64 ? nul : 64;
}

typedef pg8::f32x4 (AccT)[2][2][4][2];
__device__ __forceinline__ float sigmoidf_(float x) { return __builtin_amdgcn_rcpf(1.0f + __builtin_amdgcn_exp2f(x * -1.4426950408889634f)); }

struct EpiInProj {
    static constexpr bool PERM = true;
    bf16_t *CB, *U, *Q, *Kb, *V, *GC, *GA; const float* cosT; const float* sinT; float* ksum; float asc;
    __device__ __forceinline__ void operator()(const AccT& acc, const Unit& u, int wr, int wc, int fr, int fq) const {
        using pg8::u32x4; using pg8::u32x2; using pg8::f32x4;
        const int pn = u.pn, row0_ = u.pm * 256 + wr * 64 + fr, cl = wc * 32 + 8 * fq;
        int row0 = row0_;
        if (pn < 4 || (pn >= 20 && pn < 24)) {
            asm volatile("" : "+v"(row0));
            bf16_t* base = (pn < 4) ? CB : V; const int col0 = (pn & 3) * 256 + cl;
#pragma unroll
            for (int ai = 0; ai < 2; ++ai)
#pragma unroll
                for (int m = 0; m < 4; ++m) { bf16_t* rowp = base + (size_t)(row0 + ai * 128 + m * 16) * 1024 + col0;
#pragma unroll
                    for (int bj = 0; bj < 2; ++bj) { const f32x4 v0 = acc[ai][bj][m][0] * asc, v1 = acc[ai][bj][m][1] * asc; u32x4 w;
                        w.x = cvt_pk_bf16(v0[0], v0[1]); w.y = cvt_pk_bf16(v0[2], v0[3]); w.z = cvt_pk_bf16(v1[0], v1[1]); w.w = cvt_pk_bf16(v1[2], v1[3]);
                        *(u32x4*)(rowp + bj * 128) = w; } }
        } else if (pn >= 24) {
            asm volatile("" : "+v"(row0));
            bf16_t* base = (pn < 28) ? GC : GA; const int col0 = (pn & 3) * 256 + cl;
#pragma unroll
            for (int ai = 0; ai < 2; ++ai)
#pragma unroll
                for (int m = 0; m < 4; ++m) { bf16_t* rowp = base + (size_t)(row0 + ai * 128 + m * 16) * 1024 + col0;
#pragma unroll
                    for (int bj = 0; bj < 2; ++bj) { const f32x4 v0 = acc[ai][bj][m][0] * asc, v1 = acc[ai][bj][m][1] * asc; u32x4 w;
                        w.x = cvt_pk_bf16(sigmoidf_(v0[0]), sigmoidf_(v0[1])); w.y = cvt_pk_bf16(sigmoidf_(v0[2]), sigmoidf_(v0[3]));
                        w.z = cvt_pk_bf16(sigmoidf_(v1[0]), sigmoidf_(v1[1])); w.w = cvt_pk_bf16(sigmoidf_(v1[2]), sigmoidf_(v1[3]));
                        *(u32x4*)(rowp + bj * 128) = w; } }
        } else if (pn < 12) {
            asm volatile("" : "+v"(row0));
            const int ch0 = (pn - 4) * 128 + cl;
#pragma unroll
            for (int ai = 0; ai < 2; ++ai)
#pragma unroll
                for (int m = 0; m < 4; ++m) { bf16_t* rowp = U + (size_t)(row0 + ai * 128 + m * 16) * 1024 + ch0;
                    const f32x4 a0 = acc[ai][0][m][0], a1 = acc[ai][0][m][1], b0 = acc[ai][1][m][0], b1 = acc[ai][1][m][1]; u32x4 w;
                    w.x = cvt_pk_bf16(a0[0] * b0[0], a0[1] * b0[1]); w.y = cvt_pk_bf16(a0[2] * b0[2], a0[3] * b0[3]); w.z = cvt_pk_bf16(a1[0] * b1[0], a1[1] * b1[1]); w.w = cvt_pk_bf16(a1[2] * b1[2], a1[3] * b1[3]);
                    *(u32x4*)rowp = w; }
        } else {
            asm volatile("" : "+v"(row0));
            const bool isq = pn < 16; bf16_t* base = isq ? Q : Kb; const int col0 = (pn & 3) * 256 + cl; const float sc = (isq ? C2 : 1.0f) * asc;
            const int i0 = 16 * (wc & 1) + 4 * fq;
            float ks[2][8];
#pragma unroll
            for (int bj = 0; bj < 2; ++bj)
#pragma unroll
                for (int e = 0; e < 8; ++e) ks[bj][e] = 0.f;
#pragma unroll
            for (int ai = 0; ai < 2; ++ai) {
                f32x4 csv[4], snv[4];
#pragma unroll
                for (int m = 0; m < 4; ++m) { const int pos = (row0 + ai * 128 + m * 16) & (SEQ - 1); csv[m] = *(const f32x4*)(cosT + pos * 32 + i0); snv[m] = *(const f32x4*)(sinT + pos * 32 + i0); }
                asm volatile("" ::: "memory");
#pragma unroll
                for (int m = 0; m < 4; ++m)
#pragma unroll
                    for (int bj = 0; bj < 2; ++bj) { const int row = row0 + ai * 128 + m * 16;
                        const f32x4 cs = csv[m], sn = snv[m];
                        bf16_t* rowp = base + (size_t)row * 1024 + col0 + bj * 128;
                        const f32x4 v0 = acc[ai][bj][m][0], v1 = acc[ai][bj][m][1]; float o[8];
                        o[0] = (v0[0] * cs[0] - v0[1] * sn[0]) * sc; o[1] = (v0[1] * cs[0] + v0[0] * sn[0]) * sc;
                        o[2] = (v0[2] * cs[1] - v0[3] * sn[1]) * sc; o[3] = (v0[3] * cs[1] + v0[2] * sn[1]) * sc;
                        o[4] = (v1[0] * cs[2] - v1[1] * sn[2]) * sc; o[5] = (v1[1] * cs[2] + v1[0] * sn[2]) * sc;
                        o[6] = (v1[2] * cs[3] - v1[3] * sn[3]) * sc; o[7] = (v1[3] * cs[3] + v1[2] * sn[3]) * sc;
#pragma unroll
                        for (int e = 0; e < 8; ++e) { ks[bj][e] += o[e]; asm volatile("" : "+v"(ks[bj][e])); }
                        u32x4 w; w.x = cvt_pk_bf16(o[0], o[1]); w.y = cvt_pk_bf16(o[2], o[3]); w.z = cvt_pk_bf16(o[4], o[5]); w.w = cvt_pk_bf16(o[6], o[7]);
                        *(u32x4*)(rowp) = w; }
                asm volatile("" ::: "memory");
            }
            if (!isq) {
#pragma unroll
                for (int bj = 0; bj < 2; ++bj)
#pragma unroll
                    for (int e = 0; e < 8; ++e) { float s = ks[bj][e]; s += __shfl_xor(s, 1); s += __shfl_xor(s, 2); s += __shfl_xor(s, 4); s += __shfl_xor(s, 8);
                        if (fr == 0) atomicAdd(ksum + (size_t)u.pm * 1024 + col0 + bj * 128 + e, s); }
            }
        }
    }
};
template <int MODE> struct EpiGate {
    static constexpr bool PERM = true;
    const bf16_t* G; const bf16_t* T1in; bf16_t* O; float asc;
    __device__ __forceinline__ void operator()(const AccT& acc, const Unit& u, int wr, int wc, int fr, int fq) const {
        using pg8::u32x4; using pg8::f32x4;
        asm volatile("" : "+v"(fr), "+v"(fq));
        const int row0 = u.pm * 256 + wr * 64 + fr, col0 = u.pn * 256 + wc * 32 + 8 * fq;
#pragma unroll
        for (int ai = 0; ai < 2; ++ai) {
            u32x4 gg[4][2], tt[4][2];
#pragma unroll
            for (int m = 0; m < 4; ++m)
#pragma unroll
                for (int bj = 0; bj < 2; ++bj) { const size_t off = (size_t)(row0 + ai * 128 + m * 16) * 1024 + col0 + bj * 128;
                    gg[m][bj] = *(const u32x4*)(G + off); if (MODE == 1) tt[m][bj] = *(const u32x4*)(T1in + off); }
            asm volatile("" ::: "memory");
#pragma unroll
            for (int m = 0; m < 4; ++m)
#pragma unroll
                for (int bj = 0; bj < 2; ++bj) { const size_t off = (size_t)(row0 + ai * 128 + m * 16) * 1024 + col0 + bj * 128;
                    const f32x4 v0 = acc[ai][bj][m][0] * asc, v1 = acc[ai][bj][m][1] * asc; const u32x4 g = gg[m][bj]; float o[8];
                    o[0] = bf_lo(g.x) * v0[0]; o[1] = bf_hi(g.x) * v0[1]; o[2] = bf_lo(g.y) * v0[2]; o[3] = bf_hi(g.y) * v0[3];
                    o[4] = bf_lo(g.z) * v1[0]; o[5] = bf_hi(g.z) * v1[1]; o[6] = bf_lo(g.w) * v1[2]; o[7] = bf_hi(g.w) * v1[3];
                    if (MODE == 1) { const u32x4 t = tt[m][bj];
                        o[0] += bf_lo(t.x); o[1] += bf_hi(t.x); o[2] += bf_lo(t.y); o[3] += bf_hi(t.y); o[4] += bf_lo(t.z); o[5] += bf_hi(t.z); o[6] += bf_lo(t.w); o[7] += bf_hi(t.w); }
                    u32x4 w; w.x = cvt_pk_bf16(o[0], o[1]); w.y = cvt_pk_bf16(o[2], o[3]); w.z = cvt_pk_bf16(o[4], o[5]); w.w = cvt_pk_bf16(o[6], o[7]);
                    *(u32x4*)(O + off) = w; }
            asm volatile("" ::: "memory");
        }
    }
};
struct EpiResid {
    static constexpr bool PERM = false;
    const float* X; float* H;
    __device__ __forceinline__ void operator()(const AccT& acc, const Unit& u, int wr, int wc, int fr, int fq) const {
        using pg8::f32x4;
        asm volatile("" : "+v"(fr), "+v"(fq));
        const int row0 = u.pm * 256 + wr * 64 + fr, col0 = u.pn * 256 + wc * 32 + 4 * fq;
#pragma unroll
        for (int ai = 0; ai < 2; ++ai) {
            f32x4 xv[4][2][2];
#pragma unroll
            for (int m = 0; m < 4; ++m)
#pragma unroll
                for (int bj = 0; bj < 2; ++bj)
#pragma unroll
                    for (int n = 0; n < 2; ++n) xv[m][bj][n] = *(const f32x4*)(X + (size_t)(row0 + ai * 128 + m * 16) * 1024 + col0 + bj * 128 + n * 16);
            asm volatile("" ::: "memory");
#pragma unroll
            for (int m = 0; m < 4; ++m)
#pragma unroll
                for (int bj = 0; bj < 2; ++bj)
#pragma unroll
                    for (int n = 0; n < 2; ++n) *(f32x4*)(H + (size_t)(row0 + ai * 128 + m * 16) * 1024 + col0 + bj * 128 + n * 16) = xv[m][bj][n] + acc[ai][bj][m][n];
            asm volatile("" ::: "memory");
        }
    }
};
struct EpiSwiglu {
    static constexpr bool PERM = true;
    const float* bgu; const float* erstd; unsigned char* ACT;
    __device__ __forceinline__ float act1(float g, float up) const { g = fminf(g, 7.0f); up = fminf(fmaxf(up, -7.0f), 7.0f); return (up + 1.0f) * (g * sigmoidf_(1.702f * g)); }
    __device__ __forceinline__ void operator()(const AccT& acc, const Unit& u, int wr, int wc, int fr, int fq) const {
        using pg8::u32x2; using pg8::f32x4;
        asm volatile("" : "+v"(fr), "+v"(fq));
        const int row0 = u.pm * 256 + wr * 64 + fr, ch0 = u.pn * 128 + wc * 32 + 8 * fq;
        const float* bg = bgu + (size_t)u.e * 2048; const float* rsp = erstd + (size_t)u.e * 32768 + u.rt * 256 + wr * 64 + fr;
        f32x4 bgv[2], buv[2];
#pragma unroll
        for (int n = 0; n < 2; ++n) { bgv[n] = *(const f32x4*)(bg + ch0 + 4 * n); buv[n] = *(const f32x4*)(bg + 1024 + ch0 + 4 * n); }
        float rss[2][4];
#pragma unroll
        for (int ai = 0; ai < 2; ++ai)
#pragma unroll
            for (int m = 0; m < 4; ++m) rss[ai][m] = rsp[ai * 128 + m * 16];
        asm volatile("" ::: "memory");
#pragma unroll
        for (int ai = 0; ai < 2; ++ai)
#pragma unroll
            for (int m = 0; m < 4; ++m) { unsigned char* rowp = ACT + (size_t)(row0 + ai * 128 + m * 16) * 1024 + ch0; const float rs = rss[ai][m] * (1.0f / 32.0f);
                float a8[8];
#pragma unroll
                for (int n = 0; n < 2; ++n) { const f32x4 g4 = acc[ai][0][m][n] * rs + bgv[n], u4 = acc[ai][1][m][n] * rs + buv[n];
                    a8[4 * n + 0] = act1(g4[0], u4[0]); a8[4 * n + 1] = act1(g4[1], u4[1]); a8[4 * n + 2] = act1(g4[2], u4[2]); a8[4 * n + 3] = act1(g4[3], u4[3]); }
                int w0 = 0, w1 = 0;
                w0 = __builtin_amdgcn_cvt_pk_fp8_f32(a8[0], a8[1], w0, false); w0 = __builtin_amdgcn_cvt_pk_fp8_f32(a8[2], a8[3], w0, true);
                w1 = __builtin_amdgcn_cvt_pk_fp8_f32(a8[4], a8[5], w1, false); w1 = __builtin_amdgcn_cvt_pk_fp8_f32(a8[6], a8[7], w1, true);
                u32x2 w; w.x = (unsigned)w0; w.y = (unsigned)w1; *(u32x2*)rowp = w; }
    }
};
struct EpiDown {
    static constexpr bool PERM = true;
    const float* bd; const float* ewt; unsigned char* Y;
    __device__ __forceinline__ void operator()(const AccT& acc, const Unit& u, int wr, int wc, int fr, int fq) const {
        using pg8::u32x4; using pg8::f32x4;
        asm volatile("" : "+v"(fr), "+v"(fq));
        const int rl0 = wr * 64 + fr, col0 = u.pn * 256 + wc * 32 + 8 * fq;
        const float* b = bd + (size_t)u.e * 1024 + col0; const float* wp = ewt + (size_t)u.e * 32768 + u.rt * 256 + rl0;
        f32x4 bv[2][2]; float wts[2][4];
#pragma unroll
        for (int bj = 0; bj < 2; ++bj)
#pragma unroll
            for (int n = 0; n < 2; ++n) bv[bj][n] = *(const f32x4*)(b + bj * 128 + 4 * n);
#pragma unroll
        for (int ai = 0; ai < 2; ++ai)
#pragma unroll
            for (int m = 0; m < 4; ++m) wts[ai][m] = wp[ai * 128 + m * 16];
        asm volatile("" ::: "memory");
#pragma unroll
        for (int ai = 0; ai < 2; ++ai)
#pragma unroll
            for (int m = 0; m < 4; ++m) { const int rl = rl0 + ai * 128 + m * 16; const float wt = wts[ai][m] * 16.0f; unsigned char* rowp = Y + (size_t)(u.pm * 256 + rl) * 1024 + col0;
#pragma unroll
                for (int bj = 0; bj < 2; ++bj) { const f32x4 v0 = (acc[ai][bj][m][0] * (1.0f / 32.0f) + bv[bj][0]) * wt, v1 = (acc[ai][bj][m][1] * (1.0f / 32.0f) + bv[bj][1]) * wt;
                    int w0 = 0, w1 = 0; w0 = __builtin_amdgcn_cvt_pk_fp8_f32(v0[0], v0[1], w0, false); w0 = __builtin_amdgcn_cvt_pk_fp8_f32(v0[2], v0[3], w0, true);
                    w1 = __builtin_amdgcn_cvt_pk_fp8_f32(v1[0], v1[1], w1, false); w1 = __builtin_amdgcn_cvt_pk_fp8_f32(v1[2], v1[3], w1, true);
                    pg8::u32x2 w; w.x = (unsigned)w0; w.y = (unsigned)w1; *(pg8::u32x2*)(rowp + bj * 128) = w; } }
    }
};

typedef short bf16x8_t __attribute__((ext_vector_type(8)));
typedef short s16x4_t __attribute__((ext_vector_type(4)));
typedef short v4i16_t __attribute__((ext_vector_type(4)));
__device__ __forceinline__ int crow(int r, int hi) { return (r & 3) + 8 * (r >> 2) + 4 * hi; }
__device__ __forceinline__ s16x4_t vtr(const LAS unsigned char* p) { return __builtin_bit_cast(s16x4_t, __builtin_amdgcn_ds_read_tr16_b64_v4i16((LAS v4i16_t*)p)); }
constexpr int ATT_K = 0, ATT_V = 32768, ATT_Q = 65536, ATT_STG = 98304;
constexpr int UMETA_OFF = LDSCTL_OFF + 1024, WSC_OFF = LDSCTL_OFF + 2048;
constexpr int ALIST_BH = 256 * 2016;
__device__ __forceinline__ int alist_off(int j) { return 256 * (63 * j - (j * (j - 1)) / 2); }
__device__ __forceinline__ void attn_dma_k(LAS unsigned char* lds, const bf16* Kb, size_t rowbase, int h, int wave, int lane) {
#pragma unroll
    for (int i = 0; i < 4; ++i) { const bf16* ks = Kb + (rowbase + (size_t)(i * 64 + lane)) * 1024 + h * 64 + wave * 8;
        __builtin_amdgcn_global_load_lds((const unsigned*)ks, (LAS unsigned*)(lds + ATT_K + wave * 4096 + i * 1024), 16, 0, 0); }
}
__device__ __forceinline__ void attn_dma_v(LAS unsigned char* lds, const bf16* Vb, size_t rowbase, int h, int wave, int lane) {
#pragma unroll
    for (int i = 0; i < 4; ++i) { const int vi = wave * 4 + i, dh = vi >> 4, kg = vi & 15;
        const bf16* vs = Vb + (rowbase + (size_t)(kg * 16 + (lane >> 2))) * 1024 + h * 64 + dh * 32 + (lane & 3) * 8;
        __builtin_amdgcn_global_load_lds((const unsigned*)vs, (LAS unsigned*)(lds + ATT_V + dh * 16384 + kg * 1024), 16, 0, 0); }
}
__device__ __forceinline__ void attn_dma_q(LAS unsigned char* lds, const bf16* qrowp, int wave, int lane) {
#pragma unroll
    for (int i = 0; i < 4; ++i)
        __builtin_amdgcn_global_load_lds((const unsigned*)(qrowp + (2 * i + (lane >> 5)) * 8), (LAS unsigned*)(lds + ATT_Q + wave * 4096 + i * 1024), 16, 0, 0);
}
#define ATT_QKT(s, qr, nkt) do { _Pragma("unroll") for (int kt = 0; kt < 8; ++kt) { \
        if (kt < (nkt)) { s[kt] = (f32x16){0.f,0.f,0.f,0.f,0.f,0.f,0.f,0.f,0.f,0.f,0.f,0.f,0.f,0.f,0.f,0.f}; \
            _Pragma("unroll") for (int d0 = 0; d0 < 4; ++d0) { const bf16x8_t kf = *(const LAS bf16x8_t*)(F.lds + ATT_K + (2 * d0 + hi) * 4096 + (kt * 32 + r32) * 16); \
                s[kt] = __builtin_amdgcn_mfma_f32_32x32x16_bf16(kf, qr[d0], s[kt], 0, 0, 0); } } \
        else { _Pragma("unroll") for (int r = 0; r < 16; ++r) s[kt][r] = -INFINITY; } } } while (0)
#define ATT_PV(o, s, nkt) do { _Pragma("unroll") for (int kt = 0; kt < 8; ++kt) { if (kt < (nkt)) { _Pragma("unroll") for (int k2 = 0; k2 < 2; ++k2) { \
        v4u pw; pw.x = cvt_pk_bf16(s[kt][8 * k2 + 0], s[kt][8 * k2 + 1]); pw.y = cvt_pk_bf16(s[kt][8 * k2 + 2], s[kt][8 * k2 + 3]); \
        pw.z = cvt_pk_bf16(s[kt][8 * k2 + 4], s[kt][8 * k2 + 5]); pw.w = cvt_pk_bf16(s[kt][8 * k2 + 6], s[kt][8 * k2 + 7]); \
        const bf16x8_t pa = __builtin_bit_cast(bf16x8_t, pw); \
        _Pragma("unroll") for (int dh = 0; dh < 2; ++dh) { const LAS unsigned char* vp = vb + dh * 16384 + (kt * 2 + k2) * 1024; \
            const s16x4_t lo = vtr(vp), hi4 = vtr(vp + 512); \
            const bf16x8_t vf = (bf16x8_t){lo[0], lo[1], lo[2], lo[3], hi4[0], hi4[1], hi4[2], hi4[3]}; \
            o[dh] = __builtin_amdgcn_mfma_f32_32x32x16_bf16(pa, vf, o[dh], 0, 0, 0); } } } } } while (0)

constexpr int SIDE_GU = 32 * 64 * 32, SIDE_D = 32 * 64 * 16, SIDE_TASKS = SIDE_GU + SIDE_D;
struct SideSrc { const float* src; int N; };
__device__ __forceinline__ void side_issue(int task, const float* w_gu, const float* w_d, int lane, float (&sv)[16]) {
    const float* src; int N;
    if (task < SIDE_GU) { const int e = task >> 11, r = task & 2047, kb = r >> 5, nb = r & 31; N = 2048; src = w_gu + (size_t)e * 1024 * 2048 + (size_t)(kb * 16) * 2048 + nb * 64 + lane; }
    else { const int t2 = task - SIDE_GU, e = t2 >> 10, r = t2 & 1023, kb = r >> 4, nb = r & 15; N = 1024; src = w_d + (size_t)e * 1024 * 1024 + (size_t)(kb * 16) * 1024 + nb * 64 + lane; }
#pragma unroll
    for (int i = 0; i < 16; ++i) sv[i] = __builtin_nontemporal_load(src + (size_t)i * N);
}
__device__ __forceinline__ void side_finish(int task, bool real, unsigned char* dummy, unsigned char* Wgu8, unsigned char* Wd8, int lane, const float (&sv)[16]) {
    unsigned char* dst;
    if (task < SIDE_GU) { const int e = task >> 11, r = task & 2047, kb = r >> 5, nb = r & 31, n = nb * 64 + lane; dst = Wgu8 + ((size_t)e * 2048 + dst_row<3>(n)) * 1024 + kb * 16; }
    else { const int t2 = task - SIDE_GU, e = t2 >> 10, r = t2 & 1023, kb = r >> 4, nb = r & 15, n = nb * 64 + lane; dst = Wd8 + ((size_t)e * 1024 + n) * 1024 + kb * 16; }
    v4u o;
#define PK8(j) ({ int w_ = 0; w_ = __builtin_amdgcn_cvt_pk_fp8_f32(sv[4 * (j)] * 32.0f, sv[4 * (j) + 1] * 32.0f, w_, false); w_ = __builtin_amdgcn_cvt_pk_fp8_f32(sv[4 * (j) + 2] * 32.0f, sv[4 * (j) + 3] * 32.0f, w_, true); (unsigned)w_; })
    o.x = PK8(0); o.y = PK8(1); o.z = PK8(2); o.w = PK8(3);
#undef PK8
    if (!real) dst = dummy + lane * 16;
    *(GAS v4u*)dst = o;
}

#define ATT_WB(wait) asm volatile("s_waitcnt " wait "\n\ts_barrier" ::: "memory")
template <bool OWN>
__device__ __forceinline__ void attn_phase(Frame& F, const bf16* Qb, const bf16* Kb, const bf16* Vb, bf16* PO, float* PML, const unsigned short* alist, gu32* acnt, bf16* ATTO,
                                           const float* w_gu, const float* w_d, const float* g_ffn, unsigned char* Wgu8, unsigned char* Wd8) {
    const int r32 = F.lane & 31, hi = F.lane >> 5, wave = F.wave;
    LAS int* um = (LAS int*)(F.lds + UMETA_OFF);
    LAS float* wsc = (LAS float*)(F.lds + WSC_OFF + wave * 1024);
    const LAS unsigned char* vb = F.lds + ATT_V + ((F.lane >> 4) & 1) * 32 + (F.lane & 3) * 8 + (4 * hi + ((F.lane & 15) >> 2)) * 64;
    int nul = 0;
    __syncthreads();
    if (!OWN) {
        LAS int* pfx = (LAS int*)(F.lds + ATT_STG);
        int c4[4]; int sum = 0;
#pragma unroll
        for (int i = 0; i < 4; ++i) { c4[i] = ((int)__hip_atomic_load(acnt + F.tid * 4 + i, RLX_AGENT) + 255) >> 8; sum += c4[i]; }
        int inc = sum;
#pragma unroll
        for (int o = 1; o < 64; o <<= 1) { const int v = __shfl_up(inc, o); if (F.lane >= o) inc += v; }
        LAS int* wt = pfx + 2064;
        if (F.lane == 63) wt[wave] = inc;
        __syncthreads();
        int base = 0;
        for (int w = 0; w < wave; ++w) base += wt[w];
        int ex = base + inc - sum;
#pragma unroll
        for (int i = 0; i < 4; ++i) { pfx[F.tid * 4 + i] = ex; ex += c4[i]; }
        if (F.tid == 511) pfx[2048] = ex;
        __syncthreads();
        const int NU = pfx[2048];
        const int u0 = (int)(((long)blockIdx.x * NU) / F.G), u1 = (int)(((long)(blockIdx.x + 1) * NU) / F.G);
        nul = u1 - u0; if (nul > 64) nul = 64;
        if (F.tid < nul) { const int u = u0 + F.tid; int lo_ = 0, hi_ = 2048;
            while (hi_ - lo_ > 1) { const int mid = (lo_ + hi_) >> 1; if (pfx[mid] <= u) lo_ = mid; else hi_ = mid; }
            const int chunk = u - pfx[lo_], cnt = (int)__hip_atomic_load(acnt + lo_, RLX_AGENT), rem = cnt - chunk * 256;
            um[F.tid * 4 + 0] = lo_; um[F.tid * 4 + 1] = chunk; um[F.tid * 4 + 2] = rem < 256 ? rem : 256; }
    } else {
        nul = ((int)blockIdx.x < 2048) ? (2047 - (int)blockIdx.x) / F.G + 1 : 0; if (nul > 64) nul = 64;
        if (F.tid < nul) { const int u = (int)blockIdx.x + F.tid * F.G; um[F.tid * 4 + 0] = u; um[F.tid * 4 + 1] = 0; um[F.tid * 4 + 2] = 256; }
    }
    __syncthreads();
    unsigned char* dummy = Wd8 + (size_t)(WS_SIDE_DUMMY - WS_WD) + (size_t)(F.vcu * 8 + wave) * 1024;
    int st_next = OWN ? SIDE_TASKS : (F.vcu * 8 + wave), st_cur = -1, st_cur1 = -1; const int st_step = F.G * 8; float sv[16], sv1[16];
    if (nul > 0) {
#define ATT_ENT(k) (OWN ? (unsigned)((((um[(k) * 4] & 63) * 256 + wave * 32 + r32) << 2) | 3) \
                        : (unsigned)alist[(size_t)(um[(k) * 4] >> 6) * ALIST_BH + alist_off(um[(k) * 4] & 63) + um[(k) * 4 + 1] * 256 + wave * 32 + r32])
#define ATT_ROWBASE(k) ((size_t)(um[(k) * 4] >> 10) * SEQ + (size_t)(um[(k) * 4] & 63) * 256)
#define ATT_H(k) ((um[(k) * 4] >> 6) & 15)
#define ATT_B(k) (um[(k) * 4] >> 10)
    unsigned ent0 = ATT_ENT(0), ent1 = (nul > 1) ? ATT_ENT(1) : 0u;
    attn_dma_k(F.lds, Kb, ATT_ROWBASE(0), ATT_H(0), wave, F.lane);
    attn_dma_q(F.lds, Qb + ((size_t)ATT_B(0) * SEQ + (ent0 >> 2)) * 1024 + ATT_H(0) * 64, wave, F.lane);
    asm volatile("" ::: "memory");
    attn_dma_v(F.lds, Vb, ATT_ROWBASE(0), ATT_H(0), wave, F.lane);
    for (int k = 0; k < nul; ++k) {
        const int b = ATT_B(k), h = ATT_H(k), jb = um[k * 4] & 63, nh = um[k * 4 + 2];
        const int t = (int)(ent0 >> 2), slot = (int)(ent0 & 3); const size_t qrow = (size_t)b * SEQ + t;
        const int qi = wave * 32 + r32; const bool valid = qi < nh;
        const bool same_prev = !OWN && k > 0 && um[(k - 1) * 4] == um[k * 4], same_next = !OWN && k + 1 < nul && um[(k + 1) * 4] == um[k * 4];
        if (!same_prev) { ATT_WB("vmcnt(4)"); }
        else { asm volatile("s_waitcnt vmcnt(0)" ::: "memory"); }
        bf16x8_t qr[4];
#pragma unroll
        for (int d0 = 0; d0 < 4; ++d0) qr[d0] = *(const LAS bf16x8_t*)(F.lds + ATT_Q + wave * 4096 + (2 * d0 + hi) * 512 + r32 * 16);
        int k2 = (k + 2 < nul) ? k + 2 : nul - 1; asm volatile("" : "+s"(k2));
        unsigned ent2 = OWN ? ((k + 2 < nul) ? ATT_ENT(k + 2) : 0u) : ATT_ENT(k2);
        bool st_r0 = false, st_r1 = false;
        if (!OWN) { st_r0 = st_next < SIDE_TASKS; st_cur = st_r0 ? st_next : SIDE_TASKS - 1; if (st_r0) st_next += st_step; side_issue(st_cur, w_gu, w_d, F.lane, sv);
            st_r1 = st_next < SIDE_TASKS; st_cur1 = st_r1 ? st_next : SIDE_TASKS - 1; if (st_r1) st_next += st_step; side_issue(st_cur1, w_gu, w_d, F.lane, sv1); }
        const int nv = OWN ? (jb < 3 ? jb : 3) : 0;
        const bool active = wave * 32 < nh;
        const int nkt = OWN ? wave + 1 : 8;
        f32x16 s[8];
        if (active) { ATT_QKT(s, qr, nkt); }
        if (!same_prev || !same_next) { if (OWN) { ATT_WB("vmcnt(0) lgkmcnt(0)"); } else { ATT_WB("vmcnt(33) lgkmcnt(0)"); } }
        else { asm volatile("s_waitcnt lgkmcnt(0)" ::: "memory"); }
        if (k + 1 < nul) { int ln_ = F.lane; asm volatile("" : "+v"(ln_)); if (!same_next) attn_dma_k(F.lds, Kb, ATT_ROWBASE(k + 1), ATT_H(k + 1), wave, ln_);
            attn_dma_q(F.lds, Qb + ((size_t)ATT_B(k + 1) * SEQ + (ent1 >> 2)) * 1024 + ATT_H(k + 1) * 64, wave, ln_); }
        float mx = -INFINITY, l = 0.f;
        f32x16 o[2]; o[0] = (f32x16){0.f,0.f,0.f,0.f,0.f,0.f,0.f,0.f,0.f,0.f,0.f,0.f,0.f,0.f,0.f,0.f}; o[1] = o[0];
        if (active) {
            if (OWN) {
#pragma unroll
                for (int kt = 0; kt < 8; ++kt) if (kt == wave) {
#pragma unroll
                    for (int r = 0; r < 16; ++r) s[kt][r] = (crow(r, hi) > r32) ? -INFINITY : s[kt][r]; }
            }
#pragma unroll
            for (int kt = 0; kt < 8; ++kt)
#pragma unroll
                for (int r = 0; r < 16; ++r) mx = fmaxf(mx, s[kt][r]);
            mx = fmaxf(mx, __shfl_xor(mx, 32));
            {
                typedef float f32x2_ __attribute__((ext_vector_type(2)));
                const f32x2_ nm = (f32x2_){-mx, -mx}; f32x2_ l2 = (f32x2_){0.f, 0.f};
#pragma unroll
                for (int kt = 0; kt < 8; ++kt)
#pragma unroll
                    for (int r = 0; r < 16; r += 2) { f32x2_ d = (f32x2_){s[kt][r], s[kt][r + 1]} + nm; d.x = __builtin_amdgcn_exp2f(d.x); d.y = __builtin_amdgcn_exp2f(d.y); s[kt][r] = d.x; s[kt][r + 1] = d.y; l2 += d; }
                l = l2.x + l2.y;
            }
            l += __shfl_xor(l, 32);
            ATT_PV(o, s, nkt);
        }
        if (!same_next) { ATT_WB("lgkmcnt(0)"); }
        else { asm volatile("s_waitcnt lgkmcnt(0)" ::: "memory"); }
        if (!OWN) { side_finish(st_cur, st_r0, dummy, Wgu8, Wd8, F.lane, sv); side_finish(st_cur1, st_r1, dummy, Wgu8, Wd8, F.lane, sv1); asm volatile("" ::: "memory"); }
        if (active) {
            LAS bf16* stg = (LAS bf16*)(F.lds + ATT_STG + wave * 4096);
            if (!OWN) {
                if (hi == 0) { wsc[r32] = 1.0f / l; ((LAS int*)wsc)[32 + r32] = valid ? (int)((qrow * 16 + h) * 3 + slot) : -1;
                    if (valid) { float* pm = PML + ((qrow * 16 + h) * 3 + slot) * 2; pm[0] = mx; pm[1] = l; } }
                LDS_WAIT(); asm volatile("" ::: "memory");
#pragma unroll
                for (int r = 0; r < 16; ++r) { const int orow = crow(r, hi); const float rl = wsc[orow];
#pragma unroll
                    for (int dh = 0; dh < 2; ++dh) stg[orow * 64 + dh * 32 + r32] = (bf16)(cvt_pk_bf16(o[dh][r] * rl, 0.f) & 0xffffu); }
                LDS_WAIT(); asm volatile("" ::: "memory");
#pragma unroll
                for (int i = 0; i < 4; ++i) { const int row = i * 8 + (F.lane >> 3), ch = F.lane & 7; const int pidx = ((LAS int*)wsc)[32 + row];
                    const v4u v = *(const LAS v4u*)(stg + row * 64 + ch * 8);
                    if (pidx >= 0) *(GAS v4u*)(PO + (size_t)pidx * 64 + ch * 8) = v; }
            } else {
                float pm_[3], pl_[3];
#pragma unroll
                for (int i = 0; i < 3; ++i) { pm_[i] = -INFINITY; pl_[i] = 0.f; if (i < nv) { const float* pm = PML + ((qrow * 16 + h) * 3 + i) * 2; pm_[i] = pm[0]; pl_[i] = pm[1]; } }
                float Mx = mx;
#pragma unroll
                for (int i = 0; i < 3; ++i) Mx = fmaxf(Mx, pm_[i]);
                const float aown = __builtin_amdgcn_exp2f(mx - Mx); float W = l * aown; float wi[3];
#pragma unroll
                for (int i = 0; i < 3; ++i) { wi[i] = pl_[i] * __builtin_amdgcn_exp2f(pm_[i] - Mx); W += wi[i]; }
                const float rW = 1.0f / W;
                if (hi == 0) { wsc[r32 * 4 + 0] = aown * rW; wsc[r32 * 4 + 1] = wi[0] * rW; wsc[r32 * 4 + 2] = wi[1] * rW; wsc[r32 * 4 + 3] = wi[2] * rW; }
                LDS_WAIT(); asm volatile("" ::: "memory");
#pragma unroll
                for (int r = 0; r < 16; ++r) { const int orow = crow(r, hi); const float c0 = wsc[orow * 4];
#pragma unroll
                    for (int dh = 0; dh < 2; ++dh) stg[orow * 64 + dh * 32 + r32] = (bf16)(cvt_pk_bf16(o[dh][r] * c0, 0.f) & 0xffffu); }
                LDS_WAIT(); asm volatile("" ::: "memory");
                const size_t grow0 = (size_t)b * SEQ + jb * 256 + wave * 32;
                v4u pp[4][3];
#pragma unroll
                for (int i = 0; i < 4; ++i)
#pragma unroll
                    for (int sl = 0; sl < 3; ++sl) { pp[i][sl] = (v4u){0u, 0u, 0u, 0u};
                        if (sl < nv) pp[i][sl] = *(const GAS v4u*)(PO + (((grow0 + i * 8 + (F.lane >> 3)) * 16 + h) * 3 + sl) * 64 + (F.lane & 7) * 8); }
#pragma unroll
                for (int i = 0; i < 4; ++i) { const int row = i * 8 + (F.lane >> 3), ch = F.lane & 7;
                    const v4u ov = *(const LAS v4u*)(stg + row * 64 + ch * 8);
                    float a8[8] = {bf_lo(ov.x), bf_hi(ov.x), bf_lo(ov.y), bf_hi(ov.y), bf_lo(ov.z), bf_hi(ov.z), bf_lo(ov.w), bf_hi(ov.w)};
#pragma unroll
                    for (int sl = 0; sl < 3; ++sl) { const float c = wsc[row * 4 + 1 + sl]; const v4u pv = pp[i][sl];
                        a8[0] += c * bf_lo(pv.x); a8[1] += c * bf_hi(pv.x); a8[2] += c * bf_lo(pv.y); a8[3] += c * bf_hi(pv.y);
                        a8[4] += c * bf_lo(pv.z); a8[5] += c * bf_hi(pv.z); a8[6] += c * bf_lo(pv.w); a8[7] += c * bf_hi(pv.w); }
                    int w0 = 0, w1 = 0; w0 = __builtin_amdgcn_cvt_pk_fp8_f32(a8[0] * 16.f, a8[1] * 16.f, w0, false); w0 = __builtin_amdgcn_cvt_pk_fp8_f32(a8[2] * 16.f, a8[3] * 16.f, w0, true);
                    w1 = __builtin_amdgcn_cvt_pk_fp8_f32(a8[4] * 16.f, a8[5] * 16.f, w1, false); w1 = __builtin_amdgcn_cvt_pk_fp8_f32(a8[6] * 16.f, a8[7] * 16.f, w1, true);
                    v2u w; w.x = (unsigned)w0; w.y = (unsigned)w1; *(GAS v2u*)((unsigned char*)ATTO + (grow0 + row) * 1024 + h * 64 + ch * 8) = w; }
            }
        }
        asm volatile("" ::: "memory");
        if (k + 1 < nul && !same_next) { int ln_ = F.lane; asm volatile("" : "+v"(ln_)); attn_dma_v(F.lds, Vb, ATT_ROWBASE(k + 1), ATT_H(k + 1), wave, ln_); }
        else if (k + 1 >= nul) { asm volatile("s_waitcnt vmcnt(0)" ::: "memory"); }
        ent0 = ent1; ent1 = ent2;
    }
    }
    asm volatile("s_waitcnt vmcnt(0) lgkmcnt(0)" ::: "memory");
    if (!OWN) { for (; st_next < SIDE_TASKS; st_next += 2 * st_step) { side_issue(st_next, w_gu, w_d, F.lane, sv); const bool two = st_next + st_step < SIDE_TASKS; if (two) side_issue(st_next + st_step, w_gu, w_d, F.lane, sv1);
            side_finish(st_next, true, dummy, Wgu8, Wd8, F.lane, sv); if (two) side_finish(st_next + st_step, true, dummy, Wgu8, Wd8, F.lane, sv1); } }
    asm volatile("s_waitcnt vmcnt(0) lgkmcnt(0)" ::: "memory");
    __syncthreads();
#undef ATT_ENT
#undef ATT_ROWBASE
#undef ATT_H
#undef ATT_B
}

#define DECL_PTRS() int z_ = 0; asm volatile("" : "+s"(z_)); unsigned char* ws = args.ws + z_; const float* x = args.in[0 + z_]; const float* g_mix = args.in[1 + z_]; const float* w_in = args.in[2 + z_]; const float* conv_w = args.in[3 + z_]; const float* w_co = args.in[4 + z_]; const float* w_ao = args.in[5 + z_]; const float* w_out = args.in[6 + z_]; const float* g_ffn = args.in[7 + z_]; const float* router_w = args.in[8 + z_]; const float* router_b = args.in[9 + z_]; const float* w_gu = args.in[10 + z_]; const float* b_gu = args.in[11 + z_]; const float* w_d = args.in[12 + z_]; const float* b_d = args.in[13 + z_]; const float* g_fin = args.in[14 + z_]; float* out = args.out + z_; bf16* Win_t = (bf16*)(ws + WS_WIN); bf16* Wco_t = (bf16*)(ws + WS_WCO); bf16* Wao_t = (bf16*)(ws + WS_WAO); bf16* Wout_t = (bf16*)(ws + WS_WOUT); bf16* Wgu_t = (bf16*)(ws + WS_WGU); bf16* Wd_t = (bf16*)(ws + WS_WD); bf16* XN = (bf16*)(ws + WS_XN); bf16* CB = (bf16*)(ws + WS_CB); bf16* U = (bf16*)(ws + WS_U); bf16* Qb = (bf16*)(ws + WS_Q); bf16* Kb = (bf16*)(ws + WS_K); bf16* Vb = (bf16*)(ws + WS_V); bf16* GC = (bf16*)(ws + WS_GC); bf16* GA = (bf16*)(ws + WS_GA); bf16* T1 = U; bf16* MERGED = Qb; bf16* ATTO = XN; bf16* HN = XN; bf16* ACT = (bf16*)(ws + WS_ACT); bf16* Y = (bf16*)(ws + WS_Y); float* cosT = (float*)(ws + WS_COS); float* sinT = (float*)(ws + WS_SIN); float* ksum = (float*)(ws + WS_KSUM); float* rwg = (float*)(ws + WS_RWG); bf16* PO = (bf16*)(ws + WS_PO); float* PML = (float*)(ws + WS_PML); unsigned short* alist = (unsigned short*)(ws + WS_ALIST); gu32* acnt = F.ctl + CW_ACNT; int* etok = (int*)(ws + WS_ETOK); float* ewt = (float*)(ws + WS_EWT); float* erstd = (float*)(ws + WS_ERSTD); (void)erstd; unsigned char* Win8 = ws + WS_WIN8; unsigned char* Wao8 = ws + WS_WAO8; unsigned char* XN8 = ws + WS_XN8; (void)Win8; (void)Wao8; (void)XN8; int* tokslot = (int*)(ws + WS_TOKSLOT); (void)x; (void)out;
struct Args { const float* in[15]; float* out; unsigned char* ws; int ph_lo, ph_hi; };
constexpr int NPHASE = 11;

__global__ void __launch_bounds__(512, 2) fwd_kernel(Args args) {
    extern __shared__ __attribute__((aligned(16))) unsigned char lds_raw[];
    Frame F;
    F.lds = (LAS unsigned char*)lds_raw;
    F.tid = threadIdx.x; F.lane = F.tid & 63; F.wave = __builtin_amdgcn_readfirstlane(F.tid >> 6);
    F.G = gridDim.x; { const int bx = blockIdx.x; F.vcu = (F.G % 8 == 0) ? (bx % 8) * (F.G / 8) + bx / 8 : bx; }
    F.ws = args.ws; F.ctl = (gu32*)(args.ws + WS_CTL);

    for (int u = F.tid; u < (LDS_BYTES - LDSCTL_OFF) / 4; u += 512) ((LAS unsigned*)(F.lds + LDSCTL_OFF))[u] = 0u;
    __syncthreads();
    XcdBarrier bar = xcd_barrier_post((unsigned*)(F.ctl + CW_BAR), (volatile LAS unsigned*)(F.lds + MISC_OFF) + 8);
    const int lo = args.ph_lo, hi = args.ph_hi;
#define IN(k) (lo <= (k) && (k) < hi)
#define SEAM(k) do { if (IN(k) && IN((k) + 1)) xcd_barrier(bar); } while (0)
    const int gw = F.vcu * 8 + F.wave, NGW = F.G * 8;
    LAS int* tab = (LAS int*)(F.lds + TAB_OFF);

    if (IN(0)) {
        DECL_PTRS();
        constexpr int I_IN = 16 * 128, I_SQ = 16 * 16;
        constexpr int NITEMS = I_IN + 3 * I_SQ;
        for (int it = gw; it < NITEMS; it += NGW) {
            int r = it;
            if (r < I_IN) { const int nb = r % 128; if (nb < 48 || (nb >= 96 && nb < 112)) p0_transpose_task<1>(w_in, 8192, Win_t, g_mix, r, F.lane); else p0_transpose_task8<1>(w_in, 8192, Win8, g_mix, r, F.lane); continue; } r -= I_IN;
            if (r < I_SQ) { p0_transpose_task8<0>(w_ao, 1024, Wao8, nullptr, r, F.lane); continue; } r -= I_SQ;
            if (r < I_SQ) { p0_transpose_task<0>(w_co, 1024, Wco_t, nullptr, r, F.lane); continue; } r -= I_SQ;
            p0_transpose_task<0>(w_out, 1024, Wout_t, nullptr, r, F.lane);
        }
        for (int m = gw; m < M; m += NGW) {
            const GAS f32x4* xr = (const GAS f32x4*)(x + (size_t)m * D) + F.lane; f32x4 v[4]; float s = 0.f;
#pragma unroll
            for (int j = 0; j < 4; ++j) { v[j] = xr[64 * j]; s += (v[j].x * v[j].x + v[j].y * v[j].y) + (v[j].z * v[j].z + v[j].w * v[j].w); }
            const float rstd = 1.0f / sqrtf(wave_sum(s) * (1.f / D) + EPS);
            GAS v2u* o8 = (GAS v2u*)(XN + (size_t)m * D) + F.lane; GAS unsigned* o4 = (GAS unsigned*)(XN8 + (size_t)m * D) + F.lane;
#pragma unroll
            for (int j = 0; j < 4; ++j) { v2u w; w.x = cvt_pk_bf16(v[j].x * rstd, v[j].y * rstd); w.y = cvt_pk_bf16(v[j].z * rstd, v[j].w * rstd); o8[64 * j] = w;
                int q8 = 0; q8 = __builtin_amdgcn_cvt_pk_fp8_f32(v[j].x * rstd, v[j].y * rstd, q8, false); q8 = __builtin_amdgcn_cvt_pk_fp8_f32(v[j].z * rstd, v[j].w * rstd, q8, true); o4[64 * j] = (unsigned)q8; }
        }
        const int gt = F.vcu * 512 + F.tid, NT = F.G * 512;
        for (int i = gt; i < SEQ * 32; i += NT) { const int pos = i >> 5, k = i & 31; const float inv = powf(10000.0f, -(float)k / 32.0f); const float ang = (float)pos * inv; cosT[i] = cosf(ang); sinT[i] = sinf(ang); }
        for (int i = gt; i < BATCH * NBLK * 1024; i += NT) ksum[i] = 0.f;
        { unsigned short* rwgH = (unsigned short*)rwg; unsigned short* rwgL = rwgH + 64 * 64 * 8;
          for (int i = gt; i < 64 * 64 * 8; i += NT) { const int jj = i & 7, ln = (i >> 3) & 63, st = i >> 9, k = 16 * st + 8 * (ln >> 5) + jj, e = ln & 31;
              const float v = router_w[k * 32 + e] * g_ffn[k]; const unsigned hb = cvt_pk_bf16(v, 0.f) & 0xffffu; const float vh = __uint_as_float(hb << 16);
              rwgH[i] = (unsigned short)hb; rwgL[i] = (unsigned short)(cvt_pk_bf16(v - vh, 0.f) & 0xffffu); } }
    }
    SEAM(0);
    if (IN(1)) {
        DECL_PTRS();
        { DensePol P{XN, Win_t, M / 256, 16, F.G, (int)blockIdx.x, 2, 12, 0, 12}; EpiInProj E{CB, U, Qb, Kb, Vb, GC, GA, cosT, sinT, ksum, 1.0f};
          pg8::gemm_phase<EpiInProj, DensePol, true>(F.lds, P, E); }
        { DensePol P{XN8, Win8, M / 256, 16, F.G, (int)blockIdx.x, 1, 12, 12, 16}; EpiInProj E{CB, U, Qb, Kb, Vb, GC, GA, cosT, sinT, ksum, 1.0f / 32.0f};
          pg8::gemm_phase<EpiInProj, DensePol, true, true>(F.lds, P, E); }
    }
    SEAM(1);
    if (IN(2)) {
        DECL_PTRS();
        bf16* CBW = CB;
        {
            const int cg = F.tid & 127, rs = F.tid >> 7;
            float w0[8], w1[8], w2[8];
#pragma unroll
            for (int e = 0; e < 8; ++e) { w0[e] = conv_w[cg * 8 + e]; w1[e] = conv_w[1024 + cg * 8 + e]; w2[e] = conv_w[2048 + cg * 8 + e]; }
            const int row0 = F.vcu * (M / F.G) + rs * 32, pos0 = row0 & (SEQ - 1);
            const size_t off0 = (size_t)row0 * 1024 + cg * 8;
            v4u u1 = (v4u){0u, 0u, 0u, 0u}, u2 = (v4u){0u, 0u, 0u, 0u};
            if (pos0 >= 1) u1 = *(const GAS v4u*)(U + off0 - 1024);
            if (pos0 >= 2) u2 = *(const GAS v4u*)(U + off0 - 2048);
#pragma unroll 1
            for (int r = 0; r < 32; r += 4) {
                v4u cb[4], uu[4];
#pragma unroll
                for (int q = 0; q < 4; ++q) { cb[q] = *(const GAS v4u*)(CB + off0 + (size_t)(r + q) * 1024); uu[q] = *(const GAS v4u*)(U + off0 + (size_t)(r + q) * 1024); }
#pragma unroll
                for (int q = 0; q < 4; ++q) {
                    const v4u u0 = uu[q]; float o[8];
#define CV(i, cw, a0, a1, a2, sel) o[i] = sel(cw) * (w0[i] * sel(a2) + w1[i] * sel(a1) + w2[i] * sel(a0))
                    CV(0, cb[q].x, u0.x, u1.x, u2.x, bf_lo); CV(1, cb[q].x, u0.x, u1.x, u2.x, bf_hi); CV(2, cb[q].y, u0.y, u1.y, u2.y, bf_lo); CV(3, cb[q].y, u0.y, u1.y, u2.y, bf_hi);
                    CV(4, cb[q].z, u0.z, u1.z, u2.z, bf_lo); CV(5, cb[q].z, u0.z, u1.z, u2.z, bf_hi); CV(6, cb[q].w, u0.w, u1.w, u2.w, bf_lo); CV(7, cb[q].w, u0.w, u1.w, u2.w, bf_hi);
#undef CV
                    v4u w; w.x = cvt_pk_bf16(o[0], o[1]); w.y = cvt_pk_bf16(o[2], o[3]); w.z = cvt_pk_bf16(o[4], o[5]); w.w = cvt_pk_bf16(o[6], o[7]);
                    *(GAS v4u*)(CBW + off0 + (size_t)(r + q) * 1024) = w;
                    u2 = u1; u1 = u0;
                }
            }
        }
        __syncthreads();
        {
            LAS unsigned char* kmH = F.lds; LAS unsigned char* kmL = F.lds + 8192;
            LAS int* lc = (LAS int*)(F.lds + 16384); LAS int* gb = lc + 64;
            const int r32 = F.lane & 31, hi = F.lane >> 5;
            for (int task = F.vcu; task < 32 * 32; task += F.G) {
                const int bh = task >> 5, chunk = task & 31, b = bh >> 4, h = bh & 15;
                { const int j = F.tid >> 3, c = F.tid & 7;
                  const f32x4 k0 = *(const f32x4*)(ksum + (size_t)(b * 64 + j) * 1024 + h * 64 + c * 8), k1 = *(const f32x4*)(ksum + (size_t)(b * 64 + j) * 1024 + h * 64 + c * 8 + 4);
                  v4u vh; vh.x = cvt_pk_bf16(k0.x, k0.y); vh.y = cvt_pk_bf16(k0.z, k0.w); vh.z = cvt_pk_bf16(k1.x, k1.y); vh.w = cvt_pk_bf16(k1.z, k1.w);
                  v4u vl; vl.x = cvt_pk_bf16(k0.x - bf_lo(vh.x), k0.y - bf_hi(vh.x)); vl.y = cvt_pk_bf16(k0.z - bf_lo(vh.y), k0.w - bf_hi(vh.y));
                  vl.z = cvt_pk_bf16(k1.x - bf_lo(vh.z), k1.y - bf_hi(vh.z)); vl.w = cvt_pk_bf16(k1.z - bf_lo(vh.w), k1.w - bf_hi(vh.w));
                  *(LAS v4u*)(kmH + c * 1024 + j * 16) = vh; *(LAS v4u*)(kmL + c * 1024 + j * 16) = vl; }
                if (F.tid < 64) lc[F.tid] = 0;
                __syncthreads();
                const int own = chunk * 2 + (F.wave >> 2), nv = own < 3 ? own : 3;
                int sel[2][3] = {{0, 0, 0}, {0, 0, 0}}, rk[2][3] = {{0, 0, 0}, {0, 0, 0}};
                if (own > 0) {
#pragma unroll
                    for (int ps = 0; ps < 2; ++ps) {
                        const int t = chunk * 512 + F.wave * 64 + ps * 32 + r32;
                        bf16x8_t qr[4];
#pragma unroll
                        for (int d0 = 0; d0 < 4; ++d0) qr[d0] = *(const bf16x8_t*)(Qb + (size_t)(b * SEQ + t) * 1024 + h * 64 + d0 * 16 + hi * 8);
                        float v0 = -INFINITY, v1 = -INFINITY, v2 = -INFINITY; int i0 = 0, i1 = 0, i2 = 0;
#pragma unroll
                        for (int tl = 0; tl < 2; ++tl) {
                            if (tl * 32 < own) {
                                f32x16 g = {0.f, 0.f, 0.f, 0.f, 0.f, 0.f, 0.f, 0.f, 0.f, 0.f, 0.f, 0.f, 0.f, 0.f, 0.f, 0.f};
#pragma unroll
                                for (int d0 = 0; d0 < 4; ++d0) { const bf16x8_t ah = *(const LAS bf16x8_t*)(kmH + (2 * d0 + hi) * 1024 + (tl * 32 + r32) * 16), al = *(const LAS bf16x8_t*)(kmL + (2 * d0 + hi) * 1024 + (tl * 32 + r32) * 16);
                                    g = __builtin_amdgcn_mfma_f32_32x32x16_bf16(ah, qr[d0], g, 0, 0, 0); g = __builtin_amdgcn_mfma_f32_32x32x16_bf16(al, qr[d0], g, 0, 0, 0); }
#pragma unroll
                                for (int r = 0; r < 16; ++r) { const int j = tl * 32 + crow(r, hi); const float gv = (j < own) ? g[r] : -INFINITY;
                                    if (gv > v0) { v2 = v1; i2 = i1; v1 = v0; i1 = i0; v0 = gv; i0 = j; }
                                    else if (gv > v1) { v2 = v1; i2 = i1; v1 = gv; i1 = j; }
                                    else if (gv > v2) { v2 = gv; i2 = j; } }
                            }
                        }
                        float pv[3] = {__shfl_xor(v0, 32), __shfl_xor(v1, 32), __shfl_xor(v2, 32)}; int pi[3] = {__shfl_xor(i0, 32), __shfl_xor(i1, 32), __shfl_xor(i2, 32)};
#pragma unroll
                        for (int e = 0; e < 3; ++e) { const float gv = pv[e]; const int j = pi[e];
                            if (gv > v0 || (gv == v0 && j < i0)) { v2 = v1; i2 = i1; v1 = v0; i1 = i0; v0 = gv; i0 = j; }
                            else if (gv > v1 || (gv == v1 && j < i1)) { v2 = v1; i2 = i1; v1 = gv; i1 = j; }
                            else if (gv > v2 || (gv == v2 && j < i2)) { v2 = gv; i2 = j; } }
                        sel[ps][0] = i0; sel[ps][1] = i1; sel[ps][2] = i2;
                        if (hi == 0) {
                            rk[ps][0] = __hip_atomic_fetch_add(&lc[i0], 1, __ATOMIC_RELAXED, __HIP_MEMORY_SCOPE_WORKGROUP);
                            if (nv > 1) rk[ps][1] = __hip_atomic_fetch_add(&lc[i1], 1, __ATOMIC_RELAXED, __HIP_MEMORY_SCOPE_WORKGROUP);
                            if (nv > 2) rk[ps][2] = __hip_atomic_fetch_add(&lc[i2], 1, __ATOMIC_RELAXED, __HIP_MEMORY_SCOPE_WORKGROUP);
                        }
                    }
                }
                __syncthreads();
                if (F.tid < 64) { const int c = lc[F.tid]; gb[F.tid] = c ? (int)__hip_atomic_fetch_add((unsigned*)(acnt + bh * 64 + F.tid), (unsigned)c, RLX_AGENT) : 0; }
                __syncthreads();
                if (own > 0 && hi == 0) {
                    unsigned short* lb = alist + (size_t)bh * ALIST_BH;
#pragma unroll
                    for (int ps = 0; ps < 2; ++ps) { const int t = chunk * 512 + F.wave * 64 + ps * 32 + r32;
                        lb[alist_off(sel[ps][0]) + gb[sel[ps][0]] + rk[ps][0]] = (unsigned short)((t << 2) | 0);
                        if (nv > 1) lb[alist_off(sel[ps][1]) + gb[sel[ps][1]] + rk[ps][1]] = (unsigned short)((t << 2) | 1);
                        if (nv > 2) lb[alist_off(sel[ps][2]) + gb[sel[ps][2]] + rk[ps][2]] = (unsigned short)((t << 2) | 2); }
                }
                __syncthreads();
            }
        }
    }
    SEAM(2);
    if (IN(3)) {
        DECL_PTRS();
        attn_phase<false>(F, Qb, Kb, Vb, PO, PML, alist, acnt, ATTO, w_gu, w_d, g_ffn, (unsigned char*)Wgu_t, (unsigned char*)Wd_t);
    }
    SEAM(3);
    if (IN(4)) {
        DECL_PTRS();
        attn_phase<true>(F, Qb, Kb, Vb, PO, PML, alist, acnt, ATTO, w_gu, w_d, g_ffn, (unsigned char*)Wgu_t, (unsigned char*)Wd_t);
    }
    SEAM(4);
    if (IN(5)) {
        DECL_PTRS();
        { DensePol P{CB, Wco_t, M / 256, 4, F.G, (int)blockIdx.x, 2, 4, 0, 0}; EpiGate<0> E{GC, nullptr, T1, 1.0f}; pg8::gemm_phase<EpiGate<0>, DensePol, true>(F.lds, P, E); }
        VM_WAIT(); __syncthreads();
        { DensePol P{ATTO, Wao8, M / 256, 4, F.G, (int)blockIdx.x, 1, 4, 0, 0}; EpiGate<1> E{GA, T1, MERGED, 1.0f / 512.0f}; pg8::gemm_phase<EpiGate<1>, DensePol, true, true>(F.lds, P, E); }
    }
    SEAM(5);
    if (IN(6)) {
        DECL_PTRS();
        DensePol P{MERGED, Wout_t, M / 256, 4, F.G, (int)blockIdx.x, 2, 4, 0, 0}; EpiResid E{x, out};
        pg8::gemm_phase<EpiResid, DensePol, true>(F.lds, P, E);
    }
    SEAM(6);
    if (IN(7)) {
        DECL_PTRS();
        LAS int* lcnt = (LAS int*)(F.lds + 98304); LAS int* gbase = lcnt + 32;
        if (F.tid < 32) lcnt[F.tid] = 0;
        __syncthreads();
        const int rows_per_wg = M / F.G;
        int myrank[4] = {0, 0, 0, 0}, mye[4] = {0, 0, 0, 0}; float myw[4] = {0.f, 0.f, 0.f, 0.f}; int mytok = -1; float myrstd = 0.f;
        {
            const int r32 = F.lane & 31, hh = F.lane >> 5, rt = F.wave & 3, kh = F.wave >> 2, row = F.vcu * rows_per_wg + rt * 32 + r32;
            const float* hrow = out + (size_t)row * 1024 + kh * 512 + 8 * hh;
            unsigned char* hn = (unsigned char*)HN + (size_t)row * 1024 + kh * 512 + 8 * hh;
            const float* gfr = g_ffn + kh * 512 + 8 * hh;
            const unsigned short* rwgH = (const unsigned short*)rwg + ((size_t)(kh * 32) * 64 + F.lane) * 8; const unsigned short* rwgL = rwgH + 64 * 64 * 8;
            f32x16 acc = {0.f, 0.f, 0.f, 0.f, 0.f, 0.f, 0.f, 0.f, 0.f, 0.f, 0.f, 0.f, 0.f, 0.f, 0.f, 0.f}; float ss = 0.f;
#pragma unroll 4
            for (int st = 0; st < 32; ++st) {
                const f32x4 a0 = *(const f32x4*)(hrow + 16 * st), a1 = *(const f32x4*)(hrow + 16 * st + 4);
                const v4u bh = *(const v4u*)(rwgH + (size_t)st * 512), bl = *(const v4u*)(rwgL + (size_t)st * 512);
                ss += (a0.x * a0.x + a0.y * a0.y) + (a0.z * a0.z + a0.w * a0.w) + (a1.x * a1.x + a1.y * a1.y) + (a1.z * a1.z + a1.w * a1.w);
                v4u ah; ah.x = cvt_pk_bf16(a0.x, a0.y); ah.y = cvt_pk_bf16(a0.z, a0.w); ah.z = cvt_pk_bf16(a1.x, a1.y); ah.w = cvt_pk_bf16(a1.z, a1.w);
                v4u al; al.x = cvt_pk_bf16(a0.x - bf_lo(ah.x), a0.y - bf_hi(ah.x)); al.y = cvt_pk_bf16(a0.z - bf_lo(ah.y), a0.w - bf_hi(ah.y));
                al.z = cvt_pk_bf16(a1.x - bf_lo(ah.z), a1.y - bf_hi(ah.z)); al.w = cvt_pk_bf16(a1.z - bf_lo(ah.w), a1.w - bf_hi(ah.w));
                { const f32x4 g0 = *(const f32x4*)(gfr + 16 * st), g1 = *(const f32x4*)(gfr + 16 * st + 4); int w0 = 0, w1 = 0;
                  w0 = __builtin_amdgcn_cvt_pk_fp8_f32(a0.x * g0.x, a0.y * g0.y, w0, false); w0 = __builtin_amdgcn_cvt_pk_fp8_f32(a0.z * g0.z, a0.w * g0.w, w0, true);
                  w1 = __builtin_amdgcn_cvt_pk_fp8_f32(a1.x * g1.x, a1.y * g1.y, w1, false); w1 = __builtin_amdgcn_cvt_pk_fp8_f32(a1.z * g1.z, a1.w * g1.w, w1, true);
                  v2u w; w.x = (unsigned)w0; w.y = (unsigned)w1; *(GAS v2u*)(hn + 16 * st) = w; }
                const bf16x8_t fah = __builtin_bit_cast(bf16x8_t, ah), fal = __builtin_bit_cast(bf16x8_t, al), fbh = __builtin_bit_cast(bf16x8_t, bh), fbl = __builtin_bit_cast(bf16x8_t, bl);
                acc = __builtin_amdgcn_mfma_f32_32x32x16_bf16(fah, fbh, acc, 0, 0, 0);
                acc = __builtin_amdgcn_mfma_f32_32x32x16_bf16(fah, fbl, acc, 0, 0, 0);
                acc = __builtin_amdgcn_mfma_f32_32x32x16_bf16(fal, fbh, acc, 0, 0, 0);
            }
            LAS float* xch = (LAS float*)(F.lds + 32768 + rt * 8192);
            if (kh == 1) {
#pragma unroll
                for (int r = 0; r < 16; ++r) xch[r * 64 + F.lane] = acc[r];
                xch[16 * 64 + F.lane] = ss; }
            LDS_WAIT(); __syncthreads();
            if (kh == 0) {
#pragma unroll
                for (int r = 0; r < 16; ++r) acc[r] += xch[r * 64 + F.lane];
                ss += xch[16 * 64 + F.lane];
                ss += __shfl_xor(ss, 32);
                const float rstd = 1.0f / sqrtf(ss * (1.f / D) + EPS);
                LAS float* scr = (LAS float*)(F.lds + rt * 8192);
#pragma unroll
                for (int r = 0; r < 16; ++r) scr[crow(r, hh) * 33 + r32] = acc[r];
                LDS_WAIT(); asm volatile("" ::: "memory");
                if (hh == 0) {
                    float v0 = -INFINITY, v1 = -INFINITY, v2 = -INFINITY, v3 = -INFINITY; int i0 = 0, i1 = 0, i2 = 0, i3 = 0;
#pragma unroll 4
                    for (int e = 0; e < 32; ++e) { const float g = scr[r32 * 33 + e] * rstd + router_b[e];
                        if (g > v0) { v3 = v2; i3 = i2; v2 = v1; i2 = i1; v1 = v0; i1 = i0; v0 = g; i0 = e; }
                        else if (g > v1) { v3 = v2; i3 = i2; v2 = v1; i2 = i1; v1 = g; i1 = e; }
                        else if (g > v2) { v3 = v2; i3 = i2; v2 = g; i2 = e; }
                        else if (g > v3) { v3 = g; i3 = e; } }
                    const float e1 = __expf(v1 - v0), e2 = __expf(v2 - v0), e3 = __expf(v3 - v0), inv = 1.0f / (1.0f + e1 + e2 + e3);
                    mye[0] = i0; mye[1] = i1; mye[2] = i2; mye[3] = i3; myw[0] = inv; myw[1] = e1 * inv; myw[2] = e2 * inv; myw[3] = e3 * inv; mytok = row; myrstd = rstd;
#pragma unroll
                    for (int k = 0; k < 4; ++k) myrank[k] = __hip_atomic_fetch_add(&lcnt[mye[k]], 1, __ATOMIC_RELAXED, __HIP_MEMORY_SCOPE_WORKGROUP);
                }
            }
        }
        __syncthreads();
        if (F.tid < 32) gbase[F.tid] = (int)__hip_atomic_fetch_add((unsigned*)(F.ctl + CW_ECNT + 64 * F.tid), (unsigned)lcnt[F.tid], RLX_AGENT);
        __syncthreads();
        if (mytok >= 0) {
#pragma unroll
            for (int k = 0; k < 4; ++k) { const int e = mye[k], pos = gbase[e] + myrank[k]; etok[e * 32768 + pos] = mytok; ewt[e * 32768 + pos] = myw[k]; erstd[e * 32768 + pos] = myrstd; tokslot[mytok * 4 + k] = e * 32768 + pos; }
        }
    }
    SEAM(7);
    if (IN(8) || IN(9) || IN(10)) {
        __syncthreads();
        if (F.tid == 0) { int p = 0; for (int e = 0; e < 32; ++e) { const int c = (int)__hip_atomic_load(F.ctl + CW_ECNT + 64 * e, RLX_AGENT); tab[e] = c; tab[32 + e] = p; p += (c + 255) >> 8; } tab[64] = p; tab[65] = p; }
        __syncthreads();
    }
    if (IN(8)) {
        DECL_PTRS();
        LAS int* ul = (LAS int*)(F.lds + UMETA_OFF); __syncthreads(); const int nul = moe_unit_list(ul, tab, 8, F.G, (int)blockIdx.x, F.tid); __syncthreads();
        MoePol1 P{HN, Wgu_t, etok, tab, ul, nul}; EpiSwiglu E{b_gu, erstd, (unsigned char*)ACT};
        pg8::gemm_phase<EpiSwiglu, MoePol1, true, true>(F.lds, P, E);
    }
    SEAM(8);
    if (IN(9)) {
        DECL_PTRS();
        LAS int* ul = (LAS int*)(F.lds + UMETA_OFF); __syncthreads(); const int nul = moe_unit_list(ul, tab, 4, F.G, (int)blockIdx.x, F.tid); __syncthreads();
        MoePol2 P{ACT, Wd_t, ul, nul}; EpiDown E{b_d, ewt, (unsigned char*)Y};
        pg8::gemm_phase<EpiDown, MoePol2, true, true>(F.lds, P, E);
    }
    SEAM(9);
    if (IN(10)) {
        DECL_PTRS();
        const unsigned tmo = __hip_atomic_load(F.ctl + CW_BAR + XB_TMO, RLX_AGENT);
        for (int m = gw; m < M; m += NGW) {
            GAS f32x4* hr = (GAS f32x4*)(out + (size_t)m * D) + F.lane; f32x4 v[4];
#pragma unroll
            for (int j = 0; j < 4; ++j) v[j] = hr[64 * j];
#pragma unroll
            for (int k = 0; k < 4; ++k) { const int ts = tokslot[m * 4 + k], e = ts >> 15, pos = ts & 32767; const size_t srow = (size_t)tab[32 + e] * 256 + pos;
                const GAS unsigned* yr = (const GAS unsigned*)((const unsigned char*)Y + srow * 1024) + F.lane;
#pragma unroll
                for (int j = 0; j < 4; ++j) { const unsigned w = yr[64 * j]; const pg8::f32x2 lo2 = __builtin_amdgcn_cvt_pk_f32_fp8((int)w, false), hi2 = __builtin_amdgcn_cvt_pk_f32_fp8((int)w, true);
                    v[j].x += lo2[0] * (1.0f / 16.0f); v[j].y += lo2[1] * (1.0f / 16.0f); v[j].z += hi2[0] * (1.0f / 16.0f); v[j].w += hi2[1] * (1.0f / 16.0f); } }
            float s = 0.f;
#pragma unroll
            for (int j = 0; j < 4; ++j) s += (v[j].x * v[j].x + v[j].y * v[j].y) + (v[j].z * v[j].z + v[j].w * v[j].w);
            float rstd = 1.0f / sqrtf(wave_sum(s) * (1.f / D) + EPS);
            if (tmo) rstd = __builtin_nanf("");
            const GAS f32x4* gf = (const GAS f32x4*)g_fin + F.lane;
#pragma unroll
            for (int j = 0; j < 4; ++j) { const f32x4 g = gf[64 * j]; hr[64 * j] = v[j] * rstd * g; }
        }
    }
#undef IN
#undef SEAM
}

extern "C" void kernel_launch(void* const* d_in, const int* in_sizes, int n_in, void* d_out, int out_size, void* d_ws, size_t ws_size, hipStream_t stream) {
    static int grid = 0;
    if (grid == 0) {
        if (n_in != 15 || out_size != M * D || ws_size < WS_END) { fprintf(stderr, "kernel_launch: unexpected shapes (n_in %d out %d ws %zu); nothing launched\n", n_in, out_size, ws_size); grid = -1; return; }
        int dev = 0, cus = 0, per_cu = 0;
        if (hipGetDevice(&dev) != hipSuccess || hipDeviceGetAttribute(&cus, hipDeviceAttributeMultiprocessorCount, dev) != hipSuccess) { grid = -1; return; }
        if (hipFuncSetAttribute((const void*)fwd_kernel, hipFuncAttributeMaxDynamicSharedMemorySize, LDS_BYTES) != hipSuccess) { fprintf(stderr, "kernel_launch: hipFuncSetAttribute failed\n"); grid = -1; return; }
        if (hipOccupancyMaxActiveBlocksPerMultiprocessor(&per_cu, (const void*)fwd_kernel, 512, LDS_BYTES) != hipSuccess || per_cu < 1) { fprintf(stderr, "kernel_launch: occupancy query reports %d blocks per CU; nothing launched\n", per_cu); (void)hipGetLastError(); grid = -1; return; }
        (void)hipGetLastError();
        grid = cus;
    }
    if (grid < 0) return;
    (void)hipMemsetAsync((char*)d_ws + WS_CTL, 0, CTL_ZERO_BYTES, stream);
    Args a{};
    for (int i = 0; i < 15; ++i) a.in[i] = (const float*)d_in[i];
    a.out = (float*)d_out; a.ws = (unsigned char*)d_ws;
    a.ph_lo = 0; a.ph_hi = NPHASE;
#ifndef LAUNCH_PLAN
    hipLaunchKernelGGL(fwd_kernel, dim3(grid), dim3(512), LDS_BYTES, stream, a);
#else
    { static const int plan[] = {LAUNCH_PLAN}; for (unsigned i = 0; i < sizeof(plan) / sizeof(plan[0]); ++i) { a.ph_lo = plan[i]; a.ph_hi = plan[i] + 1; hipLaunchKernelGGL(fwd_kernel, dim3(grid), dim3(512), LDS_BYTES, stream, a); } }
#endif
}
```

```cpp
#include <hip/hip_runtime.h>
#include <cstdio>
#include <cstdint>
#include <cmath>


constexpr int BATCH = 2, SEQ = 16384, D = 1024, M = BATCH * SEQ, NH = 16, HD = 64, NBLK = SEQ / 256, NE = 32, NIN = 8192;
constexpr float EPS = 1e-5f;
constexpr float C2 = 0.125f * 1.4426950408889634f;

namespace pg8 {
#define PG8_LAS __attribute__((address_space(3)))
typedef unsigned short bf16_t;
typedef short bf16x8 __attribute__((ext_vector_type(8)));
typedef float f32x4 __attribute__((ext_vector_type(4)));
typedef float f32x2 __attribute__((ext_vector_type(2)));
typedef unsigned u32x4 __attribute__((ext_vector_type(4)));
typedef unsigned u32x2 __attribute__((ext_vector_type(2)));
constexpr int BM = 256, BK = 64, HALF = 128, HTB = HALF * BK * 2, STAGE_BYTES = 8 * HTB, NXCD = 8, WGM = 8, KD = 1024;

__host__ __device__ __forceinline__ int lds_byte(int r, int c) { const int st = (r >> 4) * 2 + (c >> 5), rr = r & 15, cc = c & 31, ob = rr * 64 + cc * 2; return st * 1024 + (ob ^ (((ob >> 9) & 1) << 5)); }
__host__ __device__ __forceinline__ void stage_rc(int b, int& R, int& C) { const int st = b / 1024, sb = b % 1024, swz = sb ^ (((sb >> 9) & 1) << 5); R = (st >> 1) * 16 + swz / 64; C = (st & 1) * 32 + (swz % 64) / 2; }
__host__ __device__ __forceinline__ int perm32(int rho) { const int n = rho >> 4, i = rho & 15; return 8 * (i >> 2) + 4 * n + (i & 3); }

struct Unit { int pm, pn, e, rt; };

typedef float f32x2_cv __attribute__((ext_vector_type(2))); typedef __bf16 bf16x2_cv __attribute__((ext_vector_type(2)));
__device__ __forceinline__ unsigned cvt_pk_bf16(float lo, float hi) { const f32x2_cv v = {lo, hi}; const bf16x2_cv b = __builtin_convertvector(v, bf16x2_cv); return __builtin_bit_cast(unsigned, b); }
__device__ __forceinline__ float bf_lo(unsigned w) { return __uint_as_float(w << 16); }
__device__ __forceinline__ float bf_hi(unsigned w) { return __uint_as_float(w & 0xffff0000u); }

__device__ __forceinline__ bool tile_order(int i, int G, int c, int nM, int nN, int& pm, int& pn) {
    const int nwg = nM * nN; const long L = (long)i * G + c; if (L >= nwg) return false;
    int wgid = (int)L;
    { const int q = nwg / NXCD, r = nwg % NXCD, xcd = wgid % NXCD, off = wgid / NXCD; wgid = (xcd < r ? xcd * (q + 1) : r * (q + 1) + (xcd - r) * q) + off; }
    const int nig = WGM * nN, gid = wgid / nig, fm = gid * WGM, gsz = (nM - fm) < WGM ? (nM - fm) : WGM;
    pm = fm + ((wgid % nig) % gsz); pn = (wgid % nig) / gsz; return true;
}

typedef int v8i __attribute__((ext_vector_type(8)));
typedef int v4i __attribute__((ext_vector_type(4)));
template <class Epi, class Pol, bool ALIGN_EPI, bool FP8 = false>
__device__ __forceinline__ void gemm_phase(PG8_LAS unsigned char* lds, const Pol& S, const Epi& E) {
    constexpr int K = KD, KB = FP8 ? KD : 2 * KD  , nt = KB / 128;
    const int tid = threadIdx.x, wid = __builtin_amdgcn_readfirstlane(tid >> 6), lane = tid & 63, wr = wid >> 2, wc = wid & 3, fr = lane & 15, fq = lane >> 4;
    int RA[2], CA[2]; unsigned voffB[2];
#pragma unroll
    for (int i = 0; i < 2; ++i) { int R, C; stage_rc(tid * 16 + i * 8192, R, C); const int Rb = Epi::PERM ? ((R & ~31) + perm32(R & 31)) : R;
        RA[i] = R; CA[i] = C; voffB[i] = (unsigned)(Rb * KB + C * 2); }
    constexpr unsigned kstep = BK * 2, hstep = (unsigned)HALF * KB;
    const unsigned ldsw = (unsigned)wid * 1024u;
    const int aoff = lds_byte(wr * 64 + fr, fq * 8), boff = lds_byte(wc * 32 + fr, fq * 8);
#define PG8_SA(b, h) (((b) * 2 + (h)) * HTB)
#define PG8_SB(b, h) ((4 + (b) * 2 + (h)) * HTB)
#define PG8_GLDS(bufoff, ptr, o0, o1) do { \
        __builtin_amdgcn_global_load_lds((const unsigned*)((const char*)(ptr) + (o0)), (PG8_LAS unsigned*)(lds + (bufoff) + ldsw), 16, 0, 0); \
        __builtin_amdgcn_global_load_lds((const unsigned*)((const char*)(ptr) + (o1)), (PG8_LAS unsigned*)(lds + (bufoff) + ldsw + 8192), 16, 0, 0); } while (0)
#define PG8_STAGE_B(bufoff, ptr) PG8_GLDS(bufoff, ptr, voffB[0], voffB[1])
#define PG8_LDA(dst, b, h) do { if constexpr (FP8) { _Pragma("unroll") for (int m = 0; m < 4; ++m) { const v4i l_ = *(const PG8_LAS v4i*)(lds + PG8_SA(b, h) + aoff + m * 2048), h_ = *(const PG8_LAS v4i*)(lds + PG8_SA(b, h) + aoff + m * 2048 + 1024); \
            dst##8[m] = (v8i){l_[0], l_[1], l_[2], l_[3], h_[0], h_[1], h_[2], h_[3]}; } } \
        else { _Pragma("unroll") for (int m = 0; m < 4; ++m) _Pragma("unroll") for (int k = 0; k < 2; ++k) dst[m][k] = *(const PG8_LAS bf16x8*)(lds + PG8_SA(b, h) + aoff + m * 2048 + k * 1024); } } while (0)
#define PG8_LDB(dst, b, h) do { if constexpr (FP8) { _Pragma("unroll") for (int n = 0; n < 2; ++n) { const v4i l_ = *(const PG8_LAS v4i*)(lds + PG8_SB(b, h) + boff + n * 2048), h_ = *(const PG8_LAS v4i*)(lds + PG8_SB(b, h) + boff + n * 2048 + 1024); \
            dst##8[n] = (v8i){l_[0], l_[1], l_[2], l_[3], h_[0], h_[1], h_[2], h_[3]}; } } \
        else { _Pragma("unroll") for (int n = 0; n < 2; ++n) _Pragma("unroll") for (int k = 0; k < 2; ++k) dst[n][k] = *(const PG8_LAS bf16x8*)(lds + PG8_SB(b, h) + boff + n * 2048 + k * 1024); } } while (0)
#define PG8_MMA(ai, bj, At, Bt) do { __builtin_amdgcn_s_setprio(1); if constexpr (FP8) { _Pragma("unroll") for (int m = 0; m < 4; ++m) _Pragma("unroll") for (int n = 0; n < 2; ++n) \
        asm volatile("s_nop 1\n\tv_mfma_scale_f32_16x16x128_f8f6f4 %0, %1, %2, %0, %3, %3 op_sel_hi:[0,0,0]" : "+v"(acc[ai][bj][m][n]) : "v"(Bt##8[n]), "v"(At##8[m]), "v"(one_scale)); } \
        else { _Pragma("unroll") for (int m = 0; m < 4; ++m) _Pragma("unroll") for (int n = 0; n < 2; ++n) _Pragma("unroll") for (int k = 0; k < 2; ++k) \
        acc[ai][bj][m][n] = __builtin_amdgcn_mfma_f32_16x16x32_bf16(Bt[n][k], At[m][k], acc[ai][bj][m][n], 0, 0, 0); } __builtin_amdgcn_s_setprio(0); } while (0)
#define PG8_WAIT_V(n) asm volatile("s_waitcnt vmcnt(" #n ")" ::: "memory")
#define PG8_WAIT_L(n) asm volatile("s_waitcnt lgkmcnt(" #n ")" ::: "memory")
#define PG8_BAR __builtin_amdgcn_s_barrier()
#define PG8_SCHED __builtin_amdgcn_sched_barrier(0)
#define PG8_AOFF(vo, u) do { _Pragma("unroll") for (int h_ = 0; h_ < 2; ++h_) _Pragma("unroll") for (int i_ = 0; i_ < 2; ++i_) { \
        if constexpr (Pol::GATHER) vo[h_][i_] = (unsigned)(S.gather(u, h_ * HALF + RA[i_]) * KB + CA[i_] * 2); \
        else vo[h_][i_] = (unsigned)((h_ * HALF + RA[i_]) * KB + CA[i_] * 2); } } while (0)
    Unit cur, nxt; int ui = 0;
    if (!S.next(0, cur)) return;
    f32x4 acc[2][2][4][2];
#pragma unroll
    for (int a = 0; a < 2; ++a)
#pragma unroll
        for (int b = 0; b < 2; ++b)
#pragma unroll
            for (int m = 0; m < 4; ++m)
#pragma unroll
                for (int n = 0; n < 2; ++n) acc[a][b][m][n] = (f32x4){0.f, 0.f, 0.f, 0.f};
    bf16x8 At[4][2], B0[2][2], B1[2][2]; v8i At8[4], B08[2], B18[2];
    int one_scale = 0x7f7f7f7f; asm volatile("" : "+v"(one_scale));
    unsigned voC[2][2], voN[2][2];
    PG8_AOFF(voC, cur);
#pragma unroll
    for (int h_ = 0; h_ < 2; ++h_)
#pragma unroll
        for (int i_ = 0; i_ < 2; ++i_) voN[h_][i_] = voC[h_][i_];
    const char* cA = S.a_base(cur); const char* cB = S.b_base(cur);
    PG8_STAGE_B(PG8_SB(0, 0), cB); PG8_STAGE_B(PG8_SB(0, 1), cB + hstep); PG8_GLDS(PG8_SA(0, 0), cA, voC[0][0], voC[0][1]); PG8_GLDS(PG8_SA(0, 1), cA, voC[1][0], voC[1][1]);
    if (wr == 1) PG8_BAR;
    PG8_WAIT_V(2); PG8_BAR;
    PG8_STAGE_B(PG8_SB(1, 0), cB + kstep); PG8_GLDS(PG8_SA(1, 0), cA + kstep, voC[0][0], voC[0][1]); PG8_STAGE_B(PG8_SB(1, 1), cB + hstep + kstep);
    PG8_WAIT_V(6); PG8_BAR;
    for (;;) {
        const bool has_next = S.next(ui + 1, nxt);
        const char* nA = cA; const char* nB = cB;
        if (has_next) { nA = S.a_base(nxt); nB = S.b_base(nxt); if constexpr (Pol::GATHER) { PG8_AOFF(voN, nxt); } }
        else { if constexpr (Pol::GATHER) {
#pragma unroll
            for (int h_ = 0; h_ < 2; ++h_)
#pragma unroll
                for (int i_ = 0; i_ < 2; ++i_) voN[h_][i_] = voC[h_][i_]; } }
#pragma unroll 1
        for (int t = 0; t < nt; t += 2) {
            const bool last = (t == nt - 2);
            const char* a1 = cA + (size_t)(t + 1) * kstep;
            const char* a2 = last ? nA : cA + (size_t)(t + 2) * kstep; const char* b2 = last ? nB : cB + (size_t)(t + 2) * kstep;
            const char* a3 = a2 + kstep; const char* b3 = b2 + kstep;
            unsigned o00, o01, o10, o11;
            if constexpr (Pol::GATHER) { o00 = last ? voN[0][0] : voC[0][0]; o01 = last ? voN[0][1] : voC[0][1]; o10 = last ? voN[1][0] : voC[1][0]; o11 = last ? voN[1][1] : voC[1][1]; }
            else { o00 = voC[0][0]; o01 = voC[0][1]; o10 = voC[1][0]; o11 = voC[1][1]; }
            PG8_LDB(B0, 0, 0); PG8_LDB(B1, 0, 1); PG8_SCHED; PG8_LDA(At, 0, 0); PG8_GLDS(PG8_SA(1, 1), a1, voC[1][0], voC[1][1]);
            PG8_WAIT_V(8); PG8_WAIT_L(0); PG8_BAR; PG8_MMA(0, 0, At, B0); PG8_MMA(0, 1, At, B1); PG8_BAR; PG8_SCHED;
            PG8_LDA(At, 0, 1); PG8_STAGE_B(PG8_SB(0, 0), b2); PG8_STAGE_B(PG8_SB(0, 1), b2 + hstep); PG8_GLDS(PG8_SA(0, 0), a2, o00, o01);
            PG8_WAIT_V(8); PG8_WAIT_L(0); PG8_BAR; PG8_MMA(1, 0, At, B0); PG8_MMA(1, 1, At, B1); PG8_BAR; PG8_SCHED;
            PG8_LDB(B0, 1, 0); PG8_LDB(B1, 1, 1); PG8_SCHED; PG8_LDA(At, 1, 0); PG8_GLDS(PG8_SA(0, 1), a2, o10, o11);
            PG8_WAIT_V(8); PG8_WAIT_L(0); PG8_BAR; PG8_MMA(0, 0, At, B0); PG8_MMA(0, 1, At, B1); PG8_BAR; PG8_SCHED;
            PG8_LDA(At, 1, 1); PG8_STAGE_B(PG8_SB(1, 0), b3); PG8_STAGE_B(PG8_SB(1, 1), b3 + hstep); PG8_GLDS(PG8_SA(1, 0), a3, o00, o01);
            PG8_WAIT_V(8); PG8_WAIT_L(0); PG8_BAR; PG8_MMA(1, 0, At, B0); PG8_MMA(1, 1, At, B1); PG8_BAR; PG8_SCHED;
        }
        if constexpr (FP8) asm volatile("s_nop 15\n\ts_nop 15" ::: "memory");
        if constexpr (ALIGN_EPI) { if (wr == 0) PG8_BAR; }
        E(acc, cur, wr, wc, fr, fq);
        if (!has_next) break;
#pragma unroll
        for (int a = 0; a < 2; ++a)
#pragma unroll
            for (int b = 0; b < 2; ++b)
#pragma unroll
                for (int m = 0; m < 4; ++m)
#pragma unroll
                    for (int n = 0; n < 2; ++n) acc[a][b][m][n] = (f32x4){0.f, 0.f, 0.f, 0.f};
        cur = nxt; cA = nA; cB = nB; ++ui;
#pragma unroll
        for (int h_ = 0; h_ < 2; ++h_)
#pragma unroll
            for (int i_ = 0; i_ < 2; ++i_) voC[h_][i_] = voN[h_][i_];
        if constexpr (ALIGN_EPI) { if (wr == 1) PG8_BAR; }
    }
    PG8_WAIT_V(0);
    if constexpr (!ALIGN_EPI) { if (wr == 0) PG8_BAR; }
    PG8_BAR;
#undef PG8_SA
#undef PG8_SB
#undef PG8_GLDS
#undef PG8_STAGE_B
#undef PG8_LDA
#undef PG8_LDB
#undef PG8_MMA
#undef PG8_WAIT_V
#undef PG8_WAIT_L
#undef PG8_BAR
#undef PG8_SCHED
#undef PG8_AOFF
}
}

constexpr size_t MiB = 1u << 20;
constexpr size_t WS_CTL = 0, CTL_ZERO_BYTES = 1 * MiB;
constexpr size_t WS_RWG = 1 * MiB;
constexpr size_t WS_KSUM = 1 * MiB + 512 * 1024;
constexpr size_t WS_ETOK = 2 * MiB;
constexpr size_t WS_EWT = 6 * MiB;
constexpr size_t WS_TOKSLOT = 10 * MiB;
constexpr size_t WS_COS = 11 * MiB, WS_SIN = 13 * MiB;
constexpr size_t WS_WCO = 16 * MiB, WS_WAO = 18 * MiB, WS_WOUT = 20 * MiB;
constexpr size_t WS_WIN = 24 * MiB;
constexpr size_t WS_WGU = 40 * MiB;
constexpr size_t WS_WD = 168 * MiB;
constexpr size_t WS_XN = 232 * MiB;
constexpr size_t WS_CB = 296 * MiB;
constexpr size_t WS_U = 360 * MiB;
constexpr size_t WS_Q = 424 * MiB;
constexpr size_t WS_K = 488 * MiB;
constexpr size_t WS_V = 552 * MiB;
constexpr size_t WS_GC = 616 * MiB;
constexpr size_t WS_GA = 680 * MiB;
constexpr size_t WS_PO = 744 * MiB;
constexpr size_t WS_PML = 936 * MiB;
constexpr size_t WS_ALIST = 952 * MiB;
constexpr size_t WS_ACT = 296 * MiB;
constexpr size_t WS_Y = 616 * MiB;
constexpr size_t WS_WIN8 = 104 * MiB;
constexpr size_t WS_WAO8 = 112 * MiB;
constexpr size_t WS_XN8 = 744 * MiB;
constexpr size_t WS_ERSTD = 986 * MiB;
constexpr size_t WS_SIDE_DUMMY = 990 * MiB;
constexpr size_t WS_END = 992 * MiB;
constexpr int CW_BAR = 4096;
constexpr int CW_ECNT = 8192;
constexpr int CW_ACNT = 16384;
constexpr int CW_DBG = 20000;

constexpr int RING_BYTES = 131072, LDSCTL_OFF = RING_BYTES, MISC_OFF = LDSCTL_OFF + 320, TAB_OFF = LDSCTL_OFF + 512, LDS_BYTES = 147456;

#define GAS __attribute__((address_space(1)))
#define LAS __attribute__((address_space(3)))
typedef unsigned short bf16;
typedef unsigned v4u __attribute__((ext_vector_type(4)));
typedef unsigned v2u __attribute__((ext_vector_type(2)));
typedef float f32x4 __attribute__((ext_vector_type(4)));
typedef float f32x16 __attribute__((ext_vector_type(16)));
typedef GAS unsigned gu32;
#define RLX_AGENT __ATOMIC_RELAXED, __HIP_MEMORY_SCOPE_AGENT
#define LDS_WAIT() asm volatile("s_waitcnt lgkmcnt(0)" ::: "memory")
#define VM_WAIT() asm volatile("s_waitcnt vmcnt(0)" ::: "memory")
using pg8::cvt_pk_bf16; using pg8::bf_lo; using pg8::bf_hi;

#define XB_TMO      128
#define XB_XCNT(j)  (256  + 64 * (j))
#define XB_XSUB(j)  (1280 + 64 * (j))
#define XB_XGEN(j)  (2304 + 64 * (j))
#define XB_TOP      3328
#define XB_TOPGEN   3392
#define XCD_BAR_WORDS 3456
#define XB_SPIN_CAP (1u << 18)
__device__ __forceinline__ unsigned xb_ld(unsigned* p)              { return __hip_atomic_load(p, __ATOMIC_RELAXED, __HIP_MEMORY_SCOPE_AGENT); }
__device__ __forceinline__ unsigned xb_add(unsigned* p, unsigned v) { return __hip_atomic_fetch_add(p, v, __ATOMIC_RELAXED, __HIP_MEMORY_SCOPE_AGENT); }
__device__ __forceinline__ unsigned xb_xcc_id() { return (unsigned)__builtin_amdgcn_s_getreg((3 << 11) | 20) & 0xFu; }
#define XB_SPIN(cond, bar) do { unsigned _sp = 0; while (cond) { __builtin_amdgcn_s_sleep(1); \
    if ((++_sp & 255u) == 0u) { if (xb_ld(&(bar)[XB_TMO])) break; if (_sp > XB_SPIN_CAP) { atomicAdd(&(bar)[XB_TMO], 1u); break; } } } } while (0)
struct XcdBarrier { unsigned* bar; unsigned x; volatile LAS unsigned* st; };
__device__ __forceinline__ XcdBarrier xcd_barrier_post(unsigned* bar, volatile LAS unsigned* st) {
    XcdBarrier b; b.bar = bar; b.x = xb_xcc_id(); b.st = st;
    if (threadIdx.x == 0) (void)xb_add(&bar[XB_XCNT(b.x)], 1u);
    return b;
}
__device__ __forceinline__ void xcd_barrier_complete(unsigned* bar, unsigned x, unsigned& nloc, unsigned& nx) {
    const unsigned G = gridDim.x * gridDim.y * gridDim.z;
    unsigned sum, cnt, mine, sp = 0u;
    for (;;) {
        sum = 0u; cnt = 0u; mine = 0u;
#pragma unroll
        for (unsigned j = 0; j < 16; ++j) { const unsigned c = xb_ld(&bar[XB_XCNT(j)]); sum += c; cnt += (c > 0u) ? 1u : 0u; mine = (j == x) ? c : mine; }
        if (sum == G) break;
        __builtin_amdgcn_s_sleep(1);
        if ((++sp & 255u) == 0u) { if (xb_ld(&bar[XB_TMO])) break; if (sp > XB_SPIN_CAP) { atomicAdd(&bar[XB_TMO], 1u); break; } }
    }
    nloc = mine > 0u ? mine : 1u; nx = cnt > 0u ? cnt : 1u;
}
__device__ __forceinline__ void xcd_barrier(const XcdBarrier& b) {
    asm volatile("s_waitcnt vmcnt(0)" ::: "memory");
    __syncthreads();
    if (threadIdx.x == 0) {
        unsigned* bar = b.bar;
        __builtin_amdgcn_s_waitcnt(0);
        unsigned nloc = b.st[0], nx = b.st[1];
        if (nloc == 0u) { xcd_barrier_complete(bar, b.x, nloc, nx); b.st[0] = nloc; b.st[1] = nx; }
        const unsigned old = xb_add(&bar[XB_XSUB(b.x)], 1u);
        const unsigned gen = old / nloc;
        if (old + 1u == (gen + 1u) * nloc) {
            __builtin_amdgcn_fence(__ATOMIC_RELEASE, "agent");
            asm volatile("s_waitcnt vmcnt(0)" ::: "memory");
            const unsigned og = xb_add(&bar[XB_TOP], 1u);
            const unsigned tg = og / nx;
            if (og + 1u == (tg + 1u) * nx) xb_add(&bar[XB_TOPGEN], 1u);
            else XB_SPIN(xb_ld(&bar[XB_TOPGEN]) == tg, bar);
            __builtin_amdgcn_fence(__ATOMIC_ACQUIRE, "agent");
            xb_add(&bar[XB_XGEN(b.x)], 1u);
            asm volatile("s_waitcnt vmcnt(0)" ::: "memory");
        } else {
            XB_SPIN(xb_ld(&bar[XB_XGEN(b.x)]) == gen, bar);
            __builtin_amdgcn_fence(__ATOMIC_ACQUIRE, "agent");
            asm volatile("s_waitcnt vmcnt(0)" ::: "memory");
        }
    }
    __syncthreads();
}

struct Frame {
    LAS unsigned char* lds;
    gu32* ctl;
    int tid, lane, wave, vcu, G;
    unsigned char* ws;
};
__device__ __forceinline__ float wave_sum(float v) {
#pragma unroll
    for (int o = 1; o < 64; o <<= 1) v += __shfl_xor(v, o);
    return v;
}

template <int MODE> __device__ __forceinline__ int dst_row(int n) {
    if (MODE == 1) {
        if (n < 1024) return n;
        if (n < 3072) { const int ch = (n - 1024) & 1023; return 1024 + (ch >> 7) * 256 + (n < 2048 ? 0 : 128) + (ch & 127); }
        if (n < 5120) { const int base = n < 4096 ? 3072 : 4096, r = n - base, h = r >> 6, d = r & 63; return base + 64 * h + 2 * (d & 31) + (d >> 5); }
        return n;
    }
    if (MODE == 2) return n < 1024 ? 2 * n : 2 * (n - 1024) + 1;
    if (MODE == 3) { const int ch = n & 1023; return (ch >> 7) * 256 + (n < 1024 ? 0 : 128) + (ch & 127); }
    return n;
}
template <int MODE> __device__ __forceinline__ void p0_transpose_item(const float* W, int K, int N, bf16* WT, const float* g, LAS float* scr, int item, int lane) {
    const int nblk = N / 32, kb = item / nblk, nb = item % nblk, k0 = 64 * kb, n0 = 32 * nb;
#pragma unroll 8
    for (int i = 0; i < 32; ++i) { const int kk = 2 * i + (lane >> 5); float v = W[(size_t)(k0 + kk) * N + n0 + (lane & 31)]; if (g) v *= g[k0 + kk]; scr[kk * 33 + (lane & 31)] = v; }
    LDS_WAIT(); asm volatile("" ::: "memory");
    const int c = lane & 7;
#pragma unroll
    for (int j = 0; j < 4; ++j) { const int n = (lane >> 3) + 8 * j; const LAS float* s = scr + (8 * c) * 33 + n;
        v4u o; o.x = cvt_pk_bf16(s[0 * 33], s[1 * 33]); o.y = cvt_pk_bf16(s[2 * 33], s[3 * 33]); o.z = cvt_pk_bf16(s[4 * 33], s[5 * 33]); o.w = cvt_pk_bf16(s[6 * 33], s[7 * 33]);
        *(GAS v4u*)(WT + (size_t)dst_row<MODE>(n0 + n) * K + k0 + 8 * c) = o; }
    LDS_WAIT(); asm volatile("" ::: "memory");
}

template <int MODE> __device__ __forceinline__ void p0_transpose_task(const float* W, int N, bf16* WT, const float* g, int task, int lane) {
    const int nblk = N / 64, kb = task / nblk, nb = task % nblk, kq = lane >> 4, n4 = lane & 15, k0 = 64 * kb + 16 * kq, n = 64 * nb + 4 * n4;
    const float* src = W + (size_t)k0 * N + n;
    f32x4 v[16];
#pragma unroll
    for (int i = 0; i < 16; ++i) v[i] = __builtin_nontemporal_load((const f32x4*)(src + (size_t)i * N));
    if (g) {
#pragma unroll
        for (int i = 0; i < 16; i += 4) { const f32x4 g4 = *(const f32x4*)(g + k0 + i); v[i] *= g4.x; v[i + 1] *= g4.y; v[i + 2] *= g4.z; v[i + 3] *= g4.w; }
    }
#pragma unroll
    for (int e = 0; e < 4; ++e) { bf16* dst = WT + (size_t)dst_row<MODE>(n + e) * 1024 + k0;
#pragma unroll
        for (int c = 0; c < 2; ++c) { v4u o; o.x = cvt_pk_bf16(v[8 * c][e], v[8 * c + 1][e]); o.y = cvt_pk_bf16(v[8 * c + 2][e], v[8 * c + 3][e]); o.z = cvt_pk_bf16(v[8 * c + 4][e], v[8 * c + 5][e]); o.w = cvt_pk_bf16(v[8 * c + 6][e], v[8 * c + 7][e]);
            *(GAS v4u*)(dst + 8 * c) = o; } }
}
template <int MODE> __device__ __forceinline__ void p0_transpose_task8(const float* W, int N, unsigned char* WT, const float* g, int task, int lane) {
    const int nblk = N / 64, kb = task / nblk, nb = task % nblk, kq = lane >> 4, n4 = lane & 15, k0 = 64 * kb + 16 * kq, n = 64 * nb + 4 * n4;
    const float* src = W + (size_t)k0 * N + n;
    f32x4 v[16];
#pragma unroll
    for (int i = 0; i < 16; ++i) v[i] = __builtin_nontemporal_load((const f32x4*)(src + (size_t)i * N));
#pragma unroll
    for (int i = 0; i < 16; i += 4) { f32x4 g4 = (f32x4){32.0f, 32.0f, 32.0f, 32.0f}; if (g) g4 = *(const f32x4*)(g + k0 + i) * 32.0f; v[i] *= g4.x; v[i + 1] *= g4.y; v[i + 2] *= g4.z; v[i + 3] *= g4.w; }
#pragma unroll
    for (int e = 0; e < 4; ++e) { unsigned char* dst = WT + (size_t)dst_row<MODE>(n + e) * 1024 + k0; v4u o;
#define PK8(j) ({ int w_ = 0; w_ = __builtin_amdgcn_cvt_pk_fp8_f32(v[4 * (j)][e], v[4 * (j) + 1][e], w_, false); w_ = __builtin_amdgcn_cvt_pk_fp8_f32(v[4 * (j) + 2][e], v[4 * (j) + 3][e], w_, true); (unsigned)w_; })
        o.x = PK8(0); o.y = PK8(1); o.z = PK8(2); o.w = PK8(3);
#undef PK8
        *(GAS v4u*)dst = o; }
}

using pg8::Unit; using pg8::bf16_t;
struct DensePol {
    static constexpr bool GATHER = false;
    const void* A; const void* Bt; int nM, nN, G, c; int esz  , split, off0, off1;
    __device__ __forceinline__ bool next(int i, Unit& u) const { u.e = 0; u.rt = 0; int j; if (!pg8::tile_order(i, G, c, nM, nN, u.pm, j)) return false; u.pn = j < split ? j + off0 : j + off1; return true; }
    __device__ __forceinline__ const char* a_base(const Unit& u) const { return (const char*)A + (size_t)u.pm * 256 * 1024 * esz; }
    __device__ __forceinline__ const char* b_base(const Unit& u) const { return (const char*)Bt + (size_t)u.pn * 256 * 1024 * esz; }
    __device__ __forceinline__ int gather(const Unit&, int) const { return 0; }
};
struct MoePol1 {
    static constexpr bool GATHER = true;
    const void* A; const void* Bt; const int* etok; const LAS int* tab; const LAS int* ul; int nul;
    __device__ __forceinline__ bool next(int i, Unit& u) const { if (i >= nul) return false; const LAS int* p = ul + 4 * i; u.pm = p[0]; u.pn = p[1]; u.e = p[2]; u.rt = p[3]; return true; }
    __device__ __forceinline__ const char* a_base(const Unit&) const { return (const char*)A; }
    __device__ __forceinline__ const char* b_base(const Unit& u) const { return (const char*)Bt + ((size_t)u.e * 2048 + (size_t)u.pn * 256) * 1024; }
    __device__ __forceinline__ int gather(const Unit& u, int r) const { const int pos = u.rt * 256 + r; return pos < tab[u.e] ? etok[u.e * 32768 + pos] : 0; }
};
struct MoePol2 {
    static constexpr bool GATHER = false;
    const void* A; const void* Bt; const LAS int* ul; int nul;
    __device__ __forceinline__ bool next(int i, Unit& u) const { const int k = i; if (k >= nul) return false; const LAS int* p = ul + 4 * k; u.pm = p[0]; u.pn = p[1]; u.e = p[2]; u.rt = p[3]; return true; }
    __device__ __forceinline__ const char* a_base(const Unit& u) const { return (const char*)A + (size_t)u.pm * 256 * 1024; }
    __device__ __forceinline__ const char* b_base(const Unit& u) const { return (const char*)Bt + ((size_t)u.e * 1024 + (size_t)u.pn * 256) * 1024; }
    __device__ __forceinline__ int gather(const Unit&, int) const { return 0; }
};

__device__ __forceinline__ int moe_unit_list(LAS int* ul, const LAS int* tab, int ncol, int G, int c, int tid) {
    const int T = tab[65], nun = T * ncol; const int nul = (c < nun) ? (nun - 1 - c) / G + 1 : 0;
    if (tid < nul && tid < 64) { int g, pn; pg8::tile_order(tid, G, c, T, ncol, g, pn); int e = 0;
        for (int k = 1; k < 32; ++k) e += (tab[32 + k] <= g) ? 1 : 0;
        ul[4 * tid + 0] = g; ul[4 * tid + 1] = pn; ul[4 * tid + 2] = e; ul[4 * tid + 3] = g - tab[32 + e]; }
    return nul < 64 ? nul : 64;
}

typedef pg8::f32x4 (AccT)[2][2][4][2];
__device__ __forceinline__ float sigmoidf_(float x) { return __builtin_amdgcn_rcpf(1.0f + __builtin_amdgcn_exp2f(x * -1.4426950408889634f)); }

struct EpiInProj {
    static constexpr bool PERM = true;
    bf16_t *CB, *U, *Q, *Kb, *V, *GC, *GA; const float* cosT; const float* sinT; float* ksum; float asc;
    __device__ __forceinline__ void operator()(const AccT& acc, const Unit& u, int wr, int wc, int fr, int fq) const {
        using pg8::u32x4; using pg8::u32x2; using pg8::f32x4;
        const int pn = u.pn, row0_ = u.pm * 256 + wr * 64 + fr, cl = wc * 32 + 8 * fq;
        int row0 = row0_;
        if (pn < 4 || (pn >= 20 && pn < 24)) {
            asm volatile("" : "+v"(row0));
            bf16_t* base = (pn < 4) ? CB : V; const int col0 = (pn & 3) * 256 + cl;
#pragma unroll
            for (int ai = 0; ai < 2; ++ai)
#pragma unroll
                for (int m = 0; m < 4; ++m) { bf16_t* rowp = base + (size_t)(row0 + ai * 128 + m * 16) * 1024 + col0;
#pragma unroll
                    for (int bj = 0; bj < 2; ++bj) { const f32x4 v0 = acc[ai][bj][m][0] * asc, v1 = acc[ai][bj][m][1] * asc; u32x4 w;
                        w.x = cvt_pk_bf16(v0[0], v0[1]); w.y = cvt_pk_bf16(v0[2], v0[3]); w.z = cvt_pk_bf16(v1[0], v1[1]); w.w = cvt_pk_bf16(v1[2], v1[3]);
                        *(u32x4*)(rowp + bj * 128) = w; } }
        } else if (pn >= 24) {
            asm volatile("" : "+v"(row0));
            bf16_t* base = (pn < 28) ? GC : GA; const int col0 = (pn & 3) * 256 + cl;
#pragma unroll
            for (int ai = 0; ai < 2; ++ai)
#pragma unroll
                for (int m = 0; m < 4; ++m) { bf16_t* rowp = base + (size_t)(row0 + ai * 128 + m * 16) * 1024 + col0;
#pragma unroll
                    for (int bj = 0; bj < 2; ++bj) { const f32x4 v0 = acc[ai][bj][m][0] * asc, v1 = acc[ai][bj][m][1] * asc; u32x4 w;
                        w.x = cvt_pk_bf16(sigmoidf_(v0[0]), sigmoidf_(v0[1])); w.y = cvt_pk_bf16(sigmoidf_(v0[2]), sigmoidf_(v0[3]));
                        w.z = cvt_pk_bf16(sigmoidf_(v1[0]), sigmoidf_(v1[1])); w.w = cvt_pk_bf16(sigmoidf_(v1[2]), sigmoidf_(v1[3]));
                        *(u32x4*)(rowp + bj * 128) = w; } }
        } else if (pn < 12) {
            asm volatile("" : "+v"(row0));
            const int ch0 = (pn - 4) * 128 + cl;
#pragma unroll
            for (int ai = 0; ai < 2; ++ai)
#pragma unroll
                for (int m = 0; m < 4; ++m) { bf16_t* rowp = U + (size_t)(row0 + ai * 128 + m * 16) * 1024 + ch0;
                    const f32x4 a0 = acc[ai][0][m][0], a1 = acc[ai][0][m][1], b0 = acc[ai][1][m][0], b1 = acc[ai][1][m][1]; u32x4 w;
                    w.x = cvt_pk_bf16(a0[0] * b0[0], a0[1] * b0[1]); w.y = cvt_pk_bf16(a0[2] * b0[2], a0[3] * b0[3]); w.z = cvt_pk_bf16(a1[0] * b1[0], a1[1] * b1[1]); w.w = cvt_pk_bf16(a1[2] * b1[2], a1[3] * b1[3]);
                    *(u32x4*)rowp = w; }
        } else {
            asm volatile("" : "+v"(row0));
            const bool isq = pn < 16; bf16_t* base = isq ? Q : Kb; const int col0 = (pn & 3) * 256 + cl; const float sc = (isq ? C2 : 1.0f) * asc;
            const int i0 = 16 * (wc & 1) + 4 * fq;
            float ks[2][8];
#pragma unroll
            for (int bj = 0; bj < 2; ++bj)
#pragma unroll
                for (int e = 0; e < 8; ++e) ks[bj][e] = 0.f;
#pragma unroll
            for (int ai = 0; ai < 2; ++ai) {
                f32x4 csv[4], snv[4];
#pragma unroll
                for (int m = 0; m < 4; ++m) { const int pos = (row0 + ai * 128 + m * 16) & (SEQ - 1); csv[m] = *(const f32x4*)(cosT + pos * 32 + i0); snv[m] = *(const f32x4*)(sinT + pos * 32 + i0); }
                asm volatile("" ::: "memory");
#pragma unroll
                for (int m = 0; m < 4; ++m)
#pragma unroll
                    for (int bj = 0; bj < 2; ++bj) { const int row = row0 + ai * 128 + m * 16;
                        const f32x4 cs = csv[m], sn = snv[m];
                        bf16_t* rowp = base + (size_t)row * 1024 + col0 + bj * 128;
                        const f32x4 v0 = acc[ai][bj][m][0], v1 = acc[ai][bj][m][1]; float o[8];
                        o[0] = (v0[0] * cs[0] - v0[1] * sn[0]) * sc; o[1] = (v0[1] * cs[0] + v0[0] * sn[0]) * sc;
                        o[2] = (v0[2] * cs[1] - v0[3] * sn[1]) * sc; o[3] = (v0[3] * cs[1] + v0[2] * sn[1]) * sc;
                        o[4] = (v1[0] * cs[2] - v1[1] * sn[2]) * sc; o[5] = (v1[1] * cs[2] + v1[0] * sn[2]) * sc;
                        o[6] = (v1[2] * cs[3] - v1[3] * sn[3]) * sc; o[7] = (v1[3] * cs[3] + v1[2] * sn[3]) * sc;
#pragma unroll
                        for (int e = 0; e < 8; ++e) { ks[bj][e] += o[e]; asm volatile("" : "+v"(ks[bj][e])); }
                        u32x4 w; w.x = cvt_pk_bf16(o[0], o[1]); w.y = cvt_pk_bf16(o[2], o[3]); w.z = cvt_pk_bf16(o[4], o[5]); w.w = cvt_pk_bf16(o[6], o[7]);
                        *(u32x4*)(rowp) = w; }
                asm volatile("" ::: "memory");
            }
            if (!isq) {
#pragma unroll
                for (int bj = 0; bj < 2; ++bj)
#pragma unroll
                    for (int e = 0; e < 8; ++e) { float s = ks[bj][e]; s += __shfl_xor(s, 1); s += __shfl_xor(s, 2); s += __shfl_xor(s, 4); s += __shfl_xor(s, 8);
                        if (fr == 0) atomicAdd(ksum + (size_t)u.pm * 1024 + col0 + bj * 128 + e, s); }
            }
        }
    }
};
template <int MODE> struct EpiGate {
    static constexpr bool PERM = true;
    const bf16_t* G; const bf16_t* T1in; bf16_t* O; float asc;
    __device__ __forceinline__ void operator()(const AccT& acc, const Unit& u, int wr, int wc, int fr, int fq) const {
        using pg8::u32x4; using pg8::f32x4;
        asm volatile("" : "+v"(fr), "+v"(fq));
        const int row0 = u.pm * 256 + wr * 64 + fr, col0 = u.pn * 256 + wc * 32 + 8 * fq;
#pragma unroll
        for (int ai = 0; ai < 2; ++ai) {
            u32x4 gg[4][2], tt[4][2];
#pragma unroll
            for (int m = 0; m < 4; ++m)
#pragma unroll
                for (int bj = 0; bj < 2; ++bj) { const size_t off = (size_t)(row0 + ai * 128 + m * 16) * 1024 + col0 + bj * 128;
                    gg[m][bj] = *(const u32x4*)(G + off); if (MODE == 1) tt[m][bj] = *(const u32x4*)(T1in + off); }
            asm volatile("" ::: "memory");
#pragma unroll
            for (int m = 0; m < 4; ++m)
#pragma unroll
                for (int bj = 0; bj < 2; ++bj) { const size_t off = (size_t)(row0 + ai * 128 + m * 16) * 1024 + col0 + bj * 128;
                    const f32x4 v0 = acc[ai][bj][m][0] * asc, v1 = acc[ai][bj][m][1] * asc; const u32x4 g = gg[m][bj]; float o[8];
                    o[0] = bf_lo(g.x) * v0[0]; o[1] = bf_hi(g.x) * v0[1]; o[2] = bf_lo(g.y) * v0[2]; o[3] = bf_hi(g.y) * v0[3];
                    o[4] = bf_lo(g.z) * v1[0]; o[5] = bf_hi(g.z) * v1[1]; o[6] = bf_lo(g.w) * v1[2]; o[7] = bf_hi(g.w) * v1[3];
                    if (MODE == 1) { const u32x4 t = tt[m][bj];
                        o[0] += bf_lo(t.x); o[1] += bf_hi(t.x); o[2] += bf_lo(t.y); o[3] += bf_hi(t.y); o[4] += bf_lo(t.z); o[5] += bf_hi(t.z); o[6] += bf_lo(t.w); o[7] += bf_hi(t.w); }
                    u32x4 w; w.x = cvt_pk_bf16(o[0], o[1]); w.y = cvt_pk_bf16(o[2], o[3]); w.z = cvt_pk_bf16(o[4], o[5]); w.w = cvt_pk_bf16(o[6], o[7]);
                    *(u32x4*)(O + off) = w; }
            asm volatile("" ::: "memory");
        }
    }
};
struct EpiResid {
    static constexpr bool PERM = false;
    const float* X; float* H;
    __device__ __forceinline__ void operator()(const AccT& acc, const Unit& u, int wr, int wc, int fr, int fq) const {
        using pg8::f32x4;
        asm volatile("" : "+v"(fr), "+v"(fq));
        const int row0 = u.pm * 256 + wr * 64 + fr, col0 = u.pn * 256 + wc * 32 + 4 * fq;
#pragma unroll
        for (int ai = 0; ai < 2; ++ai) {
            f32x4 xv[4][2][2];
#pragma unroll
            for (int m = 0; m < 4; ++m)
#pragma unroll
                for (int bj = 0; bj < 2; ++bj)
#pragma unroll
                    for (int n = 0; n < 2; ++n) xv[m][bj][n] = *(const f32x4*)(X + (size_t)(row0 + ai * 128 + m * 16) * 1024 + col0 + bj * 128 + n * 16);
            asm volatile("" ::: "memory");
#pragma unroll
            for (int m = 0; m < 4; ++m)
#pragma unroll
                for (int bj = 0; bj < 2; ++bj)
#pragma unroll
                    for (int n = 0; n < 2; ++n) *(f32x4*)(H + (size_t)(row0 + ai * 128 + m * 16) * 1024 + col0 + bj * 128 + n * 16) = xv[m][bj][n] + acc[ai][bj][m][n];
            asm volatile("" ::: "memory");
        }
    }
};
struct EpiSwiglu {
    static constexpr bool PERM = true;
    const float* bgu; const float* erstd; unsigned char* ACT;
    __device__ __forceinline__ float act1(float g, float up) const { g = fminf(g, 7.0f); up = fminf(fmaxf(up, -7.0f), 7.0f); return (up + 1.0f) * (g * sigmoidf_(1.702f * g)); }
    __device__ __forceinline__ void operator()(const AccT& acc, const Unit& u, int wr, int wc, int fr, int fq) const {
        using pg8::u32x2; using pg8::f32x4;
        asm volatile("" : "+v"(fr), "+v"(fq));
        const int row0 = u.pm * 256 + wr * 64 + fr, ch0 = u.pn * 128 + wc * 32 + 8 * fq;
        const float* bg = bgu + (size_t)u.e * 2048; const float* rsp = erstd + (size_t)u.e * 32768 + u.rt * 256 + wr * 64 + fr;
        f32x4 bgv[2], buv[2];
#pragma unroll
        for (int n = 0; n < 2; ++n) { bgv[n] = *(const f32x4*)(bg + ch0 + 4 * n); buv[n] = *(const f32x4*)(bg + 1024 + ch0 + 4 * n); }
        float rss[2][4];
#pragma unroll
        for (int ai = 0; ai < 2; ++ai)
#pragma unroll
            for (int m = 0; m < 4; ++m) rss[ai][m] = rsp[ai * 128 + m * 16];
        asm volatile("" ::: "memory");
#pragma unroll
        for (int ai = 0; ai < 2; ++ai)
#pragma unroll
            for (int m = 0; m < 4; ++m) { unsigned char* rowp = ACT + (size_t)(row0 + ai * 128 + m * 16) * 1024 + ch0; const float rs = rss[ai][m] * (1.0f / 32.0f);
                float a8[8];
#pragma unroll
                for (int n = 0; n < 2; ++n) { const f32x4 g4 = acc[ai][0][m][n] * rs + bgv[n], u4 = acc[ai][1][m][n] * rs + buv[n];
                    a8[4 * n + 0] = act1(g4[0], u4[0]); a8[4 * n + 1] = act1(g4[1], u4[1]); a8[4 * n + 2] = act1(g4[2], u4[2]); a8[4 * n + 3] = act1(g4[3], u4[3]); }
                int w0 = 0, w1 = 0;
                w0 = __builtin_amdgcn_cvt_pk_fp8_f32(a8[0], a8[1], w0, false); w0 = __builtin_amdgcn_cvt_pk_fp8_f32(a8[2], a8[3], w0, true);
                w1 = __builtin_amdgcn_cvt_pk_fp8_f32(a8[4], a8[5], w1, false); w1 = __builtin_amdgcn_cvt_pk_fp8_f32(a8[6], a8[7], w1, true);
                u32x2 w; w.x = (unsigned)w0; w.y = (unsigned)w1; *(u32x2*)rowp = w; }
    }
};
struct EpiDown {
    static constexpr bool PERM = true;
    const float* bd; const float* ewt; unsigned char* Y;
    __device__ __forceinline__ void operator()(const AccT& acc, const Unit& u, int wr, int wc, int fr, int fq) const {
        using pg8::u32x4; using pg8::f32x4;
        asm volatile("" : "+v"(fr), "+v"(fq));
        const int rl0 = wr * 64 + fr, col0 = u.pn * 256 + wc * 32 + 8 * fq;
        const float* b = bd + (size_t)u.e * 1024 + col0; const float* wp = ewt + (size_t)u.e * 32768 + u.rt * 256 + rl0;
        f32x4 bv[2][2]; float wts[2][4];
#pragma unroll
        for (int bj = 0; bj < 2; ++bj)
#pragma unroll
            for (int n = 0; n < 2; ++n) bv[bj][n] = *(const f32x4*)(b + bj * 128 + 4 * n);
#pragma unroll
        for (int ai = 0; ai < 2; ++ai)
#pragma unroll
            for (int m = 0; m < 4; ++m) wts[ai][m] = wp[ai * 128 + m * 16];
        asm volatile("" ::: "memory");
#pragma unroll
        for (int ai = 0; ai < 2; ++ai)
#pragma unroll
            for (int m = 0; m < 4; ++m) { const int rl = rl0 + ai * 128 + m * 16; const float wt = wts[ai][m] * 16.0f; unsigned char* rowp = Y + (size_t)(u.pm * 256 + rl) * 1024 + col0;
#pragma unroll
                for (int bj = 0; bj < 2; ++bj) { const f32x4 v0 = (acc[ai][bj][m][0] * (1.0f / 32.0f) + bv[bj][0]) * wt, v1 = (acc[ai][bj][m][1] * (1.0f / 32.0f) + bv[bj][1]) * wt;
                    int w0 = 0, w1 = 0; w0 = __builtin_amdgcn_cvt_pk_fp8_f32(v0[0], v0[1], w0, false); w0 = __builtin_amdgcn_cvt_pk_fp8_f32(v0[2], v0[3], w0, true);
                    w1 = __builtin_amdgcn_cvt_pk_fp8_f32(v1[0], v1[1], w1, false); w1 = __builtin_amdgcn_cvt_pk_fp8_f32(v1[2], v1[3], w1, true);
                    pg8::u32x2 w; w.x = (unsigned)w0; w.y = (unsigned)w1; *(pg8::u32x2*)(rowp + bj * 128) = w; } }
    }
};

typedef short bf16x8_t __attribute__((ext_vector_type(8)));
typedef short s16x4_t __attribute__((ext_vector_type(4)));
typedef short v4i16_t __attribute__((ext_vector_type(4)));
__device__ __forceinline__ int crow(int r, int hi) { return (r & 3) + 8 * (r >> 2) + 4 * hi; }
__device__ __forceinline__ s16x4_t vtr(const LAS unsigned char* p) { return __builtin_bit_cast(s16x4_t, __builtin_amdgcn_ds_read_tr16_b64_v4i16((LAS v4i16_t*)p)); }
constexpr int ATT_K = 0, ATT_V = 32768, ATT_Q = 65536, ATT_STG = 98304;
constexpr int UMETA_OFF = LDSCTL_OFF + 1024, WSC_OFF = LDSCTL_OFF + 2048;
constexpr int ALIST_BH = 256 * 2016;
__device__ __forceinline__ int alist_off(int j) { return 256 * (63 * j - (j * (j - 1)) / 2); }
__device__ __forceinline__ void attn_dma_k(LAS unsigned char* lds, const bf16* Kb, size_t rowbase, int h, int wave, int lane) {
#pragma unroll
    for (int i = 0; i < 4; ++i) { const bf16* ks = Kb + (rowbase + (size_t)(i * 64 + lane)) * 1024 + h * 64 + wave * 8;
        __builtin_amdgcn_global_load_lds((const unsigned*)ks, (LAS unsigned*)(lds + ATT_K + wave * 4096 + i * 1024), 16, 0, 0); }
}
__device__ __forceinline__ void attn_dma_v(LAS unsigned char* lds, const bf16* Vb, size_t rowbase, int h, int wave, int lane) {
#pragma unroll
    for (int i = 0; i < 4; ++i) { const int vi = wave * 4 + i, dh = vi >> 4, kg = vi & 15;
        const bf16* vs = Vb + (rowbase + (size_t)(kg * 16 + (lane >> 2))) * 1024 + h * 64 + dh * 32 + (lane & 3) * 8;
        __builtin_amdgcn_global_load_lds((const unsigned*)vs, (LAS unsigned*)(lds + ATT_V + dh * 16384 + kg * 1024), 16, 0, 0); }
}
__device__ __forceinline__ void attn_dma_q(LAS unsigned char* lds, const bf16* qrowp, int wave, int lane) {
#pragma unroll
    for (int i = 0; i < 4; ++i)
        __builtin_amdgcn_global_load_lds((const unsigned*)(qrowp + (2 * i + (lane >> 5)) * 8), (LAS unsigned*)(lds + ATT_Q + wave * 4096 + i * 1024), 16, 0, 0);
}
#define ATT_QKT(s, qr, nkt) do { _Pragma("unroll") for (int kt = 0; kt < 8; ++kt) { \
        if (kt < (nkt)) { s[kt] = (f32x16){0.f,0.f,0.f,0.f,0.f,0.f,0.f,0.f,0.f,0.f,0.f,0.f,0.f,0.f,0.f,0.f}; \
            _Pragma("unroll") for (int d0 = 0; d0 < 4; ++d0) { const bf16x8_t kf = *(const LAS bf16x8_t*)(F.lds + ATT_K + (2 * d0 + hi) * 4096 + (kt * 32 + r32) * 16); \
                s[kt] = __builtin_amdgcn_mfma_f32_32x32x16_bf16(kf, qr[d0], s[kt], 0, 0, 0); } } \
        else { _Pragma("unroll") for (int r = 0; r < 16; ++r) s[kt][r] = -INFINITY; } } } while (0)
#define ATT_PV(o, s, nkt) do { _Pragma("unroll") for (int kt = 0; kt < 8; ++kt) { if (kt < (nkt)) { _Pragma("unroll") for (int k2 = 0; k2 < 2; ++k2) { \
        v4u pw; pw.x = cvt_pk_bf16(s[kt][8 * k2 + 0], s[kt][8 * k2 + 1]); pw.y = cvt_pk_bf16(s[kt][8 * k2 + 2], s[kt][8 * k2 + 3]); \
        pw.z = cvt_pk_bf16(s[kt][8 * k2 + 4], s[kt][8 * k2 + 5]); pw.w = cvt_pk_bf16(s[kt][8 * k2 + 6], s[kt][8 * k2 + 7]); \
        const bf16x8_t pa = __builtin_bit_cast(bf16x8_t, pw); \
        _Pragma("unroll") for (int dh = 0; dh < 2; ++dh) { const LAS unsigned char* vp = vb + dh * 16384 + (kt * 2 + k2) * 1024; \
            const s16x4_t lo = vtr(vp), hi4 = vtr(vp + 512); \
            const bf16x8_t vf = (bf16x8_t){lo[0], lo[1], lo[2], lo[3], hi4[0], hi4[1], hi4[2], hi4[3]}; \
            o[dh] = __builtin_amdgcn_mfma_f32_32x32x16_bf16(pa, vf, o[dh], 0, 0, 0); } } } } } while (0)

constexpr int SIDE_GU = 32 * 64 * 32, SIDE_D = 32 * 64 * 16, SIDE_TASKS = SIDE_GU + SIDE_D;
struct SideSrc { const float* src; int N; };
__device__ __forceinline__ void side_issue(int task, const float* w_gu, const float* w_d, int lane, float (&sv)[16]) {
    const float* src; int N;
    if (task < SIDE_GU) { const int e = task >> 11, r = task & 2047, kb = r >> 5, nb = r & 31; N = 2048; src = w_gu + (size_t)e * 1024 * 2048 + (size_t)(kb * 16) * 2048 + nb * 64 + lane; }
    else { const int t2 = task - SIDE_GU, e = t2 >> 10, r = t2 & 1023, kb = r >> 4, nb = r & 15; N = 1024; src = w_d + (size_t)e * 1024 * 1024 + (size_t)(kb * 16) * 1024 + nb * 64 + lane; }
#pragma unroll
    for (int i = 0; i < 16; ++i) sv[i] = __builtin_nontemporal_load(src + (size_t)i * N);
}
__device__ __forceinline__ void side_finish(int task, bool real, unsigned char* dummy, unsigned char* Wgu8, unsigned char* Wd8, int lane, const float (&sv)[16]) {
    unsigned char* dst;
    if (task < SIDE_GU) { const int e = task >> 11, r = task & 2047, kb = r >> 5, nb = r & 31, n = nb * 64 + lane; dst = Wgu8 + ((size_t)e * 2048 + dst_row<3>(n)) * 1024 + kb * 16; }
    else { const int t2 = task - SIDE_GU, e = t2 >> 10, r = t2 & 1023, kb = r >> 4, nb = r & 15, n = nb * 64 + lane; dst = Wd8 + ((size_t)e * 1024 + n) * 1024 + kb * 16; }
    v4u o;
#define PK8(j) ({ int w_ = 0; w_ = __builtin_amdgcn_cvt_pk_fp8_f32(sv[4 * (j)] * 32.0f, sv[4 * (j) + 1] * 32.0f, w_, false); w_ = __builtin_amdgcn_cvt_pk_fp8_f32(sv[4 * (j) + 2] * 32.0f, sv[4 * (j) + 3] * 32.0f, w_, true); (unsigned)w_; })
    o.x = PK8(0); o.y = PK8(1); o.z = PK8(2); o.w = PK8(3);
#undef PK8
    if (!real) dst = dummy + lane * 16;
    *(GAS v4u*)dst = o;
}

#define ATT_WB(wait) asm volatile("s_waitcnt " wait "\n\ts_barrier" ::: "memory")
template <bool OWN>
__device__ __forceinline__ void attn_phase(Frame& F, const bf16* Qb, const bf16* Kb, const bf16* Vb, bf16* PO, float* PML, const unsigned short* alist, gu32* acnt, bf16* ATTO,
                                           const float* w_gu, const float* w_d, const float* g_ffn, unsigned char* Wgu8, unsigned char* Wd8) {
    const int r32 = F.lane & 31, hi = F.lane >> 5, wave = F.wave;
    LAS int* um = (LAS int*)(F.lds + UMETA_OFF);
    LAS float* wsc = (LAS float*)(F.lds + WSC_OFF + wave * 1024);
    const LAS unsigned char* vb = F.lds + ATT_V + ((F.lane >> 4) & 1) * 32 + (F.lane & 3) * 8 + (4 * hi + ((F.lane & 15) >> 2)) * 64;
    int nul = 0;
    __syncthreads();
    if (!OWN) {
        LAS int* pfx = (LAS int*)(F.lds + ATT_STG);
        int c4[4]; int sum = 0;
#pragma unroll
        for (int i = 0; i < 4; ++i) { c4[i] = ((int)__hip_atomic_load(acnt + F.tid * 4 + i, RLX_AGENT) + 255) >> 8; sum += c4[i]; }
        int inc = sum;
#pragma unroll
        for (int o = 1; o < 64; o <<= 1) { const int v = __shfl_up(inc, o); if (F.lane >= o) inc += v; }
        LAS int* wt = pfx + 2064;
        if (F.lane == 63) wt[wave] = inc;
        __syncthreads();
        int base = 0;
        for (int w = 0; w < wave; ++w) base += wt[w];
        int ex = base + inc - sum;
#pragma unroll
        for (int i = 0; i < 4; ++i) { pfx[F.tid * 4 + i] = ex; ex += c4[i]; }
        if (F.tid == 511) pfx[2048] = ex;
        __syncthreads();
        const int NU = pfx[2048];
        const int u0 = (int)(((long)blockIdx.x * NU) / F.G), u1 = (int)(((long)(blockIdx.x + 1) * NU) / F.G);
        nul = u1 - u0; if (nul > 64) nul = 64;
        if (F.tid < nul) { const int u = u0 + F.tid; int lo_ = 0, hi_ = 2048;
            while (hi_ - lo_ > 1) { const int mid = (lo_ + hi_) >> 1; if (pfx[mid] <= u) lo_ = mid; else hi_ = mid; }
            const int chunk = u - pfx[lo_], cnt = (int)__hip_atomic_load(acnt + lo_, RLX_AGENT), rem = cnt - chunk * 256;
            um[F.tid * 4 + 0] = lo_; um[F.tid * 4 + 1] = chunk; um[F.tid * 4 + 2] = rem < 256 ? rem : 256; }
    } else {
        nul = ((int)blockIdx.x < 2048) ? (2047 - (int)blockIdx.x) / F.G + 1 : 0; if (nul > 64) nul = 64;
        if (F.tid < nul) { const int u = (int)blockIdx.x + F.tid * F.G; um[F.tid * 4 + 0] = u; um[F.tid * 4 + 1] = 0; um[F.tid * 4 + 2] = 256; }
    }
    __syncthreads();
    unsigned char* dummy = Wd8 + (size_t)(WS_SIDE_DUMMY - WS_WD) + (size_t)(F.vcu * 8 + wave) * 1024;
    int st_next = OWN ? SIDE_TASKS : (F.vcu * 8 + wave), st_cur = -1, st_cur1 = -1; const int st_step = F.G * 8; float sv[16], sv1[16];
    if (nul > 0) {
#define ATT_ENT(k) (OWN ? (unsigned)((((um[(k) * 4] & 63) * 256 + wave * 32 + r32) << 2) | 3) \
                        : (unsigned)alist[(size_t)(um[(k) * 4] >> 6) * ALIST_BH + alist_off(um[(k) * 4] & 63) + um[(k) * 4 + 1] * 256 + wave * 32 + r32])
#define ATT_ROWBASE(k) ((size_t)(um[(k) * 4] >> 10) * SEQ + (size_t)(um[(k) * 4] & 63) * 256)
#define ATT_H(k) ((um[(k) * 4] >> 6) & 15)
#define ATT_B(k) (um[(k) * 4] >> 10)
    unsigned ent0 = ATT_ENT(0), ent1 = (nul > 1) ? ATT_ENT(1) : 0u;
    attn_dma_k(F.lds, Kb, ATT_ROWBASE(0), ATT_H(0), wave, F.lane);
    attn_dma_q(F.lds, Qb + ((size_t)ATT_B(0) * SEQ + (ent0 >> 2)) * 1024 + ATT_H(0) * 64, wave, F.lane);
    asm volatile("" ::: "memory");
    attn_dma_v(F.lds, Vb, ATT_ROWBASE(0), ATT_H(0), wave, F.lane);
    for (int k = 0; k < nul; ++k) {
        const int b = ATT_B(k), h = ATT_H(k), jb = um[k * 4] & 63, nh = um[k * 4 + 2];
        const int t = (int)(ent0 >> 2), slot = (int)(ent0 & 3); const size_t qrow = (size_t)b * SEQ + t;
        const int qi = wave * 32 + r32; const bool valid = qi < nh;
        const bool same_prev = !OWN && k > 0 && um[(k - 1) * 4] == um[k * 4], same_next = !OWN && k + 1 < nul && um[(k + 1) * 4] == um[k * 4];
        if (!same_prev) { ATT_WB("vmcnt(4)"); }
        else { asm volatile("s_waitcnt vmcnt(0)" ::: "memory"); }
        bf16x8_t qr[4];
#pragma unroll
        for (int d0 = 0; d0 < 4; ++d0) qr[d0] = *(const LAS bf16x8_t*)(F.lds + ATT_Q + wave * 4096 + (2 * d0 + hi) * 512 + r32 * 16);
        int k2 = (k + 2 < nul) ? k + 2 : nul - 1; asm volatile("" : "+s"(k2));
        unsigned ent2 = OWN ? ((k + 2 < nul) ? ATT_ENT(k + 2) : 0u) : ATT_ENT(k2);
        bool st_r0 = false, st_r1 = false;
        if (!OWN) { st_r0 = st_next < SIDE_TASKS; st_cur = st_r0 ? st_next : SIDE_TASKS - 1; if (st_r0) st_next += st_step; side_issue(st_cur, w_gu, w_d, F.lane, sv);
            st_r1 = st_next < SIDE_TASKS; st_cur1 = st_r1 ? st_next : SIDE_TASKS - 1; if (st_r1) st_next += st_step; side_issue(st_cur1, w_gu, w_d, F.lane, sv1); }
        const int nv = OWN ? (jb < 3 ? jb : 3) : 0;
        const bool active = wave * 32 < nh;
        const int nkt = OWN ? wave + 1 : 8;
        f32x16 s[8];
        if (active) { ATT_QKT(s, qr, nkt); }
        if (!same_prev || !same_next) { if (OWN) { ATT_WB("vmcnt(0) lgkmcnt(0)"); } else { ATT_WB("vmcnt(33) lgkmcnt(0)"); } }
        else { asm volatile("s_waitcnt lgkmcnt(0)" ::: "memory"); }
        if (k + 1 < nul) { int ln_ = F.lane; asm volatile("" : "+v"(ln_)); if (!same_next) attn_dma_k(F.lds, Kb, ATT_ROWBASE(k + 1), ATT_H(k + 1), wave, ln_);
            attn_dma_q(F.lds, Qb + ((size_t)ATT_B(k + 1) * SEQ + (ent1 >> 2)) * 1024 + ATT_H(k + 1) * 64, wave, ln_); }
        float mx = -INFINITY, l = 0.f;
        f32x16 o[2]; o[0] = (f32x16){0.f,0.f,0.f,0.f,0.f,0.f,0.f,0.f,0.f,0.f,0.f,0.f,0.f,0.f,0.f,0.f}; o[1] = o[0];
        if (active) {
            if (OWN) {
#pragma unroll
                for (int kt = 0; kt < 8; ++kt) if (kt == wave) {
#pragma unroll
                    for (int r = 0; r < 16; ++r) s[kt][r] = (crow(r, hi) > r32) ? -INFINITY : s[kt][r]; }
            }
#pragma unroll
            for (int kt = 0; kt < 8; ++kt)
#pragma unroll
                for (int r = 0; r < 16; ++r) mx = fmaxf(mx, s[kt][r]);
            mx = fmaxf(mx, __shfl_xor(mx, 32));
            {
                typedef float f32x2_ __attribute__((ext_vector_type(2)));
                const f32x2_ nm = (f32x2_){-mx, -mx}; f32x2_ l2 = (f32x2_){0.f, 0.f};
#pragma unroll
                for (int kt = 0; kt < 8; ++kt)
#pragma unroll
                    for (int r = 0; r < 16; r += 2) { f32x2_ d = (f32x2_){s[kt][r], s[kt][r + 1]} + nm; d.x = __builtin_amdgcn_exp2f(d.x); d.y = __builtin_amdgcn_exp2f(d.y); s[kt][r] = d.x; s[kt][r + 1] = d.y; l2 += d; }
                l = l2.x + l2.y;
            }
            l += __shfl_xor(l, 32);
            ATT_PV(o, s, nkt);
        }
        if (!same_next) { ATT_WB("lgkmcnt(0)"); }
        else { asm volatile("s_waitcnt lgkmcnt(0)" ::: "memory"); }
        if (!OWN) { side_finish(st_cur, st_r0, dummy, Wgu8, Wd8, F.lane, sv); side_finish(st_cur1, st_r1, dummy, Wgu8, Wd8, F.lane, sv1); asm volatile("" ::: "memory"); }
        if (active) {
            LAS bf16* stg = (LAS bf16*)(F.lds + ATT_STG + wave * 4096);
            if (!OWN) {
                if (hi == 0) { wsc[r32] = 1.0f / l; ((LAS int*)wsc)[32 + r32] = valid ? (int)((qrow * 16 + h) * 3 + slot) : -1;
                    if (valid) { float* pm = PML + ((qrow * 16 + h) * 3 + slot) * 2; pm[0] = mx; pm[1] = l; } }
                LDS_WAIT(); asm volatile("" ::: "memory");
#pragma unroll
                for (int r = 0; r < 16; ++r) { const int orow = crow(r, hi); const float rl = wsc[orow];
#pragma unroll
                    for (int dh = 0; dh < 2; ++dh) stg[orow * 64 + dh * 32 + r32] = (bf16)(cvt_pk_bf16(o[dh][r] * rl, 0.f) & 0xffffu); }
                LDS_WAIT(); asm volatile("" ::: "memory");
#pragma unroll
                for (int i = 0; i < 4; ++i) { const int row = i * 8 + (F.lane >> 3), ch = F.lane & 7; const int pidx = ((LAS int*)wsc)[32 + row];
                    const v4u v = *(const LAS v4u*)(stg + row * 64 + ch * 8);
                    if (pidx >= 0) *(GAS v4u*)(PO + (size_t)pidx * 64 + ch * 8) = v; }
            } else {
                float pm_[3], pl_[3];
#pragma unroll
                for (int i = 0; i < 3; ++i) { pm_[i] = -INFINITY; pl_[i] = 0.f; if (i < nv) { const float* pm = PML + ((qrow * 16 + h) * 3 + i) * 2; pm_[i] = pm[0]; pl_[i] = pm[1]; } }
                float Mx = mx;
#pragma unroll
                for (int i = 0; i < 3; ++i) Mx = fmaxf(Mx, pm_[i]);
                const float aown = __builtin_amdgcn_exp2f(mx - Mx); float W = l * aown; float wi[3];
#pragma unroll
                for (int i = 0; i < 3; ++i) { wi[i] = pl_[i] * __builtin_amdgcn_exp2f(pm_[i] - Mx); W += wi[i]; }
                const float rW = 1.0f / W;
                if (hi == 0) { wsc[r32 * 4 + 0] = aown * rW; wsc[r32 * 4 + 1] = wi[0] * rW; wsc[r32 * 4 + 2] = wi[1] * rW; wsc[r32 * 4 + 3] = wi[2] * rW; }
                LDS_WAIT(); asm volatile("" ::: "memory");
#pragma unroll
                for (int r = 0; r < 16; ++r) { const int orow = crow(r, hi); const float c0 = wsc[orow * 4];
#pragma unroll
                    for (int dh = 0; dh < 2; ++dh) stg[orow * 64 + dh * 32 + r32] = (bf16)(cvt_pk_bf16(o[dh][r] * c0, 0.f) & 0xffffu); }
                LDS_WAIT(); asm volatile("" ::: "memory");
                const size_t grow0 = (size_t)b * SEQ + jb * 256 + wave * 32;
                v4u pp[4][3];
#pragma unroll
                for (int i = 0; i < 4; ++i)
#pragma unroll
                    for (int sl = 0; sl < 3; ++sl) { pp[i][sl] = (v4u){0u, 0u, 0u, 0u};
                        if (sl < nv) pp[i][sl] = *(const GAS v4u*)(PO + (((grow0 + i * 8 + (F.lane >> 3)) * 16 + h) * 3 + sl) * 64 + (F.lane & 7) * 8); }
#pragma unroll
                for (int i = 0; i < 4; ++i) { const int row = i * 8 + (F.lane >> 3), ch = F.lane & 7;
                    const v4u ov = *(const LAS v4u*)(stg + row * 64 + ch * 8);
                    float a8[8] = {bf_lo(ov.x), bf_hi(ov.x), bf_lo(ov.y), bf_hi(ov.y), bf_lo(ov.z), bf_hi(ov.z), bf_lo(ov.w), bf_hi(ov.w)};
#pragma unroll
                    for (int sl = 0; sl < 3; ++sl) { const float c = wsc[row * 4 + 1 + sl]; const v4u pv = pp[i][sl];
                        a8[0] += c * bf_lo(pv.x); a8[1] += c * bf_hi(pv.x); a8[2] += c * bf_lo(pv.y); a8[3] += c * bf_hi(pv.y);
                        a8[4] += c * bf_lo(pv.z); a8[5] += c * bf_hi(pv.z); a8[6] += c * bf_lo(pv.w); a8[7] += c * bf_hi(pv.w); }
                    int w0 = 0, w1 = 0; w0 = __builtin_amdgcn_cvt_pk_fp8_f32(a8[0] * 16.f, a8[1] * 16.f, w0, false); w0 = __builtin_amdgcn_cvt_pk_fp8_f32(a8[2] * 16.f, a8[3] * 16.f, w0, true);
                    w1 = __builtin_amdgcn_cvt_pk_fp8_f32(a8[4] * 16.f, a8[5] * 16.f, w1, false); w1 = __builtin_amdgcn_cvt_pk_fp8_f32(a8[6] * 16.f, a8[7] * 16.f, w1, true);
                    v2u w; w.x = (unsigned)w0; w.y = (unsigned)w1; *(GAS v2u*)((unsigned char*)ATTO + (grow0 + row) * 1024 + h * 64 + ch * 8) = w; }
            }
        }
        asm volatile("" ::: "memory");
        if (k + 1 < nul && !same_next) { int ln_ = F.lane; asm volatile("" : "+v"(ln_)); attn_dma_v(F.lds, Vb, ATT_ROWBASE(k + 1), ATT_H(k + 1), wave, ln_); }
        else if (k + 1 >= nul) { asm volatile("s_waitcnt vmcnt(0)" ::: "memory"); }
        ent0 = ent1; ent1 = ent2;
    }
    }
    asm volatile("s_waitcnt vmcnt(0) lgkmcnt(0)" ::: "memory");
    if (!OWN) { for (; st_next < SIDE_TASKS; st_next += 2 * st_step) { side_issue(st_next, w_gu, w_d, F.lane, sv); const bool two = st_next + st_step < SIDE_TASKS; if (two) side_issue(st_next + st_step, w_gu, w_d, F.lane, sv1);
            side_finish(st_next, true, dummy, Wgu8, Wd8, F.lane, sv); if (two) side_finish(st_next + st_step, true, dummy, Wgu8, Wd8, F.lane, sv1); } }
    asm volatile("s_waitcnt vmcnt(0) lgkmcnt(0)" ::: "memory");
    __syncthreads();
#undef ATT_ENT
#undef ATT_ROWBASE
#undef ATT_H
#undef ATT_B
}

#define DECL_PTRS() int z_ = 0; asm volatile("" : "+s"(z_)); unsigned char* ws = args.ws + z_; const float* x = args.in[0 + z_]; const float* g_mix = args.in[1 + z_]; const float* w_in = args.in[2 + z_]; const float* conv_w = args.in[3 + z_]; const float* w_co = args.in[4 + z_]; const float* w_ao = args.in[5 + z_]; const float* w_out = args.in[6 + z_]; const float* g_ffn = args.in[7 + z_]; const float* router_w = args.in[8 + z_]; const float* router_b = args.in[9 + z_]; const float* w_gu = args.in[10 + z_]; const float* b_gu = args.in[11 + z_]; const float* w_d = args.in[12 + z_]; const float* b_d = args.in[13 + z_]; const float* g_fin = args.in[14 + z_]; float* out = args.out + z_; bf16* Win_t = (bf16*)(ws + WS_WIN); bf16* Wco_t = (bf16*)(ws + WS_WCO); bf16* Wao_t = (bf16*)(ws + WS_WAO); bf16* Wout_t = (bf16*)(ws + WS_WOUT); bf16* Wgu_t = (bf16*)(ws + WS_WGU); bf16* Wd_t = (bf16*)(ws + WS_WD); bf16* XN = (bf16*)(ws + WS_XN); bf16* CB = (bf16*)(ws + WS_CB); bf16* U = (bf16*)(ws + WS_U); bf16* Qb = (bf16*)(ws + WS_Q); bf16* Kb = (bf16*)(ws + WS_K); bf16* Vb = (bf16*)(ws + WS_V); bf16* GC = (bf16*)(ws + WS_GC); bf16* GA = (bf16*)(ws + WS_GA); bf16* T1 = U; bf16* MERGED = Qb; bf16* ATTO = XN; bf16* HN = XN; bf16* ACT = (bf16*)(ws + WS_ACT); bf16* Y = (bf16*)(ws + WS_Y); float* cosT = (float*)(ws + WS_COS); float* sinT = (float*)(ws + WS_SIN); float* ksum = (float*)(ws + WS_KSUM); float* rwg = (float*)(ws + WS_RWG); bf16* PO = (bf16*)(ws + WS_PO); float* PML = (float*)(ws + WS_PML); unsigned short* alist = (unsigned short*)(ws + WS_ALIST); gu32* acnt = F.ctl + CW_ACNT; int* etok = (int*)(ws + WS_ETOK); float* ewt = (float*)(ws + WS_EWT); float* erstd = (float*)(ws + WS_ERSTD); (void)erstd; unsigned char* Win8 = ws + WS_WIN8; unsigned char* Wao8 = ws + WS_WAO8; unsigned char* XN8 = ws + WS_XN8; (void)Win8; (void)Wao8; (void)XN8; int* tokslot = (int*)(ws + WS_TOKSLOT); (void)x; (void)out;
struct Args { const float* in[15]; float* out; unsigned char* ws; int ph_lo, ph_hi; };
constexpr int NPHASE = 11;

__global__ void __launch_bounds__(512, 2) fwd_kernel(Args args) {
    extern __shared__ __attribute__((aligned(16))) unsigned char lds_raw[];
    Frame F;
    F.lds = (LAS unsigned char*)lds_raw;
    F.tid = threadIdx.x; F.lane = F.tid & 63; F.wave = __builtin_amdgcn_readfirstlane(F.tid >> 6);
    F.G = gridDim.x; { const int bx = blockIdx.x; F.vcu = (F.G % 8 == 0) ? (bx % 8) * (F.G / 8) + bx / 8 : bx; }
    F.ws = args.ws; F.ctl = (gu32*)(args.ws + WS_CTL);

    for (int u = F.tid; u < (LDS_BYTES - LDSCTL_OFF) / 4; u += 512) ((LAS unsigned*)(F.lds + LDSCTL_OFF))[u] = 0u;
    __syncthreads();
    XcdBarrier bar = xcd_barrier_post((unsigned*)(F.ctl + CW_BAR), (volatile LAS unsigned*)(F.lds + MISC_OFF) + 8);
    const int lo = args.ph_lo, hi = args.ph_hi;
#define IN(k) (lo <= (k) && (k) < hi)
#define SEAM(k) do { if (IN(k) && IN((k) + 1)) xcd_barrier(bar); } while (0)
    const int gw = F.vcu * 8 + F.wave, NGW = F.G * 8;
    LAS int* tab = (LAS int*)(F.lds + TAB_OFF);

    if (IN(0)) {
        DECL_PTRS();
        constexpr int I_IN = 16 * 128, I_SQ = 16 * 16;
        constexpr int NITEMS = I_IN + 3 * I_SQ;
        for (int it = gw; it < NITEMS; it += NGW) {
            int r = it;
            if (r < I_IN) { const int nb = r % 128; if (nb < 48 || (nb >= 96 && nb < 112)) p0_transpose_task<1>(w_in, 8192, Win_t, g_mix, r, F.lane); else p0_transpose_task8<1>(w_in, 8192, Win8, g_mix, r, F.lane); continue; } r -= I_IN;
            if (r < I_SQ) { p0_transpose_task8<0>(w_ao, 1024, Wao8, nullptr, r, F.lane); continue; } r -= I_SQ;
            if (r < I_SQ) { p0_transpose_task<0>(w_co, 1024, Wco_t, nullptr, r, F.lane); continue; } r -= I_SQ;
            p0_transpose_task<0>(w_out, 1024, Wout_t, nullptr, r, F.lane);
        }
        for (int m = gw; m < M; m += NGW) {
            const GAS f32x4* xr = (const GAS f32x4*)(x + (size_t)m * D) + F.lane; f32x4 v[4]; float s = 0.f;
#pragma unroll
            for (int j = 0; j < 4; ++j) { v[j] = xr[64 * j]; s += (v[j].x * v[j].x + v[j].y * v[j].y) + (v[j].z * v[j].z + v[j].w * v[j].w); }
            const float rstd = 1.0f / sqrtf(wave_sum(s) * (1.f / D) + EPS);
            GAS v2u* o8 = (GAS v2u*)(XN + (size_t)m * D) + F.lane; GAS unsigned* o4 = (GAS unsigned*)(XN8 + (size_t)m * D) + F.lane;
#pragma unroll
            for (int j = 0; j < 4; ++j) { v2u w; w.x = cvt_pk_bf16(v[j].x * rstd, v[j].y * rstd); w.y = cvt_pk_bf16(v[j].z * rstd, v[j].w * rstd); o8[64 * j] = w;
                int q8 = 0; q8 = __builtin_amdgcn_cvt_pk_fp8_f32(v[j].x * rstd, v[j].y * rstd, q8, false); q8 = __builtin_amdgcn_cvt_pk_fp8_f32(v[j].z * rstd, v[j].w * rstd, q8, true); o4[64 * j] = (unsigned)q8; }
        }
        const int gt = F.vcu * 512 + F.tid, NT = F.G * 512;
        for (int i = gt; i < SEQ * 32; i += NT) { const int pos = i >> 5, k = i & 31; const float inv = powf(10000.0f, -(float)k / 32.0f); const float ang = (float)pos * inv; cosT[i] = cosf(ang); sinT[i] = sinf(ang); }
        for (int i = gt; i < BATCH * NBLK * 1024; i += NT) ksum[i] = 0.f;
        { unsigned short* rwgH = (unsigned short*)rwg; unsigned short* rwgL = rwgH + 64 * 64 * 8;
          for (int i = gt; i < 64 * 64 * 8; i += NT) { const int jj = i & 7, ln = (i >> 3) & 63, st = i >> 9, k = 16 * st + 8 * (ln >> 5) + jj, e = ln & 31;
              const float v = router_w[k * 32 + e] * g_ffn[k]; const unsigned hb = cvt_pk_bf16(v, 0.f) & 0xffffu; const float vh = __uint_as_float(hb << 16);
              rwgH[i] = (unsigned short)hb; rwgL[i] = (unsigned short)(cvt_pk_bf16(v - vh, 0.f) & 0xffffu); } }
    }
    SEAM(0);
    if (IN(1)) {
        DECL_PTRS();
        { DensePol P{XN, Win_t, M / 256, 16, F.G, (int)blockIdx.x, 2, 12, 0, 12}; EpiInProj E{CB, U, Qb, Kb, Vb, GC, GA, cosT, sinT, ksum, 1.0f};
          pg8::gemm_phase<EpiInProj, DensePol, true>(F.lds, P, E); }
        { DensePol P{XN8, Win8, M / 256, 16, F.G, (int)blockIdx.x, 1, 12, 12, 16}; EpiInProj E{CB, U, Qb, Kb, Vb, GC, GA, cosT, sinT, ksum, 1.0f / 32.0f};
          pg8::gemm_phase<EpiInProj, DensePol, true, true>(F.lds, P, E); }
    }
    SEAM(1);
    if (IN(2)) {
        DECL_PTRS();
        bf16* CBW = CB;
        {
            const int cg = F.tid & 127, rs = F.tid >> 7;
            float w0[8], w1[8], w2[8];
#pragma unroll
            for (int e = 0; e < 8; ++e) { w0[e] = conv_w[cg * 8 + e]; w1[e] = conv_w[1024 + cg * 8 + e]; w2[e] = conv_w[2048 + cg * 8 + e]; }
            const int row0 = F.vcu * (M / F.G) + rs * 32, pos0 = row0 & (SEQ - 1);
            const size_t off0 = (size_t)row0 * 1024 + cg * 8;
            v4u u1 = (v4u){0u, 0u, 0u, 0u}, u2 = (v4u){0u, 0u, 0u, 0u};
            if (pos0 >= 1) u1 = *(const GAS v4u*)(U + off0 - 1024);
            if (pos0 >= 2) u2 = *(const GAS v4u*)(U + off0 - 2048);
#pragma unroll 1
            for (int r = 0; r < 32; r += 4) {
                v4u cb[4], uu[4];
#pragma unroll
                for (int q = 0; q < 4; ++q) { cb[q] = *(const GAS v4u*)(CB + off0 + (size_t)(r + q) * 1024); uu[q] = *(const GAS v4u*)(U + off0 + (size_t)(r + q) * 1024); }
#pragma unroll
                for (int q = 0; q < 4; ++q) {
                    const v4u u0 = uu[q]; float o[8];
#define CV(i, cw, a0, a1, a2, sel) o[i] = sel(cw) * (w0[i] * sel(a2) + w1[i] * sel(a1) + w2[i] * sel(a0))
                    CV(0, cb[q].x, u0.x, u1.x, u2.x, bf_lo); CV(1, cb[q].x, u0.x, u1.x, u2.x, bf_hi); CV(2, cb[q].y, u0.y, u1.y, u2.y, bf_lo); CV(3, cb[q].y, u0.y, u1.y, u2.y, bf_hi);
                    CV(4, cb[q].z, u0.z, u1.z, u2.z, bf_lo); CV(5, cb[q].z, u0.z, u1.z, u2.z, bf_hi); CV(6, cb[q].w, u0.w, u1.w, u2.w, bf_lo); CV(7, cb[q].w, u0.w, u1.w, u2.w, bf_hi);
#undef CV
                    v4u w; w.x = cvt_pk_bf16(o[0], o[1]); w.y = cvt_pk_bf16(o[2], o[3]); w.z = cvt_pk_bf16(o[4], o[5]); w.w = cvt_pk_bf16(o[6], o[7]);
                    *(GAS v4u*)(CBW + off0 + (size_t)(r + q) * 1024) = w;
                    u2 = u1; u1 = u0;
                }
            }
        }
        __syncthreads();
        {
            LAS unsigned char* kmH = F.lds; LAS unsigned char* kmL = F.lds + 8192;
            LAS int* lc = (LAS int*)(F.lds + 16384); LAS int* gb = lc + 64;
            const int r32 = F.lane & 31, hi = F.lane >> 5;
            for (int task = F.vcu; task < 32 * 32; task += F.G) {
                const int bh = task >> 5, chunk = task & 31, b = bh >> 4, h = bh & 15;
                { const int j = F.tid >> 3, c = F.tid & 7;
                  const f32x4 k0 = *(const f32x4*)(ksum + (size_t)(b * 64 + j) * 1024 + h * 64 + c * 8), k1 = *(const f32x4*)(ksum + (size_t)(b * 64 + j) * 1024 + h * 64 + c * 8 + 4);
                  v4u vh; vh.x = cvt_pk_bf16(k0.x, k0.y); vh.y = cvt_pk_bf16(k0.z, k0.w); vh.z = cvt_pk_bf16(k1.x, k1.y); vh.w = cvt_pk_bf16(k1.z, k1.w);
                  v4u vl; vl.x = cvt_pk_bf16(k0.x - bf_lo(vh.x), k0.y - bf_hi(vh.x)); vl.y = cvt_pk_bf16(k0.z - bf_lo(vh.y), k0.w - bf_hi(vh.y));
                  vl.z = cvt_pk_bf16(k1.x - bf_lo(vh.z), k1.y - bf_hi(vh.z)); vl.w = cvt_pk_bf16(k1.z - bf_lo(vh.w), k1.w - bf_hi(vh.w));
                  *(LAS v4u*)(kmH + c * 1024 + j * 16) = vh; *(LAS v4u*)(kmL + c * 1024 + j * 16) = vl; }
                if (F.tid < 64) lc[F.tid] = 0;
                __syncthreads();
                const int own = chunk * 2 + (F.wave >> 2), nv = own < 3 ? own : 3;
                int sel[2][3] = {{0, 0, 0}, {0, 0, 0}}, rk[2][3] = {{0, 0, 0}, {0, 0, 0}};
                if (own > 0) {
#pragma unroll
                    for (int ps = 0; ps < 2; ++ps) {
                        const int t = chunk * 512 + F.wave * 64 + ps * 32 + r32;
                        bf16x8_t qr[4];
#pragma unroll
                        for (int d0 = 0; d0 < 4; ++d0) qr[d0] = *(const bf16x8_t*)(Qb + (size_t)(b * SEQ + t) * 1024 + h * 64 + d0 * 16 + hi * 8);
                        float v0 = -INFINITY, v1 = -INFINITY, v2 = -INFINITY; int i0 = 0, i1 = 0, i2 = 0;
#pragma unroll
                        for (int tl = 0; tl < 2; ++tl) {
                            if (tl * 32 < own) {
                                f32x16 g = {0.f, 0.f, 0.f, 0.f, 0.f, 0.f, 0.f, 0.f, 0.f, 0.f, 0.f, 0.f, 0.f, 0.f, 0.f, 0.f};
#pragma unroll
                                for (int d0 = 0; d0 < 4; ++d0) { const bf16x8_t ah = *(const LAS bf16x8_t*)(kmH + (2 * d0 + hi) * 1024 + (tl * 32 + r32) * 16), al = *(const LAS bf16x8_t*)(kmL + (2 * d0 + hi) * 1024 + (tl * 32 + r32) * 16);
                                    g = __builtin_amdgcn_mfma_f32_32x32x16_bf16(ah, qr[d0], g, 0, 0, 0); g = __builtin_amdgcn_mfma_f32_32x32x16_bf16(al, qr[d0], g, 0, 0, 0); }
#pragma unroll
                                for (int r = 0; r < 16; ++r) { const int j = tl * 32 + crow(r, hi); const float gv = (j < own) ? g[r] : -INFINITY;
                                    if (gv > v0) { v2 = v1; i2 = i1; v1 = v0; i1 = i0; v0 = gv; i0 = j; }
                                    else if (gv > v1) { v2 = v1; i2 = i1; v1 = gv; i1 = j; }
                                    else if (gv > v2) { v2 = gv; i2 = j; } }
                            }
                        }
                        float pv[3] = {__shfl_xor(v0, 32), __shfl_xor(v1, 32), __shfl_xor(v2, 32)}; int pi[3] = {__shfl_xor(i0, 32), __shfl_xor(i1, 32), __shfl_xor(i2, 32)};
#pragma unroll
                        for (int e = 0; e < 3; ++e) { const float gv = pv[e]; const int j = pi[e];
                            if (gv > v0 || (gv == v0 && j < i0)) { v2 = v1; i2 = i1; v1 = v0; i1 = i0; v0 = gv; i0 = j; }
                            else if (gv > v1 || (gv == v1 && j < i1)) { v2 = v1; i2 = i1; v1 = gv; i1 = j; }
                            else if (gv > v2 || (gv == v2 && j < i2)) { v2 = gv; i2 = j; } }
                        sel[ps][0] = i0; sel[ps][1] = i1; sel[ps][2] = i2;
                        if (hi == 0) {
                            rk[ps][0] = __hip_atomic_fetch_add(&lc[i0], 1, __ATOMIC_RELAXED, __HIP_MEMORY_SCOPE_WORKGROUP);
                            if (nv > 1) rk[ps][1] = __hip_atomic_fetch_add(&lc[i1], 1, __ATOMIC_RELAXED, __HIP_MEMORY_SCOPE_WORKGROUP);
                            if (nv > 2) rk[ps][2] = __hip_atomic_fetch_add(&lc[i2], 1, __ATOMIC_RELAXED, __HIP_MEMORY_SCOPE_WORKGROUP);
                        }
                    }
                }
                __syncthreads();
                if (F.tid < 64) { const int c = lc[F.tid]; gb[F.tid] = c ? (int)__hip_atomic_fetch_add((unsigned*)(acnt + bh * 64 + F.tid), (unsigned)c, RLX_AGENT) : 0; }
                __syncthreads();
                if (own > 0 && hi == 0) {
                    unsigned short* lb = alist + (size_t)bh * ALIST_BH;
#pragma unroll
                    for (int ps = 0; ps < 2; ++ps) { const int t = chunk * 512 + F.wave * 64 + ps * 32 + r32;
                        lb[alist_off(sel[ps][0]) + gb[sel[ps][0]] + rk[ps][0]] = (unsigned short)((t << 2) | 0);
                        if (nv > 1) lb[alist_off(sel[ps][1]) + gb[sel[ps][1]] + rk[ps][1]] = (unsigned short)((t << 2) | 1);
                        if (nv > 2) lb[alist_off(sel[ps][2]) + gb[sel[ps][2]] + rk[ps][2]] = (unsigned short)((t << 2) | 2); }
                }
                __syncthreads();
            }
        }
    }
    SEAM(2);
    if (IN(3)) {
        DECL_PTRS();
        attn_phase<false>(F, Qb, Kb, Vb, PO, PML, alist, acnt, ATTO, w_gu, w_d, g_ffn, (unsigned char*)Wgu_t, (unsigned char*)Wd_t);
    }
    SEAM(3);
    if (IN(4)) {
        DECL_PTRS();
        attn_phase<true>(F, Qb, Kb, Vb, PO, PML, alist, acnt, ATTO, w_gu, w_d, g_ffn, (unsigned char*)Wgu_t, (unsigned char*)Wd_t);
    }
    SEAM(4);
    if (IN(5)) {
        DECL_PTRS();
        { DensePol P{CB, Wco_t, M / 256, 4, F.G, (int)blockIdx.x, 2, 4, 0, 0}; EpiGate<0> E{GC, nullptr, T1, 1.0f}; pg8::gemm_phase<EpiGate<0>, DensePol, true>(F.lds, P, E); }
        VM_WAIT(); __syncthreads();
        { DensePol P{ATTO, Wao8, M / 256, 4, F.G, (int)blockIdx.x, 1, 4, 0, 0}; EpiGate<1> E{GA, T1, MERGED, 1.0f / 512.0f}; pg8::gemm_phase<EpiGate<1>, DensePol, true, true>(F.lds, P, E); }
    }
    SEAM(5);
    if (IN(6)) {
        DECL_PTRS();
        DensePol P{MERGED, Wout_t, M / 256, 4, F.G, (int)blockIdx.x, 2, 4, 0, 0}; EpiResid E{x, out};
        pg8::gemm_phase<EpiResid, DensePol, true>(F.lds, P, E);
    }
    SEAM(6);
    if (IN(7)) {
        DECL_PTRS();
        LAS int* lcnt = (LAS int*)(F.lds + 98304); LAS int* gbase = lcnt + 32; LAS float* rbl = (LAS float*)(lcnt + 64);
        if (F.tid < 32) { lcnt[F.tid] = 0; rbl[F.tid] = router_b[F.tid]; }
        __syncthreads();
        const int rows_per_wg = M / F.G;
        int myrank[4] = {0, 0, 0, 0}, mye[4] = {0, 0, 0, 0}; float myw[4] = {0.f, 0.f, 0.f, 0.f}; int mytok = -1; float myrstd = 0.f;
        {
            const int r32 = F.lane & 31, hh = F.lane >> 5, rt = F.wave & 3, kh = F.wave >> 2, row = F.vcu * rows_per_wg + rt * 32 + r32;
            const float* hrow = out + (size_t)row * 1024 + kh * 512 + 8 * hh;
            unsigned char* hn = (unsigned char*)HN + (size_t)row * 1024 + kh * 512 + 8 * hh;
            const float* gfr = g_ffn + kh * 512 + 8 * hh;
            const unsigned short* rwgH = (const unsigned short*)rwg + ((size_t)(kh * 32) * 64 + F.lane) * 8; const unsigned short* rwgL = rwgH + 64 * 64 * 8;
            f32x16 acc = {0.f, 0.f, 0.f, 0.f, 0.f, 0.f, 0.f, 0.f, 0.f, 0.f, 0.f, 0.f, 0.f, 0.f, 0.f, 0.f}; float ss = 0.f;
#pragma unroll 4
            for (int st = 0; st < 32; ++st) {
                const f32x4 a0 = *(const f32x4*)(hrow + 16 * st), a1 = *(const f32x4*)(hrow + 16 * st + 4);
                const v4u bh = *(const v4u*)(rwgH + (size_t)st * 512), bl = *(const v4u*)(rwgL + (size_t)st * 512);
                ss += (a0.x * a0.x + a0.y * a0.y) + (a0.z * a0.z + a0.w * a0.w) + (a1.x * a1.x + a1.y * a1.y) + (a1.z * a1.z + a1.w * a1.w);
                v4u ah; ah.x = cvt_pk_bf16(a0.x, a0.y); ah.y = cvt_pk_bf16(a0.z, a0.w); ah.z = cvt_pk_bf16(a1.x, a1.y); ah.w = cvt_pk_bf16(a1.z, a1.w);
                v4u al; al.x = cvt_pk_bf16(a0.x - bf_lo(ah.x), a0.y - bf_hi(ah.x)); al.y = cvt_pk_bf16(a0.z - bf_lo(ah.y), a0.w - bf_hi(ah.y));
                al.z = cvt_pk_bf16(a1.x - bf_lo(ah.z), a1.y - bf_hi(ah.z)); al.w = cvt_pk_bf16(a1.z - bf_lo(ah.w), a1.w - bf_hi(ah.w));
                { const f32x4 g0 = *(const f32x4*)(gfr + 16 * st), g1 = *(const f32x4*)(gfr + 16 * st + 4); int w0 = 0, w1 = 0;
                  w0 = __builtin_amdgcn_cvt_pk_fp8_f32(a0.x * g0.x, a0.y * g0.y, w0, false); w0 = __builtin_amdgcn_cvt_pk_fp8_f32(a0.z * g0.z, a0.w * g0.w, w0, true);
                  w1 = __builtin_amdgcn_cvt_pk_fp8_f32(a1.x * g1.x, a1.y * g1.y, w1, false); w1 = __builtin_amdgcn_cvt_pk_fp8_f32(a1.z * g1.z, a1.w * g1.w, w1, true);
                  v2u w; w.x = (unsigned)w0; w.y = (unsigned)w1; *(GAS v2u*)(hn + 16 * st) = w; }
                const bf16x8_t fah = __builtin_bit_cast(bf16x8_t, ah), fal = __builtin_bit_cast(bf16x8_t, al), fbh = __builtin_bit_cast(bf16x8_t, bh), fbl = __builtin_bit_cast(bf16x8_t, bl);
                acc = __builtin_amdgcn_mfma_f32_32x32x16_bf16(fah, fbh, acc, 0, 0, 0);
                acc = __builtin_amdgcn_mfma_f32_32x32x16_bf16(fah, fbl, acc, 0, 0, 0);
                acc = __builtin_amdgcn_mfma_f32_32x32x16_bf16(fal, fbh, acc, 0, 0, 0);
            }
            LAS float* xch = (LAS float*)(F.lds + 32768 + rt * 8192);
            if (kh == 1) {
#pragma unroll
                for (int r = 0; r < 16; ++r) xch[r * 64 + F.lane] = acc[r];
                xch[16 * 64 + F.lane] = ss; }
            LDS_WAIT(); __syncthreads();
            if (kh == 0) {
#pragma unroll
                for (int r = 0; r < 16; ++r) acc[r] += xch[r * 64 + F.lane];
                ss += xch[16 * 64 + F.lane];
                ss += __shfl_xor(ss, 32);
                const float rstd = 1.0f / sqrtf(ss * (1.f / D) + EPS);
                LAS float* scr = (LAS float*)(F.lds + rt * 8192);
#pragma unroll
                for (int r = 0; r < 16; ++r) scr[crow(r, hh) * 33 + r32] = acc[r];
                LDS_WAIT(); asm volatile("" ::: "memory");
                if (hh == 0) {
                    float v0 = -INFINITY, v1 = -INFINITY, v2 = -INFINITY, v3 = -INFINITY; int i0 = 0, i1 = 0, i2 = 0, i3 = 0;
#pragma unroll 4
                    for (int e = 0; e < 32; ++e) { const float g = scr[r32 * 33 + e] * rstd + rbl[e];
                        if (g > v0) { v3 = v2; i3 = i2; v2 = v1; i2 = i1; v1 = v0; i1 = i0; v0 = g; i0 = e; }
                        else if (g > v1) { v3 = v2; i3 = i2; v2 = v1; i2 = i1; v1 = g; i1 = e; }
                        else if (g > v2) { v3 = v2; i3 = i2; v2 = g; i2 = e; }
                        else if (g > v3) { v3 = g; i3 = e; } }
                    const float e1 = __expf(v1 - v0), e2 = __expf(v2 - v0), e3 = __expf(v3 - v0), inv = 1.0f / (1.0f + e1 + e2 + e3);
                    mye[0] = i0; mye[1] = i1; mye[2] = i2; mye[3] = i3; myw[0] = inv; myw[1] = e1 * inv; myw[2] = e2 * inv; myw[3] = e3 * inv; mytok = row; myrstd = rstd;
#pragma unroll
                    for (int k = 0; k < 4; ++k) myrank[k] = __hip_atomic_fetch_add(&lcnt[mye[k]], 1, __ATOMIC_RELAXED, __HIP_MEMORY_SCOPE_WORKGROUP);
                }
            }
        }
        __syncthreads();
        if (F.tid < 32) gbase[F.tid] = (int)__hip_atomic_fetch_add((unsigned*)(F.ctl + CW_ECNT + 64 * F.tid), (unsigned)lcnt[F.tid], RLX_AGENT);
        __syncthreads();
        if (mytok >= 0) {
#pragma unroll
            for (int k = 0; k < 4; ++k) { const int e = mye[k], pos = gbase[e] + myrank[k]; etok[e * 32768 + pos] = mytok; ewt[e * 32768 + pos] = myw[k]; erstd[e * 32768 + pos] = myrstd; tokslot[mytok * 4 + k] = e * 32768 + pos; }
        }
    }
    SEAM(7);
    if (IN(8) || IN(9) || IN(10)) {
        __syncthreads();
        if (F.tid < 64) {
            const int e = F.tid & 31; const int c = (int)__hip_atomic_load(F.ctl + CW_ECNT + 64 * e, RLX_AGENT); const int t = (c + 255) >> 8;
            int inc = t;
#pragma unroll
            for (int o = 1; o < 32; o <<= 1) { const int v = __shfl_up(inc, o, 32); if (e >= o) inc += v; }
            if (F.tid < 32) { tab[e] = c; tab[32 + e] = inc - t; if (e == 31) { tab[64] = inc; tab[65] = inc; } }
        }
        __syncthreads();
    }
    if (IN(8)) {
        DECL_PTRS();
        LAS int* ul = (LAS int*)(F.lds + UMETA_OFF); __syncthreads(); const int nul = moe_unit_list(ul, tab, 8, F.G, (int)blockIdx.x, F.tid); __syncthreads();
        MoePol1 P{HN, Wgu_t, etok, tab, ul, nul}; EpiSwiglu E{b_gu, erstd, (unsigned char*)ACT};
        pg8::gemm_phase<EpiSwiglu, MoePol1, true, true>(F.lds, P, E);
    }
    SEAM(8);
    if (IN(9)) {
        DECL_PTRS();
        LAS int* ul = (LAS int*)(F.lds + UMETA_OFF); __syncthreads(); const int nul = moe_unit_list(ul, tab, 4, F.G, (int)blockIdx.x, F.tid); __syncthreads();
        MoePol2 P{ACT, Wd_t, ul, nul}; EpiDown E{b_d, ewt, (unsigned char*)Y};
        pg8::gemm_phase<EpiDown, MoePol2, true, true>(F.lds, P, E);
    }
    SEAM(9);
    if (IN(10)) {
        DECL_PTRS();
        const unsigned tmo = __hip_atomic_load(F.ctl + CW_BAR + XB_TMO, RLX_AGENT);
        f32x4 gfv[4];
#pragma unroll
        for (int j = 0; j < 4; ++j) gfv[j] = ((const GAS f32x4*)g_fin + F.lane)[64 * j];
        for (int m = gw; m < M; m += NGW) {
            GAS f32x4* hr = (GAS f32x4*)(out + (size_t)m * D) + F.lane; f32x4 v[4];
#pragma unroll
            for (int j = 0; j < 4; ++j) v[j] = hr[64 * j];
#pragma unroll
            for (int k = 0; k < 4; ++k) { const int ts = tokslot[m * 4 + k], e = ts >> 15, pos = ts & 32767; const size_t srow = (size_t)tab[32 + e] * 256 + pos;
                const GAS unsigned* yr = (const GAS unsigned*)((const unsigned char*)Y + srow * 1024) + F.lane;
#pragma unroll
                for (int j = 0; j < 4; ++j) { const unsigned w = yr[64 * j]; const pg8::f32x2 lo2 = __builtin_amdgcn_cvt_pk_f32_fp8((int)w, false), hi2 = __builtin_amdgcn_cvt_pk_f32_fp8((int)w, true);
                    v[j].x += lo2[0] * (1.0f / 16.0f); v[j].y += lo2[1] * (1.0f / 16.0f); v[j].z += hi2[0] * (1.0f / 16.0f); v[j].w += hi2[1] * (1.0f / 16.0f); } }
            float s = 0.f;
#pragma unroll
            for (int j = 0; j < 4; ++j) s += (v[j].x * v[j].x + v[j].y * v[j].y) + (v[j].z * v[j].z + v[j].w * v[j].w);
            float rstd = 1.0f / sqrtf(wave_sum(s) * (1.f / D) + EPS);
            if (tmo) rstd = __builtin_nanf("");
#pragma unroll
            for (int j = 0; j < 4; ++j) hr[64 * j] = v[j] * rstd * gfv[j];
        }
    }
#undef IN
#undef SEAM
}

extern "C" void kernel_launch(void* const* d_in, const int* in_sizes, int n_in, void* d_out, int out_size, void* d_ws, size_t ws_size, hipStream_t stream) {
    static int grid = 0;
    if (grid == 0) {
        if (n_in != 15 || out_size != M * D || ws_size < WS_END) { fprintf(stderr, "kernel_launch: unexpected shapes (n_in %d out %d ws %zu); nothing launched\n", n_in, out_size, ws_size); grid = -1; return; }
        int dev = 0, cus = 0, per_cu = 0;
        if (hipGetDevice(&dev) != hipSuccess || hipDeviceGetAttribute(&cus, hipDeviceAttributeMultiprocessorCount, dev) != hipSuccess) { grid = -1; return; }
        if (hipFuncSetAttribute((const void*)fwd_kernel, hipFuncAttributeMaxDynamicSharedMemorySize, LDS_BYTES) != hipSuccess) { fprintf(stderr, "kernel_launch: hipFuncSetAttribute failed\n"); grid = -1; return; }
        if (hipOccupancyMaxActiveBlocksPerMultiprocessor(&per_cu, (const void*)fwd_kernel, 512, LDS_BYTES) != hipSuccess || per_cu < 1) { fprintf(stderr, "kernel_launch: occupancy query reports %d blocks per CU; nothing launched\n", per_cu); (void)hipGetLastError(); grid = -1; return; }
        (void)hipGetLastError();
        grid = cus;
    }
    if (grid < 0) return;
    (void)hipMemsetAsync((char*)d_ws + WS_CTL, 0, CTL_ZERO_BYTES, stream);
    Args a{};
    for (int i = 0; i < 15; ++i) a.in[i] = (const float*)d_in[i];
    a.out = (float*)d_out; a.ws = (unsigned char*)d_ws;
    a.ph_lo = 0; a.ph_hi = NPHASE;
    hipLaunchKernelGGL(fwd_kernel, dim3(grid), dim3(512), LDS_BYTES, stream, a);
}
```

```cpp
#include <hip/hip_runtime.h>
#include <cstdio>
#include <cstdint>
#include <cmath>


constexpr int BATCH = 2, SEQ = 16384, D = 1024, M = BATCH * SEQ, NH = 16, HD = 64, NBLK = SEQ / 256, NE = 32, NIN = 8192;
constexpr float EPS = 1e-5f;
constexpr float C2 = 0.125f * 1.4426950408889634f;

namespace pg8 {
#define PG8_LAS __attribute__((address_space(3)))
typedef unsigned short bf16_t;
typedef short bf16x8 __attribute__((ext_vector_type(8)));
typedef float f32x4 __attribute__((ext_vector_type(4)));
typedef float f32x2 __attribute__((ext_vector_type(2)));
typedef unsigned u32x4 __attribute__((ext_vector_type(4)));
typedef unsigned u32x2 __attribute__((ext_vector_type(2)));
constexpr int BM = 256, BK = 64, HALF = 128, HTB = HALF * BK * 2, STAGE_BYTES = 8 * HTB, NXCD = 8, WGM = 8, KD = 1024;

__host__ __device__ __forceinline__ int lds_byte(int r, int c) { const int st = (r >> 4) * 2 + (c >> 5), rr = r & 15, cc = c & 31, ob = rr * 64 + cc * 2; return st * 1024 + (ob ^ (((ob >> 9) & 1) << 5)); }
__host__ __device__ __forceinline__ void stage_rc(int b, int& R, int& C) { const int st = b / 1024, sb = b % 1024, swz = sb ^ (((sb >> 9) & 1) << 5); R = (st >> 1) * 16 + swz / 64; C = (st & 1) * 32 + (swz % 64) / 2; }
__host__ __device__ __forceinline__ int perm32(int rho) { const int n = rho >> 4, i = rho & 15; return 8 * (i >> 2) + 4 * n + (i & 3); }

struct Unit { int pm, pn, e, rt; };

typedef float f32x2_cv __attribute__((ext_vector_type(2))); typedef __bf16 bf16x2_cv __attribute__((ext_vector_type(2)));
__device__ __forceinline__ unsigned cvt_pk_bf16(float lo, float hi) { const f32x2_cv v = {lo, hi}; const bf16x2_cv b = __builtin_convertvector(v, bf16x2_cv); return __builtin_bit_cast(unsigned, b); }
__device__ __forceinline__ float bf_lo(unsigned w) { return __uint_as_float(w << 16); }
__device__ __forceinline__ float bf_hi(unsigned w) { return __uint_as_float(w & 0xffff0000u); }

__device__ __forceinline__ bool tile_order(int i, int G, int c, int nM, int nN, int& pm, int& pn) {
    const int nwg = nM * nN; const long L = (long)i * G + c; if (L >= nwg) return false;
    int wgid = (int)L;
    { const int q = nwg / NXCD, r = nwg % NXCD, xcd = wgid % NXCD, off = wgid / NXCD; wgid = (xcd < r ? xcd * (q + 1) : r * (q + 1) + (xcd - r) * q) + off; }
    const int nig = WGM * nN, gid = wgid / nig, fm = gid * WGM, gsz = (nM - fm) < WGM ? (nM - fm) : WGM;
    pm = fm + ((wgid % nig) % gsz); pn = (wgid % nig) / gsz; return true;
}

typedef int v8i __attribute__((ext_vector_type(8)));
typedef int v4i __attribute__((ext_vector_type(4)));
template <class Epi, class Pol, bool ALIGN_EPI, bool FP8 = false>
__device__ __forceinline__ void gemm_phase(PG8_LAS unsigned char* lds, const Pol& S, const Epi& E) {
    constexpr int K = KD, KB = FP8 ? KD : 2 * KD  , nt = KB / 128;
    const int tid = threadIdx.x, wid = __builtin_amdgcn_readfirstlane(tid >> 6), lane = tid & 63, wr = wid >> 2, wc = wid & 3, fr = lane & 15, fq = lane >> 4;
    int RA[2], CA[2]; unsigned voffB[2];
#pragma unroll
    for (int i = 0; i < 2; ++i) { int R, C; stage_rc(tid * 16 + i * 8192, R, C); const int Rb = Epi::PERM ? ((R & ~31) + perm32(R & 31)) : R;
        RA[i] = R; CA[i] = C; voffB[i] = (unsigned)(Rb * KB + C * 2); }
    constexpr unsigned kstep = BK * 2, hstep = (unsigned)HALF * KB;
    const unsigned ldsw = (unsigned)wid * 1024u;
    const int aoff = lds_byte(wr * 64 + fr, fq * 8), boff = lds_byte(wc * 32 + fr, fq * 8);
#define PG8_SA(b, h) (((b) * 2 + (h)) * HTB)
#define PG8_SB(b, h) ((4 + (b) * 2 + (h)) * HTB)
#define PG8_GLDS(bufoff, ptr, o0, o1) do { \
        __builtin_amdgcn_global_load_lds((const unsigned*)((const char*)(ptr) + (o0)), (PG8_LAS unsigned*)(lds + (bufoff) + ldsw), 16, 0, 0); \
        __builtin_amdgcn_global_load_lds((const unsigned*)((const char*)(ptr) + (o1)), (PG8_LAS unsigned*)(lds + (bufoff) + ldsw + 8192), 16, 0, 0); } while (0)
#define PG8_STAGE_B(bufoff, ptr) PG8_GLDS(bufoff, ptr, voffB[0], voffB[1])
#define PG8_LDA(dst, b, h) do { if constexpr (FP8) { _Pragma("unroll") for (int m = 0; m < 4; ++m) { const v4i l_ = *(const PG8_LAS v4i*)(lds + PG8_SA(b, h) + aoff + m * 2048), h_ = *(const PG8_LAS v4i*)(lds + PG8_SA(b, h) + aoff + m * 2048 + 1024); \
            dst##8[m] = (v8i){l_[0], l_[1], l_[2], l_[3], h_[0], h_[1], h_[2], h_[3]}; } } \
        else { _Pragma("unroll") for (int m = 0; m < 4; ++m) _Pragma("unroll") for (int k = 0; k < 2; ++k) dst[m][k] = *(const PG8_LAS bf16x8*)(lds + PG8_SA(b, h) + aoff + m * 2048 + k * 1024); } } while (0)
#define PG8_LDB(dst, b, h) do { if constexpr (FP8) { _Pragma("unroll") for (int n = 0; n < 2; ++n) { const v4i l_ = *(const PG8_LAS v4i*)(lds + PG8_SB(b, h) + boff + n * 2048), h_ = *(const PG8_LAS v4i*)(lds + PG8_SB(b, h) + boff + n * 2048 + 1024); \
            dst##8[n] = (v8i){l_[0], l_[1], l_[2], l_[3], h_[0], h_[1], h_[2], h_[3]}; } } \
        else { _Pragma("unroll") for (int n = 0; n < 2; ++n) _Pragma("unroll") for (int k = 0; k < 2; ++k) dst[n][k] = *(const PG8_LAS bf16x8*)(lds + PG8_SB(b, h) + boff + n * 2048 + k * 1024); } } while (0)
#define PG8_MMA(ai, bj, At, Bt) do { __builtin_amdgcn_s_setprio(1); if constexpr (FP8) { _Pragma("unroll") for (int m = 0; m < 4; ++m) _Pragma("unroll") for (int n = 0; n < 2; ++n) \
        asm volatile("s_nop 1\n\tv_mfma_scale_f32_16x16x128_f8f6f4 %0, %1, %2, %0, %3, %3 op_sel_hi:[0,0,0]" : "+v"(acc[ai][bj][m][n]) : "v"(Bt##8[n]), "v"(At##8[m]), "v"(one_scale)); } \
        else { _Pragma("unroll") for (int m = 0; m < 4; ++m) _Pragma("unroll") for (int n = 0; n < 2; ++n) _Pragma("unroll") for (int k = 0; k < 2; ++k) \
        acc[ai][bj][m][n] = __builtin_amdgcn_mfma_f32_16x16x32_bf16(Bt[n][k], At[m][k], acc[ai][bj][m][n], 0, 0, 0); } __builtin_amdgcn_s_setprio(0); } while (0)
#define PG8_WAIT_V(n) asm volatile("s_waitcnt vmcnt(" #n ")" ::: "memory")
#define PG8_WAIT_L(n) asm volatile("s_waitcnt lgkmcnt(" #n ")" ::: "memory")
#define PG8_BAR __builtin_amdgcn_s_barrier()
#define PG8_SCHED __builtin_amdgcn_sched_barrier(0)
#define PG8_AOFF(vo, u) do { _Pragma("unroll") for (int h_ = 0; h_ < 2; ++h_) _Pragma("unroll") for (int i_ = 0; i_ < 2; ++i_) { \
        if constexpr (Pol::GATHER) vo[h_][i_] = (unsigned)(S.gather(u, h_ * HALF + RA[i_]) * KB + CA[i_] * 2); \
        else vo[h_][i_] = (unsigned)((h_ * HALF + RA[i_]) * KB + CA[i_] * 2); } } while (0)
    Unit cur, nxt; int ui = 0;
    if (!S.next(0, cur)) return;
    f32x4 acc[2][2][4][2];
#pragma unroll
    for (int a = 0; a < 2; ++a)
#pragma unroll
        for (int b = 0; b < 2; ++b)
#pragma unroll
            for (int m = 0; m < 4; ++m)
#pragma unroll
                for (int n = 0; n < 2; ++n) acc[a][b][m][n] = (f32x4){0.f, 0.f, 0.f, 0.f};
    bf16x8 At[4][2], B0[2][2], B1[2][2]; v8i At8[4], B08[2], B18[2];
    int one_scale = 0x7f7f7f7f; asm volatile("" : "+v"(one_scale));
    unsigned voC[2][2], voN[2][2];
    PG8_AOFF(voC, cur);
#pragma unroll
    for (int h_ = 0; h_ < 2; ++h_)
#pragma unroll
        for (int i_ = 0; i_ < 2; ++i_) voN[h_][i_] = voC[h_][i_];
    const char* cA = S.a_base(cur); const char* cB = S.b_base(cur);
    PG8_STAGE_B(PG8_SB(0, 0), cB); PG8_STAGE_B(PG8_SB(0, 1), cB + hstep); PG8_GLDS(PG8_SA(0, 0), cA, voC[0][0], voC[0][1]); PG8_GLDS(PG8_SA(0, 1), cA, voC[1][0], voC[1][1]);
    if (wr == 1) PG8_BAR;
    PG8_WAIT_V(2); PG8_BAR;
    PG8_STAGE_B(PG8_SB(1, 0), cB + kstep); PG8_GLDS(PG8_SA(1, 0), cA + kstep, voC[0][0], voC[0][1]); PG8_STAGE_B(PG8_SB(1, 1), cB + hstep + kstep);
    PG8_WAIT_V(6); PG8_BAR;
    for (;;) {
        const bool has_next = S.next(ui + 1, nxt);
        const char* nA = cA; const char* nB = cB;
        if (has_next) { nA = S.a_base(nxt); nB = S.b_base(nxt); if constexpr (Pol::GATHER) { PG8_AOFF(voN, nxt); } }
        else { if constexpr (Pol::GATHER) {
#pragma unroll
            for (int h_ = 0; h_ < 2; ++h_)
#pragma unroll
                for (int i_ = 0; i_ < 2; ++i_) voN[h_][i_] = voC[h_][i_]; } }
#pragma unroll 1
        for (int t = 0; t < nt; t += 2) {
            const bool last = (t == nt - 2);
            const char* a1 = cA + (size_t)(t + 1) * kstep;
            const char* a2 = last ? nA : cA + (size_t)(t + 2) * kstep; const char* b2 = last ? nB : cB + (size_t)(t + 2) * kstep;
            const char* a3 = a2 + kstep; const char* b3 = b2 + kstep;
            unsigned o00, o01, o10, o11;
            if constexpr (Pol::GATHER) { o00 = last ? voN[0][0] : voC[0][0]; o01 = last ? voN[0][1] : voC[0][1]; o10 = last ? voN[1][0] : voC[1][0]; o11 = last ? voN[1][1] : voC[1][1]; }
            else { o00 = voC[0][0]; o01 = voC[0][1]; o10 = voC[1][0]; o11 = voC[1][1]; }
            PG8_LDB(B0, 0, 0); PG8_LDB(B1, 0, 1); PG8_SCHED; PG8_LDA(At, 0, 0); PG8_GLDS(PG8_SA(1, 1), a1, voC[1][0], voC[1][1]);
            PG8_WAIT_V(8); PG8_WAIT_L(0); PG8_BAR; PG8_MMA(0, 0, At, B0); PG8_MMA(0, 1, At, B1); PG8_BAR; PG8_SCHED;
            PG8_LDA(At, 0, 1); PG8_STAGE_B(PG8_SB(0, 0), b2); PG8_STAGE_B(PG8_SB(0, 1), b2 + hstep); PG8_GLDS(PG8_SA(0, 0), a2, o00, o01);
            PG8_WAIT_V(8); PG8_WAIT_L(0); PG8_BAR; PG8_MMA(1, 0, At, B0); PG8_MMA(1, 1, At, B1); PG8_BAR; PG8_SCHED;
            PG8_LDB(B0, 1, 0); PG8_LDB(B1, 1, 1); PG8_SCHED; PG8_LDA(At, 1, 0); PG8_GLDS(PG8_SA(0, 1), a2, o10, o11);
            PG8_WAIT_V(8); PG8_WAIT_L(0); PG8_BAR; PG8_MMA(0, 0, At, B0); PG8_MMA(0, 1, At, B1); PG8_BAR; PG8_SCHED;
            PG8_LDA(At, 1, 1); PG8_STAGE_B(PG8_SB(1, 0), b3); PG8_STAGE_B(PG8_SB(1, 1), b3 + hstep); PG8_GLDS(PG8_SA(1, 0), a3, o00, o01);
            PG8_WAIT_V(8); PG8_WAIT_L(0); PG8_BAR; PG8_MMA(1, 0, At, B0); PG8_MMA(1, 1, At, B1); PG8_BAR; PG8_SCHED;
        }
        if constexpr (FP8) asm volatile("s_nop 15\n\ts_nop 15" ::: "memory");
        if constexpr (ALIGN_EPI) { if (wr == 0) PG8_BAR; }
        E(acc, cur, wr, wc, fr, fq);
        if (!has_next) break;
#pragma unroll
        for (int a = 0; a < 2; ++a)
#pragma unroll
            for (int b = 0; b < 2; ++b)
#pragma unroll
                for (int m = 0; m < 4; ++m)
#pragma unroll
                    for (int n = 0; n < 2; ++n) acc[a][b][m][n] = (f32x4){0.f, 0.f, 0.f, 0.f};
        cur = nxt; cA = nA; cB = nB; ++ui;
#pragma unroll
        for (int h_ = 0; h_ < 2; ++h_)
#pragma unroll
            for (int i_ = 0; i_ < 2; ++i_) voC[h_][i_] = voN[h_][i_];
        if constexpr (ALIGN_EPI) { if (wr == 1) PG8_BAR; }
    }
    PG8_WAIT_V(0);
    if constexpr (!ALIGN_EPI) { if (wr == 0) PG8_BAR; }
    PG8_BAR;
#undef PG8_SA
#undef PG8_SB
#undef PG8_GLDS
#undef PG8_STAGE_B
#undef PG8_LDA
#undef PG8_LDB
#undef PG8_MMA
#undef PG8_WAIT_V
#undef PG8_WAIT_L
#undef PG8_BAR
#undef PG8_SCHED
#undef PG8_AOFF
}
}

constexpr size_t MiB = 1u << 20;
constexpr size_t WS_CTL = 0, CTL_ZERO_BYTES = 1 * MiB;
constexpr size_t WS_RWG = 1 * MiB;
constexpr size_t WS_KSUM = 1 * MiB + 512 * 1024;
constexpr size_t WS_ETOK = 2 * MiB;
constexpr size_t WS_EWT = 6 * MiB;
constexpr size_t WS_TOKSLOT = 10 * MiB;
constexpr size_t WS_COS = 11 * MiB, WS_SIN = 13 * MiB;
constexpr size_t WS_WCO = 16 * MiB, WS_WAO = 18 * MiB, WS_WOUT = 20 * MiB;
constexpr size_t WS_WIN = 24 * MiB;
constexpr size_t WS_WGU = 40 * MiB;
constexpr size_t WS_WD = 168 * MiB;
constexpr size_t WS_XN = 232 * MiB;
constexpr size_t WS_CB = 296 * MiB;
constexpr size_t WS_U = 360 * MiB;
constexpr size_t WS_Q = 424 * MiB;
constexpr size_t WS_K = 488 * MiB;
constexpr size_t WS_V = 552 * MiB;
constexpr size_t WS_GC = 616 * MiB;
constexpr size_t WS_GA = 680 * MiB;
constexpr size_t WS_PO = 744 * MiB;
constexpr size_t WS_PML = 936 * MiB;
constexpr size_t WS_ALIST = 952 * MiB;
constexpr size_t WS_ACT = 296 * MiB;
constexpr size_t WS_Y = 616 * MiB;
constexpr size_t WS_WIN8 = 104 * MiB;
constexpr size_t WS_WAO8 = 112 * MiB;
constexpr size_t WS_XN8 = 744 * MiB;
constexpr size_t WS_ERSTD = 986 * MiB;
constexpr size_t WS_SIDE_DUMMY = 990 * MiB;
constexpr size_t WS_END = 992 * MiB;
constexpr int CW_BAR = 4096;
constexpr int CW_ECNT = 8192;
constexpr int CW_ACNT = 16384;
constexpr int CW_DBG = 20000;

constexpr int RING_BYTES = 131072, LDSCTL_OFF = RING_BYTES, MISC_OFF = LDSCTL_OFF + 320, TAB_OFF = LDSCTL_OFF + 512, LDS_BYTES = 147456;

#define GAS __attribute__((address_space(1)))
#define LAS __attribute__((address_space(3)))
typedef unsigned short bf16;
typedef unsigned v4u __attribute__((ext_vector_type(4)));
typedef unsigned v2u __attribute__((ext_vector_type(2)));
typedef float f32x4 __attribute__((ext_vector_type(4)));
typedef float f32x16 __attribute__((ext_vector_type(16)));
typedef GAS unsigned gu32;
#define RLX_AGENT __ATOMIC_RELAXED, __HIP_MEMORY_SCOPE_AGENT
#define LDS_WAIT() asm volatile("s_waitcnt lgkmcnt(0)" ::: "memory")
#define VM_WAIT() asm volatile("s_waitcnt vmcnt(0)" ::: "memory")
using pg8::cvt_pk_bf16; using pg8::bf_lo; using pg8::bf_hi;

#define XB_TMO      128
#define XB_XCNT(j)  (256  + 64 * (j))
#define XB_XSUB(j)  (1280 + 64 * (j))
#define XB_XGEN(j)  (2304 + 64 * (j))
#define XB_TOP      3328
#define XB_TOPGEN   3392
#define XCD_BAR_WORDS 3456
#define XB_SPIN_CAP (1u << 18)
__device__ __forceinline__ unsigned xb_ld(unsigned* p)              { return __hip_atomic_load(p, __ATOMIC_RELAXED, __HIP_MEMORY_SCOPE_AGENT); }
__device__ __forceinline__ unsigned xb_add(unsigned* p, unsigned v) { return __hip_atomic_fetch_add(p, v, __ATOMIC_RELAXED, __HIP_MEMORY_SCOPE_AGENT); }
__device__ __forceinline__ unsigned xb_xcc_id() { return (unsigned)__builtin_amdgcn_s_getreg((3 << 11) | 20) & 0xFu; }
#define XB_SPIN(cond, bar) do { unsigned _sp = 0; while (cond) { __builtin_amdgcn_s_sleep(1); \
    if ((++_sp & 255u) == 0u) { if (xb_ld(&(bar)[XB_TMO])) break; if (_sp > XB_SPIN_CAP) { atomicAdd(&(bar)[XB_TMO], 1u); break; } } } } while (0)
struct XcdBarrier { unsigned* bar; unsigned x; volatile LAS unsigned* st; };
__device__ __forceinline__ XcdBarrier xcd_barrier_post(unsigned* bar, volatile LAS unsigned* st) {
    XcdBarrier b; b.bar = bar; b.x = xb_xcc_id(); b.st = st;
    if (threadIdx.x == 0) (void)xb_add(&bar[XB_XCNT(b.x)], 1u);
    return b;
}
__device__ __forceinline__ void xcd_barrier_complete(unsigned* bar, unsigned x, unsigned& nloc, unsigned& nx) {
    const unsigned G = gridDim.x * gridDim.y * gridDim.z;
    unsigned sum, cnt, mine, sp = 0u;
    for (;;) {
        sum = 0u; cnt = 0u; mine = 0u;
#pragma unroll
        for (unsigned j = 0; j < 16; ++j) { const unsigned c = xb_ld(&bar[XB_XCNT(j)]); sum += c; cnt += (c > 0u) ? 1u : 0u; mine = (j == x) ? c : mine; }
        if (sum == G) break;
        __builtin_amdgcn_s_sleep(1);
        if ((++sp & 255u) == 0u) { if (xb_ld(&bar[XB_TMO])) break; if (sp > XB_SPIN_CAP) { atomicAdd(&bar[XB_TMO], 1u); break; } }
    }
    nloc = mine > 0u ? mine : 1u; nx = cnt > 0u ? cnt : 1u;
}
__device__ __forceinline__ void xcd_barrier(const XcdBarrier& b) {
    asm volatile("s_waitcnt vmcnt(0)" ::: "memory");
    __syncthreads();
    if (threadIdx.x == 0) {
        unsigned* bar = b.bar;
        __builtin_amdgcn_s_waitcnt(0);
        unsigned nloc = b.st[0], nx = b.st[1];
        if (nloc == 0u) { xcd_barrier_complete(bar, b.x, nloc, nx); b.st[0] = nloc; b.st[1] = nx; }
        const unsigned old = xb_add(&bar[XB_XSUB(b.x)], 1u);
        const unsigned gen = old / nloc;
        if (old + 1u == (gen + 1u) * nloc) {
            __builtin_amdgcn_fence(__ATOMIC_RELEASE, "agent");
            asm volatile("s_waitcnt vmcnt(0)" ::: "memory");
            const unsigned og = xb_add(&bar[XB_TOP], 1u);
            const unsigned tg = og / nx;
            if (og + 1u == (tg + 1u) * nx) xb_add(&bar[XB_TOPGEN], 1u);
            else XB_SPIN(xb_ld(&bar[XB_TOPGEN]) == tg, bar);
            __builtin_amdgcn_fence(__ATOMIC_ACQUIRE, "agent");
            xb_add(&bar[XB_XGEN(b.x)], 1u);
            asm volatile("s_waitcnt vmcnt(0)" ::: "memory");
        } else {
            XB_SPIN(xb_ld(&bar[XB_XGEN(b.x)]) == gen, bar);
            __builtin_amdgcn_fence(__ATOMIC_ACQUIRE, "agent");
            asm volatile("s_waitcnt vmcnt(0)" ::: "memory");
        }
    }
    __syncthreads();
}

struct Frame {
    LAS unsigned char* lds;
    gu32* ctl;
    int tid, lane, wave, vcu, G;
    unsigned char* ws;
};
__device__ __forceinline__ float wave_sum(float v) {
#pragma unroll
    for (int o = 1; o < 64; o <<= 1) v += __shfl_xor(v, o);
    return v;
}

template <int MODE> __device__ __forceinline__ int dst_row(int n) {
    if (MODE == 1) {
        if (n < 1024) return n;
        if (n < 3072) { const int ch = (n - 1024) & 1023; return 1024 + (ch >> 7) * 256 + (n < 2048 ? 0 : 128) + (ch & 127); }
        if (n < 5120) { const int base = n < 4096 ? 3072 : 4096, r = n - base, h = r >> 6, d = r & 63; return base + 64 * h + 2 * (d & 31) + (d >> 5); }
        return n;
    }
    if (MODE == 2) return n < 1024 ? 2 * n : 2 * (n - 1024) + 1;
    if (MODE == 3) { const int ch = n & 1023; return (ch >> 7) * 256 + (n < 1024 ? 0 : 128) + (ch & 127); }
    return n;
}
template <int MODE> __device__ __forceinline__ void p0_transpose_item(const float* W, int K, int N, bf16* WT, const float* g, LAS float* scr, int item, int lane) {
    const int nblk = N / 32, kb = item / nblk, nb = item % nblk, k0 = 64 * kb, n0 = 32 * nb;
#pragma unroll 8
    for (int i = 0; i < 32; ++i) { const int kk = 2 * i + (lane >> 5); float v = W[(size_t)(k0 + kk) * N + n0 + (lane & 31)]; if (g) v *= g[k0 + kk]; scr[kk * 33 + (lane & 31)] = v; }
    LDS_WAIT(); asm volatile("" ::: "memory");
    const int c = lane & 7;
#pragma unroll
    for (int j = 0; j < 4; ++j) { const int n = (lane >> 3) + 8 * j; const LAS float* s = scr + (8 * c) * 33 + n;
        v4u o; o.x = cvt_pk_bf16(s[0 * 33], s[1 * 33]); o.y = cvt_pk_bf16(s[2 * 33], s[3 * 33]); o.z = cvt_pk_bf16(s[4 * 33], s[5 * 33]); o.w = cvt_pk_bf16(s[6 * 33], s[7 * 33]);
        *(GAS v4u*)(WT + (size_t)dst_row<MODE>(n0 + n) * K + k0 + 8 * c) = o; }
    LDS_WAIT(); asm volatile("" ::: "memory");
}

template <int MODE> __device__ __forceinline__ void p0_transpose_task(const float* W, int N, bf16* WT, const float* g, int task, int lane) {
    const int nblk = N / 64, kb = task / nblk, nb = task % nblk, kq = lane >> 4, n4 = lane & 15, k0 = 64 * kb + 16 * kq, n = 64 * nb + 4 * n4;
    const float* src = W + (size_t)k0 * N + n;
    f32x4 v[16];
#pragma unroll
    for (int i = 0; i < 16; ++i) v[i] = __builtin_nontemporal_load((const f32x4*)(src + (size_t)i * N));
    if (g) {
#pragma unroll
        for (int i = 0; i < 16; i += 4) { const f32x4 g4 = *(const f32x4*)(g + k0 + i); v[i] *= g4.x; v[i + 1] *= g4.y; v[i + 2] *= g4.z; v[i + 3] *= g4.w; }
    }
#pragma unroll
    for (int e = 0; e < 4; ++e) { bf16* dst = WT + (size_t)dst_row<MODE>(n + e) * 1024 + k0;
#pragma unroll
        for (int c = 0; c < 2; ++c) { v4u o; o.x = cvt_pk_bf16(v[8 * c][e], v[8 * c + 1][e]); o.y = cvt_pk_bf16(v[8 * c + 2][e], v[8 * c + 3][e]); o.z = cvt_pk_bf16(v[8 * c + 4][e], v[8 * c + 5][e]); o.w = cvt_pk_bf16(v[8 * c + 6][e], v[8 * c + 7][e]);
            *(GAS v4u*)(dst + 8 * c) = o; } }
}
template <int MODE> __device__ __forceinline__ void p0_transpose_task8(const float* W, int N, unsigned char* WT, const float* g, int task, int lane) {
    const int nblk = N / 64, kb = task / nblk, nb = task % nblk, kq = lane >> 4, n4 = lane & 15, k0 = 64 * kb + 16 * kq, n = 64 * nb + 4 * n4;
    const float* src = W + (size_t)k0 * N + n;
    f32x4 v[16];
#pragma unroll
    for (int i = 0; i < 16; ++i) v[i] = __builtin_nontemporal_load((const f32x4*)(src + (size_t)i * N));
#pragma unroll
    for (int i = 0; i < 16; i += 4) { f32x4 g4 = (f32x4){32.0f, 32.0f, 32.0f, 32.0f}; if (g) g4 = *(const f32x4*)(g + k0 + i) * 32.0f; v[i] *= g4.x; v[i + 1] *= g4.y; v[i + 2] *= g4.z; v[i + 3] *= g4.w; }
#pragma unroll
    for (int e = 0; e < 4; ++e) { unsigned char* dst = WT + (size_t)dst_row<MODE>(n + e) * 1024 + k0; v4u o;
#define PK8(j) ({ int w_ = 0; w_ = __builtin_amdgcn_cvt_pk_fp8_f32(v[4 * (j)][e], v[4 * (j) + 1][e], w_, false); w_ = __builtin_amdgcn_cvt_pk_fp8_f32(v[4 * (j) + 2][e], v[4 * (j) + 3][e], w_, true); (unsigned)w_; })
        o.x = PK8(0); o.y = PK8(1); o.z = PK8(2); o.w = PK8(3);
#undef PK8
        *(GAS v4u*)dst = o; }
}

using pg8::Unit; using pg8::bf16_t;
struct DensePol {
    static constexpr bool GATHER = false;
    const void* A; const void* Bt; int nM, nN, G, c; int esz  , split, off0, off1;
    __device__ __forceinline__ bool next(int i, Unit& u) const { u.e = 0; u.rt = 0; int j; if (!pg8::tile_order(i, G, c, nM, nN, u.pm, j)) return false; u.pn = j < split ? j + off0 : j + off1; return true; }
    __device__ __forceinline__ const char* a_base(const Unit& u) const { return (const char*)A + (size_t)u.pm * 256 * 1024 * esz; }
    __device__ __forceinline__ const char* b_base(const Unit& u) const { return (const char*)Bt + (size_t)u.pn * 256 * 1024 * esz; }
    __device__ __forceinline__ int gather(const Unit&, int) const { return 0; }
};
struct MoePol1 {
    static constexpr bool GATHER = true;
    const void* A; const void* Bt; const int* etok; const LAS int* tab; const LAS int* ul; int nul;
    __device__ __forceinline__ bool next(int i, Unit& u) const { if (i >= nul) return false; const LAS int* p = ul + 4 * i; u.pm = p[0]; u.pn = p[1]; u.e = p[2]; u.rt = p[3]; return true; }
    __device__ __forceinline__ const char* a_base(const Unit&) const { return (const char*)A; }
    __device__ __forceinline__ const char* b_base(const Unit& u) const { return (const char*)Bt + ((size_t)u.e * 2048 + (size_t)u.pn * 256) * 1024; }
    __device__ __forceinline__ int gather(const Unit& u, int r) const { const int pos = u.rt * 256 + r; return pos < tab[u.e] ? etok[u.e * 32768 + pos] : 0; }
};
struct MoePol2 {
    static constexpr bool GATHER = false;
    const void* A; const void* Bt; const LAS int* ul; int nul;
    __device__ __forceinline__ bool next(int i, Unit& u) const { const int k = i; if (k >= nul) return false; const LAS int* p = ul + 4 * k; u.pm = p[0]; u.pn = p[1]; u.e = p[2]; u.rt = p[3]; return true; }
    __device__ __forceinline__ const char* a_base(const Unit& u) const { return (const char*)A + (size_t)u.pm * 256 * 1024; }
    __device__ __forceinline__ const char* b_base(const Unit& u) const { return (const char*)Bt + ((size_t)u.e * 1024 + (size_t)u.pn * 256) * 1024; }
    __device__ __forceinline__ int gather(const Unit&, int) const { return 0; }
};

__device__ __forceinline__ int moe_unit_list(LAS int* ul, const LAS int* tab, int ncol, int G, int c, int tid) {
    const int T = tab[65], nun = T * ncol; const int nul = (c < nun) ? (nun - 1 - c) / G + 1 : 0;
    if (tid < nul && tid < 64) { int g, pn; pg8::tile_order(tid, G, c, T, ncol, g, pn); int e = 0;
        for (int k = 1; k < 32; ++k) e += (tab[32 + k] <= g) ? 1 : 0;
        ul[4 * tid + 0] = g; ul[4 * tid + 1] = pn; ul[4 * tid + 2] = e; ul[4 * tid + 3] = g - tab[32 + e]; }
    return nul < 64 ? nul : 64;
}

typedef pg8::f32x4 (AccT)[2][2][4][2];
__device__ __forceinline__ float sigmoidf_(float x) { return __builtin_amdgcn_rcpf(1.0f + __builtin_amdgcn_exp2f(x * -1.4426950408889634f)); }

struct EpiInProj {
    static constexpr bool PERM = true;
    bf16_t *CB, *U, *Q, *Kb, *V, *GC, *GA; const float* cosT; const float* sinT; float* ksum; float asc;
    __device__ __forceinline__ void operator()(const AccT& acc, const Unit& u, int wr, int wc, int fr, int fq) const {
        using pg8::u32x4; using pg8::u32x2; using pg8::f32x4;
        const int pn = u.pn, row0_ = u.pm * 256 + wr * 64 + fr, cl = wc * 32 + 8 * fq;
        int row0 = row0_;
        if (pn < 4 || (pn >= 20 && pn < 24)) {
            asm volatile("" : "+v"(row0));
            bf16_t* base = (pn < 4) ? CB : V; const int col0 = (pn & 3) * 256 + cl;
#pragma unroll
            for (int ai = 0; ai < 2; ++ai)
#pragma unroll
                for (int m = 0; m < 4; ++m) { bf16_t* rowp = base + (size_t)(row0 + ai * 128 + m * 16) * 1024 + col0;
#pragma unroll
                    for (int bj = 0; bj < 2; ++bj) { const f32x4 v0 = acc[ai][bj][m][0] * asc, v1 = acc[ai][bj][m][1] * asc; u32x4 w;
                        w.x = cvt_pk_bf16(v0[0], v0[1]); w.y = cvt_pk_bf16(v0[2], v0[3]); w.z = cvt_pk_bf16(v1[0], v1[1]); w.w = cvt_pk_bf16(v1[2], v1[3]);
                        *(u32x4*)(rowp + bj * 128) = w; } }
        } else if (pn >= 24) {
            asm volatile("" : "+v"(row0));
            bf16_t* base = (pn < 28) ? GC : GA; const int col0 = (pn & 3) * 256 + cl;
#pragma unroll
            for (int ai = 0; ai < 2; ++ai)
#pragma unroll
                for (int m = 0; m < 4; ++m) { bf16_t* rowp = base + (size_t)(row0 + ai * 128 + m * 16) * 1024 + col0;
#pragma unroll
                    for (int bj = 0; bj < 2; ++bj) { const f32x4 v0 = acc[ai][bj][m][0] * asc, v1 = acc[ai][bj][m][1] * asc; u32x4 w;
                        w.x = cvt_pk_bf16(sigmoidf_(v0[0]), sigmoidf_(v0[1])); w.y = cvt_pk_bf16(sigmoidf_(v0[2]), sigmoidf_(v0[3]));
                        w.z = cvt_pk_bf16(sigmoidf_(v1[0]), sigmoidf_(v1[1])); w.w = cvt_pk_bf16(sigmoidf_(v1[2]), sigmoidf_(v1[3]));
                        *(u32x4*)(rowp + bj * 128) = w; } }
        } else if (pn < 12) {
            asm volatile("" : "+v"(row0));
            const int ch0 = (pn - 4) * 128 + cl;
#pragma unroll
            for (int ai = 0; ai < 2; ++ai)
#pragma unroll
                for (int m = 0; m < 4; ++m) { bf16_t* rowp = U + (size_t)(row0 + ai * 128 + m * 16) * 1024 + ch0;
                    const f32x4 a0 = acc[ai][0][m][0], a1 = acc[ai][0][m][1], b0 = acc[ai][1][m][0], b1 = acc[ai][1][m][1]; u32x4 w;
                    w.x = cvt_pk_bf16(a0[0] * b0[0], a0[1] * b0[1]); w.y = cvt_pk_bf16(a0[2] * b0[2], a0[3] * b0[3]); w.z = cvt_pk_bf16(a1[0] * b1[0], a1[1] * b1[1]); w.w = cvt_pk_bf16(a1[2] * b1[2], a1[3] * b1[3]);
                    *(u32x4*)rowp = w; }
        } else {
            asm volatile("" : "+v"(row0));
            const bool isq = pn < 16; bf16_t* base = isq ? Q : Kb; const int col0 = (pn & 3) * 256 + cl; const float sc = (isq ? C2 : 1.0f) * asc;
            const int i0 = 16 * (wc & 1) + 4 * fq;
            float ks[2][8];
#pragma unroll
            for (int bj = 0; bj < 2; ++bj)
#pragma unroll
                for (int e = 0; e < 8; ++e) ks[bj][e] = 0.f;
#pragma unroll
            for (int ai = 0; ai < 2; ++ai) {
                f32x4 csv[4], snv[4];
#pragma unroll
                for (int m = 0; m < 4; ++m) { const int pos = (row0 + ai * 128 + m * 16) & (SEQ - 1); csv[m] = *(const f32x4*)(cosT + pos * 32 + i0); snv[m] = *(const f32x4*)(sinT + pos * 32 + i0); }
                asm volatile("" ::: "memory");
#pragma unroll
                for (int m = 0; m < 4; ++m)
#pragma unroll
                    for (int bj = 0; bj < 2; ++bj) { const int row = row0 + ai * 128 + m * 16;
                        const f32x4 cs = csv[m], sn = snv[m];
                        bf16_t* rowp = base + (size_t)row * 1024 + col0 + bj * 128;
                        const f32x4 v0 = acc[ai][bj][m][0], v1 = acc[ai][bj][m][1]; float o[8];
                        o[0] = (v0[0] * cs[0] - v0[1] * sn[0]) * sc; o[1] = (v0[1] * cs[0] + v0[0] * sn[0]) * sc;
                        o[2] = (v0[2] * cs[1] - v0[3] * sn[1]) * sc; o[3] = (v0[3] * cs[1] + v0[2] * sn[1]) * sc;
                        o[4] = (v1[0] * cs[2] - v1[1] * sn[2]) * sc; o[5] = (v1[1] * cs[2] + v1[0] * sn[2]) * sc;
                        o[6] = (v1[2] * cs[3] - v1[3] * sn[3]) * sc; o[7] = (v1[3] * cs[3] + v1[2] * sn[3]) * sc;
#pragma unroll
                        for (int e = 0; e < 8; ++e) { ks[bj][e] += o[e]; asm volatile("" : "+v"(ks[bj][e])); }
                        u32x4 w; w.x = cvt_pk_bf16(o[0], o[1]); w.y = cvt_pk_bf16(o[2], o[3]); w.z = cvt_pk_bf16(o[4], o[5]); w.w = cvt_pk_bf16(o[6], o[7]);
                        *(u32x4*)(rowp) = w; }
                asm volatile("" ::: "memory");
            }
            if (!isq) {
#pragma unroll
                for (int bj = 0; bj < 2; ++bj)
#pragma unroll
                    for (int e = 0; e < 8; ++e) { float s = ks[bj][e]; s += __shfl_xor(s, 1); s += __shfl_xor(s, 2); s += __shfl_xor(s, 4); s += __shfl_xor(s, 8);
                        if (fr == 0) atomicAdd(ksum + (size_t)u.pm * 1024 + col0 + bj * 128 + e, s); }
            }
        }
    }
};
template <int MODE> struct EpiGate {
    static constexpr bool PERM = true;
    const bf16_t* G; const bf16_t* T1in; bf16_t* O; float asc;
    __device__ __forceinline__ void operator()(const AccT& acc, const Unit& u, int wr, int wc, int fr, int fq) const {
        using pg8::u32x4; using pg8::f32x4;
        asm volatile("" : "+v"(fr), "+v"(fq));
        const int row0 = u.pm * 256 + wr * 64 + fr, col0 = u.pn * 256 + wc * 32 + 8 * fq;
#pragma unroll
        for (int ai = 0; ai < 2; ++ai) {
            u32x4 gg[4][2], tt[4][2];
#pragma unroll
            for (int m = 0; m < 4; ++m)
#pragma unroll
                for (int bj = 0; bj < 2; ++bj) { const size_t off = (size_t)(row0 + ai * 128 + m * 16) * 1024 + col0 + bj * 128;
                    gg[m][bj] = *(const u32x4*)(G + off); if (MODE == 1) tt[m][bj] = *(const u32x4*)(T1in + off); }
            asm volatile("" ::: "memory");
#pragma unroll
            for (int m = 0; m < 4; ++m)
#pragma unroll
                for (int bj = 0; bj < 2; ++bj) { const size_t off = (size_t)(row0 + ai * 128 + m * 16) * 1024 + col0 + bj * 128;
                    const f32x4 v0 = acc[ai][bj][m][0] * asc, v1 = acc[ai][bj][m][1] * asc; const u32x4 g = gg[m][bj]; float o[8];
                    o[0] = bf_lo(g.x) * v0[0]; o[1] = bf_hi(g.x) * v0[1]; o[2] = bf_lo(g.y) * v0[2]; o[3] = bf_hi(g.y) * v0[3];
                    o[4] = bf_lo(g.z) * v1[0]; o[5] = bf_hi(g.z) * v1[1]; o[6] = bf_lo(g.w) * v1[2]; o[7] = bf_hi(g.w) * v1[3];
                    if (MODE == 1) { const u32x4 t = tt[m][bj];
                        o[0] += bf_lo(t.x); o[1] += bf_hi(t.x); o[2] += bf_lo(t.y); o[3] += bf_hi(t.y); o[4] += bf_lo(t.z); o[5] += bf_hi(t.z); o[6] += bf_lo(t.w); o[7] += bf_hi(t.w); }
                    u32x4 w; w.x = cvt_pk_bf16(o[0], o[1]); w.y = cvt_pk_bf16(o[2], o[3]); w.z = cvt_pk_bf16(o[4], o[5]); w.w = cvt_pk_bf16(o[6], o[7]);
                    *(u32x4*)(O + off) = w; }
            asm volatile("" ::: "memory");
        }
    }
};
struct EpiResid {
    static constexpr bool PERM = false;
    const float* X; float* H;
    __device__ __forceinline__ void operator()(const AccT& acc, const Unit& u, int wr, int wc, int fr, int fq) const {
        using pg8::f32x4;
        asm volatile("" : "+v"(fr), "+v"(fq));
        const int row0 = u.pm * 256 + wr * 64 + fr, col0 = u.pn * 256 + wc * 32 + 4 * fq;
#pragma unroll
        for (int ai = 0; ai < 2; ++ai) {
            f32x4 xv[4][2][2];
#pragma unroll
            for (int m = 0; m < 4; ++m)
#pragma unroll
                for (int bj = 0; bj < 2; ++bj)
#pragma unroll
                    for (int n = 0; n < 2; ++n) xv[m][bj][n] = *(const f32x4*)(X + (size_t)(row0 + ai * 128 + m * 16) * 1024 + col0 + bj * 128 + n * 16);
            asm volatile("" ::: "memory");
#pragma unroll
            for (int m = 0; m < 4; ++m)
#pragma unroll
                for (int bj = 0; bj < 2; ++bj)
#pragma unroll
                    for (int n = 0; n < 2; ++n) *(f32x4*)(H + (size_t)(row0 + ai * 128 + m * 16) * 1024 + col0 + bj * 128 + n * 16) = xv[m][bj][n] + acc[ai][bj][m][n];
            asm volatile("" ::: "memory");
        }
    }
};
struct EpiSwiglu {
    static constexpr bool PERM = true;
    const float* bgu; const float* erstd; unsigned char* ACT;
    __device__ __forceinline__ float act1(float g, float up) const { g = fminf(g, 7.0f); up = fminf(fmaxf(up, -7.0f), 7.0f); return (up + 1.0f) * (g * sigmoidf_(1.702f * g)); }
    __device__ __forceinline__ void operator()(const AccT& acc, const Unit& u, int wr, int wc, int fr, int fq) const {
        using pg8::u32x2; using pg8::f32x4;
        asm volatile("" : "+v"(fr), "+v"(fq));
        const int row0 = u.pm * 256 + wr * 64 + fr, ch0 = u.pn * 128 + wc * 32 + 8 * fq;
        const float* bg = bgu + (size_t)u.e * 2048; const float* rsp = erstd + (size_t)u.e * 32768 + u.rt * 256 + wr * 64 + fr;
        f32x4 bgv[2], buv[2];
#pragma unroll
        for (int n = 0; n < 2; ++n) { bgv[n] = *(const f32x4*)(bg + ch0 + 4 * n); buv[n] = *(const f32x4*)(bg + 1024 + ch0 + 4 * n); }
        float rss[2][4];
#pragma unroll
        for (int ai = 0; ai < 2; ++ai)
#pragma unroll
            for (int m = 0; m < 4; ++m) rss[ai][m] = rsp[ai * 128 + m * 16];
        asm volatile("" ::: "memory");
#pragma unroll
        for (int ai = 0; ai < 2; ++ai)
#pragma unroll
            for (int m = 0; m < 4; ++m) { unsigned char* rowp = ACT + (size_t)(row0 + ai * 128 + m * 16) * 1024 + ch0; const float rs = rss[ai][m] * (1.0f / 32.0f);
                float a8[8];
#pragma unroll
                for (int n = 0; n < 2; ++n) { const f32x4 g4 = acc[ai][0][m][n] * rs + bgv[n], u4 = acc[ai][1][m][n] * rs + buv[n];
                    a8[4 * n + 0] = act1(g4[0], u4[0]); a8[4 * n + 1] = act1(g4[1], u4[1]); a8[4 * n + 2] = act1(g4[2], u4[2]); a8[4 * n + 3] = act1(g4[3], u4[3]); }
                int w0 = 0, w1 = 0;
                w0 = __builtin_amdgcn_cvt_pk_fp8_f32(a8[0], a8[1], w0, false); w0 = __builtin_amdgcn_cvt_pk_fp8_f32(a8[2], a8[3], w0, true);
                w1 = __builtin_amdgcn_cvt_pk_fp8_f32(a8[4], a8[5], w1, false); w1 = __builtin_amdgcn_cvt_pk_fp8_f32(a8[6], a8[7], w1, true);
                u32x2 w; w.x = (unsigned)w0; w.y = (unsigned)w1; *(u32x2*)rowp = w; }
    }
};
struct EpiDown {
    static constexpr bool PERM = true;
    const float* bd; const float* ewt; unsigned char* Y;
    __device__ __forceinline__ void operator()(const AccT& acc, const Unit& u, int wr, int wc, int fr, int fq) const {
        using pg8::u32x4; using pg8::f32x4;
        asm volatile("" : "+v"(fr), "+v"(fq));
        const int rl0 = wr * 64 + fr, col0 = u.pn * 256 + wc * 32 + 8 * fq;
        const float* b = bd + (size_t)u.e * 1024 + col0; const float* wp = ewt + (size_t)u.e * 32768 + u.rt * 256 + rl0;
        f32x4 bv[2][2]; float wts[2][4];
#pragma unroll
        for (int bj = 0; bj < 2; ++bj)
#pragma unroll
            for (int n = 0; n < 2; ++n) bv[bj][n] = *(const f32x4*)(b + bj * 128 + 4 * n);
#pragma unroll
        for (int ai = 0; ai < 2; ++ai)
#pragma unroll
            for (int m = 0; m < 4; ++m) wts[ai][m] = wp[ai * 128 + m * 16];
        asm volatile("" ::: "memory");
#pragma unroll
        for (int ai = 0; ai < 2; ++ai)
#pragma unroll
            for (int m = 0; m < 4; ++m) { const int rl = rl0 + ai * 128 + m * 16; const float wt = wts[ai][m] * 16.0f; unsigned char* rowp = Y + (size_t)(u.pm * 256 + rl) * 1024 + col0;
#pragma unroll
                for (int bj = 0; bj < 2; ++bj) { const f32x4 v0 = (acc[ai][bj][m][0] * (1.0f / 32.0f) + bv[bj][0]) * wt, v1 = (acc[ai][bj][m][1] * (1.0f / 32.0f) + bv[bj][1]) * wt;
                    int w0 = 0, w1 = 0; w0 = __builtin_amdgcn_cvt_pk_fp8_f32(v0[0], v0[1], w0, false); w0 = __builtin_amdgcn_cvt_pk_fp8_f32(v0[2], v0[3], w0, true);
                    w1 = __builtin_amdgcn_cvt_pk_fp8_f32(v1[0], v1[1], w1, false); w1 = __builtin_amdgcn_cvt_pk_fp8_f32(v1[2], v1[3], w1, true);
                    pg8::u32x2 w; w.x = (unsigned)w0; w.y = (unsigned)w1; *(pg8::u32x2*)(rowp + bj * 128) = w; } }
    }
};

typedef short bf16x8_t __attribute__((ext_vector_type(8)));
typedef short s16x4_t __attribute__((ext_vector_type(4)));
typedef short v4i16_t __attribute__((ext_vector_type(4)));
__device__ __forceinline__ int crow(int r, int hi) { return (r & 3) + 8 * (r >> 2) + 4 * hi; }
__device__ __forceinline__ s16x4_t vtr(const LAS unsigned char* p) { return __builtin_bit_cast(s16x4_t, __builtin_amdgcn_ds_read_tr16_b64_v4i16((LAS v4i16_t*)p)); }
constexpr int ATT_K = 0, ATT_V = 32768, ATT_Q = 65536, ATT_STG = 98304;
constexpr int UMETA_OFF = LDSCTL_OFF + 1024, WSC_OFF = LDSCTL_OFF + 2048;
constexpr int ALIST_BH = 256 * 2016;
__device__ __forceinline__ int alist_off(int j) { return 256 * (63 * j - (j * (j - 1)) / 2); }
__device__ __forceinline__ void glds16(const void* gsrc, unsigned lds_dst) { unsigned keep;
    asm volatile("s_mov_b32 %0, m0\n\ts_mov_b32 m0, %2\n\ts_nop 0\n\tglobal_load_lds_dwordx4 %1, off\n\ts_mov_b32 m0, %0" : "=&s"(keep) : "v"(gsrc), "s"(lds_dst) : "memory"); }
__device__ __forceinline__ void glds16_nt(const void* gsrc, unsigned lds_dst) { unsigned keep;
    asm volatile("s_mov_b32 %0, m0\n\ts_mov_b32 m0, %2\n\ts_nop 0\n\tglobal_load_lds_dwordx4 %1, off nt\n\ts_mov_b32 m0, %0" : "=&s"(keep) : "v"(gsrc), "s"(lds_dst) : "memory"); }
#define ATT_RFL(x) ((unsigned)__builtin_amdgcn_readfirstlane((int)(x)))
__device__ __forceinline__ void attn_dma_k(unsigned ldsb, const bf16* Kb, size_t rowbase, int h, int wave, int lane) {
#pragma unroll
    for (int i = 0; i < 4; ++i) glds16(Kb + (rowbase + (size_t)(i * 64 + lane)) * 1024 + h * 64 + wave * 8, ATT_RFL(ldsb + ATT_K + wave * 4096 + i * 1024));
}
__device__ __forceinline__ void attn_dma_v(unsigned ldsb, const bf16* Vb, size_t rowbase, int h, int wave, int lane) {
#pragma unroll
    for (int i = 0; i < 4; ++i) { const int vi = wave * 4 + i, dh = vi >> 4, kg = vi & 15;
        glds16(Vb + (rowbase + (size_t)(kg * 16 + (lane >> 2))) * 1024 + h * 64 + dh * 32 + (lane & 3) * 8, ATT_RFL(ldsb + ATT_V + dh * 16384 + kg * 1024)); }
}
__device__ __forceinline__ void attn_dma_q(unsigned ldsb, const bf16* qrowp, int wave, int lane) {
#pragma unroll
    for (int i = 0; i < 4; ++i) glds16(qrowp + (2 * i + (lane >> 5)) * 8, ATT_RFL(ldsb + ATT_Q + wave * 4096 + i * 1024));
}
__device__ __forceinline__ float max3f(float a, float b, float c) { float r; asm("v_max3_f32 %0, %1, %2, %3" : "=v"(r) : "v"(a), "v"(b), "v"(c)); return r; }
__device__ __forceinline__ float max2f(float a, float b) { float r; asm("v_max_f32_e32 %0, %1, %2" : "=v"(r) : "v"(a), "v"(b)); return r; }
__device__ __forceinline__ float fsub_s(float a, float b) { float r; asm("v_sub_f32_e32 %0, %1, %2" : "=v"(r) : "v"(a), "v"(b)); return r; }
__device__ __forceinline__ float rowmax32(const f32x16& p0, const f32x16& p1) {
    float a = max3f(p0[0], p0[1], p1[0]), b = max3f(p0[2], p0[3], p1[1]); a = max3f(a, p1[2], p1[3]);
#pragma unroll
    for (int r = 4; r < 16; r += 4) { a = max3f(a, p0[r], p0[r + 1]); b = max3f(b, p0[r + 2], p0[r + 3]); a = max3f(a, p1[r], p1[r + 1]); b = max3f(b, p1[r + 2], p1[r + 3]); }
    const float m = max2f(a, b);
    auto rr = __builtin_amdgcn_permlane32_swap(__float_as_uint(m), __float_as_uint(m), false, false);
    return max2f(__uint_as_float(rr[0]), __uint_as_float(rr[1]));
}
__device__ __forceinline__ void cmask(f32x16& p0, f32x16& p1, int jb, int qrel, int hi) {
    const int kb = 64 * jb + 4 * hi;
#pragma unroll
    for (int r = 0; r < 16; ++r) { const int kv = kb + (r & 3) + 8 * (r >> 2); p0[r] = (kv > qrel) ? -INFINITY : p0[r]; p1[r] = (kv + 32 > qrel) ? -INFINITY : p1[r]; }
}

constexpr int SIDE_GU = 32 * 64 * 32, SIDE_D = 32 * 64 * 16, SIDE_TASKS = SIDE_GU + SIDE_D;
__device__ __forceinline__ void side_issue(int task, const float* w_gu, const float* w_d, int lane, float (&sv)[16]) {
    const float* src; int N;
    if (task < SIDE_GU) { const int e = task >> 11, r = task & 2047, kb = r >> 5, nb = r & 31; N = 2048; src = w_gu + (size_t)e * 1024 * 2048 + (size_t)(kb * 16) * 2048 + nb * 64 + lane; }
    else { const int t2 = task - SIDE_GU, e = t2 >> 10, r = t2 & 1023, kb = r >> 4, nb = r & 15; N = 1024; src = w_d + (size_t)e * 1024 * 1024 + (size_t)(kb * 16) * 1024 + nb * 64 + lane; }
#pragma unroll
    for (int i = 0; i < 16; ++i) sv[i] = __builtin_nontemporal_load(src + (size_t)i * N);
}
__device__ __forceinline__ void side_finish(int task, unsigned char* Wgu8, unsigned char* Wd8, int lane, const float (&sv)[16]) {
    unsigned char* dst;
    if (task < SIDE_GU) { const int e = task >> 11, r = task & 2047, kb = r >> 5, nb = r & 31, n = nb * 64 + lane; dst = Wgu8 + ((size_t)e * 2048 + dst_row<3>(n)) * 1024 + kb * 16; }
    else { const int t2 = task - SIDE_GU, e = t2 >> 10, r = t2 & 1023, kb = r >> 4, nb = r & 15, n = nb * 64 + lane; dst = Wd8 + ((size_t)e * 1024 + n) * 1024 + kb * 16; }
    v4u o;
#define PK8(j) ({ int w_ = 0; w_ = __builtin_amdgcn_cvt_pk_fp8_f32(sv[4 * (j)] * 32.0f, sv[4 * (j) + 1] * 32.0f, w_, false); w_ = __builtin_amdgcn_cvt_pk_fp8_f32(sv[4 * (j) + 2] * 32.0f, sv[4 * (j) + 3] * 32.0f, w_, true); (unsigned)w_; })
    o.x = PK8(0); o.y = PK8(1); o.z = PK8(2); o.w = PK8(3);
#undef PK8
    *(GAS v4u*)dst = o;
}

__device__ __forceinline__ void side_dma(int task, const float* w_gu, const float* w_d, int lane, unsigned stg_lds) {
    const float* src; int N;
    if (task < SIDE_GU) { const int e = task >> 11, r = task & 2047, kb = r >> 5, nb = r & 31; N = 2048; src = w_gu + (size_t)e * 1024 * 2048 + (size_t)(kb * 16) * 2048 + nb * 64; }
    else { const int t2 = task - SIDE_GU, e = t2 >> 10, r = t2 & 1023, kb = r >> 4, nb = r & 15; N = 1024; src = w_d + (size_t)e * 1024 * 1024 + (size_t)(kb * 16) * 1024 + nb * 64; }
    const float* ls = src + (size_t)(lane >> 3) * N + (lane & 7) * 4;
#pragma unroll
    for (int p = 0; p < 4; ++p) glds16_nt(ls + (size_t)((p >> 1) * 8) * N + (p & 1) * 32, ATT_RFL(stg_lds + p * 1024));
}
__device__ __forceinline__ void side_consume(int task, bool real, unsigned char* dummy, unsigned char* Wgu8, unsigned char* Wd8, int lane, const LAS unsigned char* stg) {
    const LAS float* lp = (const LAS float*)(stg + (lane >> 5) * 1024 + (lane & 31) * 4);
    float sv[16];
#pragma unroll
    for (int k = 0; k < 16; ++k) sv[k] = lp[(k >> 3) * 512 + (k & 7) * 32];
    unsigned char* dst;
    if (task < SIDE_GU) { const int e = task >> 11, r = task & 2047, kb = r >> 5, nb = r & 31, n = nb * 64 + lane; dst = Wgu8 + ((size_t)e * 2048 + dst_row<3>(n)) * 1024 + kb * 16; }
    else { const int t2 = task - SIDE_GU, e = t2 >> 10, r = t2 & 1023, kb = r >> 4, nb = r & 15, n = nb * 64 + lane; dst = Wd8 + ((size_t)e * 1024 + n) * 1024 + kb * 16; }
    v4u o;
#define PK8(j) ({ int w_ = 0; w_ = __builtin_amdgcn_cvt_pk_fp8_f32(sv[4 * (j)] * 32.0f, sv[4 * (j) + 1] * 32.0f, w_, false); w_ = __builtin_amdgcn_cvt_pk_fp8_f32(sv[4 * (j) + 2] * 32.0f, sv[4 * (j) + 3] * 32.0f, w_, true); (unsigned)w_; })
    o.x = PK8(0); o.y = PK8(1); o.z = PK8(2); o.w = PK8(3);
#undef PK8
    if (!real) dst = dummy + lane * 16;
    *(GAS v4u*)dst = o;
}

#define ATT_WB(wait) asm volatile("s_waitcnt " wait "\n\ts_barrier" ::: "memory")
template <bool OWN>
__device__ __forceinline__ void attn_phase(Frame& F, const bf16* Qb, const bf16* Kb, const bf16* Vb, bf16* PO, float* PML, const unsigned short* alist, gu32* acnt, bf16* ATTO,
                                           const float* w_gu, const float* w_d, unsigned char* Wgu8, unsigned char* Wd8) {
    const int r32 = F.lane & 31, hi = F.lane >> 5, wave = F.wave;
    LAS int* um = (LAS int*)(F.lds + UMETA_OFF);
    LAS float* wsc = (LAS float*)(F.lds + WSC_OFF + wave * 1024);
    const unsigned ldsb = (unsigned)(unsigned long)F.lds;
    const LAS unsigned char* kp0 = F.lds + ATT_K + hi * 4096 + r32 * 16;
    const LAS unsigned char* vp0 = F.lds + ATT_V + ((F.lane >> 4) & 1) * 32 + (F.lane & 3) * 8 + (4 * hi + ((F.lane & 15) >> 2)) * 64;
    int nul = 0;
    int st_tail = __builtin_amdgcn_readfirstlane(F.vcu * 8 + wave);
    __syncthreads();
    if (!OWN) {
        LAS int* pfx = (LAS int*)(F.lds + ATT_STG);
        int c4[4]; int sum = 0;
#pragma unroll
        for (int i = 0; i < 4; ++i) { c4[i] = ((int)__hip_atomic_load(acnt + F.tid * 4 + i, RLX_AGENT) + 255) >> 8; sum += c4[i]; }
        int inc = sum;
#pragma unroll
        for (int o = 1; o < 64; o <<= 1) { const int v = __shfl_up(inc, o); if (F.lane >= o) inc += v; }
        LAS int* wt = pfx + 2064;
        if (F.lane == 63) wt[wave] = inc;
        __syncthreads();
        int base = 0;
        for (int w = 0; w < wave; ++w) base += wt[w];
        int ex = base + inc - sum;
#pragma unroll
        for (int i = 0; i < 4; ++i) { pfx[F.tid * 4 + i] = ex; ex += c4[i]; }
        if (F.tid == 511) pfx[2048] = ex;
        __syncthreads();
        const int NU = pfx[2048];
        const int u0 = (int)(((long)blockIdx.x * NU) / F.G), u1 = (int)(((long)(blockIdx.x + 1) * NU) / F.G);
        nul = u1 - u0; if (nul > 64) nul = 64;
        if (F.tid < nul) { const int u = u0 + F.tid; int lo_ = 0, hi_ = 2048;
            while (hi_ - lo_ > 1) { const int mid = (lo_ + hi_) >> 1; if (pfx[mid] <= u) lo_ = mid; else hi_ = mid; }
            const int chunk = u - pfx[lo_], cnt = (int)__hip_atomic_load(acnt + lo_, RLX_AGENT), rem = cnt - chunk * 256;
            um[F.tid * 4 + 0] = lo_; um[F.tid * 4 + 1] = chunk; um[F.tid * 4 + 2] = rem < 256 ? rem : 256; }
    } else {
        nul = ((int)blockIdx.x < 2048) ? (2047 - (int)blockIdx.x) / F.G + 1 : 0; if (nul > 64) nul = 64;
        if (F.tid < nul) { const int u = (int)blockIdx.x + F.tid * F.G; um[F.tid * 4 + 0] = u; um[F.tid * 4 + 1] = 0; um[F.tid * 4 + 2] = 256; }
    }
    __syncthreads();
    if (nul > 0) {
#define ATT_ENT(k) (OWN ? (unsigned)((((um[(k) * 4] & 63) * 256 + wave * 32 + r32) << 2) | 3) \
                        : (unsigned)alist[(size_t)(um[(k) * 4] >> 6) * ALIST_BH + alist_off(um[(k) * 4] & 63) + um[(k) * 4 + 1] * 256 + wave * 32 + r32])
#define ATT_ROWBASE(k) ((size_t)(um[(k) * 4] >> 10) * SEQ + (size_t)(um[(k) * 4] & 63) * 256)
#define ATT_H(k) ((um[(k) * 4] >> 6) & 15)
#define ATT_B(k) (um[(k) * 4] >> 10)
#define A2_SBAR() __builtin_amdgcn_sched_barrier(0)
#define A2_MFMA(a, b, c) __builtin_amdgcn_mfma_f32_32x32x16_bf16(a, b, c, 0, 0, 0)
#define A2_PKW(P, B) cvt_pk_bf16(P[B], P[(B) + 1])
#define A2_PAF(k) __builtin_bit_cast(bf16x8_t, pw##k)
#define A2_VFR(i) (bf16x8_t){vlo[i][0], vlo[i][1], vlo[i][2], vlo[i][3], vhi[i][0], vhi[i][1], vhi[i][2], vhi[i][3]}
#define A2_PIN(x) asm volatile("" : "+v"(x))
#define A2_MX3(a, b, c) __builtin_fmaxf(__builtin_fmaxf((a), (b)), (c))
#define A2_EX(v) __builtin_amdgcn_exp2f(v)
#define A2_GAPA(MF, A0, A1, A2, A3, W0, W1, PW) do { MF; sacc += A0; sacc += A1; sacc += A2; sacc += A3; A2_PIN(sacc); W0; W1; A2_PIN(PW); A2_SBAR(); } while (0)
#define A2_GAPB(MF, X, B) do { MF; X[B] = A2_EX(X[B]); X[(B) + 1] = A2_EX(X[(B) + 1]); X[(B) + 2] = A2_EX(X[(B) + 2]); X[(B) + 3] = A2_EX(X[(B) + 3]); A2_PIN(X); A2_SBAR(); } while (0)
#define A2_VRD(i) do { vlo[i] = vtr(vp_ + (((i) >> 2) * 16384 + ((i) & 3) * 1024)); vhi[i] = vtr(vp_ + (((i) >> 2) * 16384 + ((i) & 3) * 1024 + 512)); } while (0)
#define A2_KRD(G, j) do { if (G) { kf[2 * (j)] = *(const LAS bf16x8_t*)(kn_ + (j) * 8192); kf[2 * (j) + 1] = *(const LAS bf16x8_t*)(kn_ + (j) * 8192 + 512); A2_SBAR(); } } while (0)
#define A2_RESC() do { if (resc) { LDS_WAIT(); _Pragma("unroll") for (int d_ = 0; d_ < 2; ++d_) _Pragma("unroll") for (int r = 0; r < 16; ++r) o[d_][r] *= wsc[crow(r, hi)]; } } while (0)
#define A2_STEP(C0, C1, P0, P1, t, GL) do { A2_SBAR(); \
    const LAS unsigned char* vp_ = vp0 + ((t) - 1) * 4096; const LAS unsigned char* kn_ = kp0 + ((t) + 1) * 1024; (void)kn_; \
    A2_VRD(0); A2_SBAR(); float sacc = (P0[0] + P0[1]); \
    A2_GAPA(C0 = A2_MFMA(kf[0], qr[0], negm), P0[2], P0[3], P0[4], P0[5],     pw0[0] = A2_PKW(P0, 0), pw0[1] = A2_PKW(P0, 2), pw0); \
    A2_VRD(4); A2_SBAR(); A2_GAPA(C1 = A2_MFMA(kf[1], qr[0], negm), P0[6], P0[7], P0[8], P0[9],     pw0[2] = A2_PKW(P0, 4), pw0[3] = A2_PKW(P0, 6), pw0); \
    A2_VRD(1); A2_SBAR(); A2_GAPA(C0 = A2_MFMA(kf[2], qr[1], C0),   P0[10], P0[11], P0[12], P0[13], pw1[0] = A2_PKW(P0, 8), pw1[1] = A2_PKW(P0, 10), pw1); \
    A2_VRD(5); A2_SBAR(); A2_GAPA(C1 = A2_MFMA(kf[3], qr[1], C1),   P0[14], P0[15], P1[0], P1[1],   pw1[2] = A2_PKW(P0, 12), pw1[3] = A2_PKW(P0, 14), pw1); \
    A2_VRD(2); A2_SBAR(); A2_GAPA(C0 = A2_MFMA(kf[4], qr[2], C0),   P1[2], P1[3], P1[4], P1[5],     pw2[0] = A2_PKW(P1, 0), pw2[1] = A2_PKW(P1, 2), pw2); \
    A2_VRD(6); A2_SBAR(); A2_GAPA(C1 = A2_MFMA(kf[5], qr[2], C1),   P1[6], P1[7], P1[8], P1[9],     pw2[2] = A2_PKW(P1, 4), pw2[3] = A2_PKW(P1, 6), pw2); \
    A2_VRD(3); A2_SBAR(); A2_GAPA(C0 = A2_MFMA(kf[6], qr[3], C0),   P1[10], P1[11], P1[12], P1[13], pw3[0] = A2_PKW(P1, 8), pw3[1] = A2_PKW(P1, 10), pw3); \
    A2_VRD(7); A2_SBAR(); A2_GAPA(C1 = A2_MFMA(kf[7], qr[3], C1),   P1[14], P1[15], 0.f, 0.f,       pw3[2] = A2_PKW(P1, 12), pw3[3] = A2_PKW(P1, 14), pw3); \
    l_reg += sacc; \
    if (OWN) { int q_ = qrel; asm volatile("" : "+v"(q_)); cmask(C0, C1, t, q_, hi); } \
    { float a = A2_MX3(C0[0], C0[1], C1[0]), b = A2_MX3(C0[2], C0[3], C1[1]); a = A2_MX3(a, C1[2], C1[3]); \
      _Pragma("unroll") for (int r = 4; r < 16; r += 4) { a = A2_MX3(a, C0[r], C0[r + 1]); b = A2_MX3(b, C0[r + 2], C0[r + 3]); a = A2_MX3(a, C1[r], C1[r + 1]); b = A2_MX3(b, C1[r + 2], C1[r + 3]); } \
      float rm = __builtin_fmaxf(a, b); { auto rr = __builtin_amdgcn_permlane32_swap(__float_as_uint(rm), __float_as_uint(rm), false, false); rm = __builtin_fmaxf(__uint_as_float(rr[0]), __uint_as_float(rr[1])); } \
      resc = false; \
      if (__builtin_expect(__builtin_amdgcn_ballot_w64(rm > 8.0f) != 0, 0)) { const float dl = __builtin_fmaxf(rm, 0.f); mhat += dl; \
        _Pragma("unroll") for (int r = 0; r < 16; ++r) { C0[r] -= dl; C1[r] -= dl; } \
        _Pragma("unroll") for (int r = 0; r < 16; ++r) negm[r] = -mhat; asm volatile("" : "+v"(negm)); \
        const float f = __builtin_amdgcn_exp2f(-dl); l_reg *= f; if (hi == 0) { int r_ = r32; asm volatile("" : "+v"(r_)); wsc[r_] = f; } resc = true; } } \
    A2_SBAR(); \
    A2_GAPB(o[0] = A2_MFMA(A2_PAF(0), A2_VFR(0), o[0]), C0, 0); \
    A2_GAPB(o[1] = A2_MFMA(A2_PAF(0), A2_VFR(4), o[1]), C0, 4); \
    A2_KRD(GL, 0); A2_GAPB(o[0] = A2_MFMA(A2_PAF(1), A2_VFR(1), o[0]), C0, 8); \
    A2_KRD(GL, 1); A2_GAPB(o[1] = A2_MFMA(A2_PAF(1), A2_VFR(5), o[1]), C0, 12); \
    A2_KRD(GL, 2); A2_GAPB(o[0] = A2_MFMA(A2_PAF(2), A2_VFR(2), o[0]), C1, 0); \
    A2_KRD(GL, 3); A2_GAPB(o[1] = A2_MFMA(A2_PAF(2), A2_VFR(6), o[1]), C1, 4); \
    A2_GAPB(o[0] = A2_MFMA(A2_PAF(3), A2_VFR(3), o[0]), C1, 8); \
    A2_GAPB(o[1] = A2_MFMA(A2_PAF(3), A2_VFR(7), o[1]), C1, 12); \
    } while (0)
    unsigned ent0 = 0u, ent1 = ATT_ENT(0), ent2 = (nul > 1) ? ATT_ENT(1) : ent1;
    asm volatile("" : "+v"(ent1), "+v"(ent2));
    attn_dma_k(ldsb, Kb, ATT_ROWBASE(0), ATT_H(0), wave, F.lane);
    attn_dma_q(ldsb, Qb + ((size_t)ATT_B(0) * SEQ + (ent1 >> 2)) * 1024 + ATT_H(0) * 64, wave, F.lane);
    attn_dma_v(ldsb, Vb, ATT_ROWBASE(0), ATT_H(0), wave, F.lane);
    bool prev_active = false;
    int st_next = st_tail; const int st_step = F.G * 8; int st_cur = 0; bool st_real = false;
    const unsigned stg_lds = ldsb + ATT_STG + wave * 4096;
    unsigned char* dummy = Wd8 + (size_t)(WS_SIDE_DUMMY - WS_WD) + (size_t)(F.vcu * 8 + wave) * 1024;
    if (!OWN) { *(GAS v4u*)(dummy + F.lane * 16) = (v4u){0u, 0u, 0u, 0u}; }
    for (int k = 0; k < nul; ++k) {
        const int b = ATT_B(k), h = ATT_H(k), jb = um[k * 4] & 63, nh = um[k * 4 + 2];
        const int qrel = wave * 32 + r32; const bool valid = qrel < nh;
        const bool same_prev = !OWN && k > 0 && um[(k - 1) * 4] == um[k * 4], same_next = !OWN && k + 1 < nul && um[(k + 1) * 4] == um[k * 4];
        const bool more = k + 1 < nul;
        if (!same_prev) { if (OWN) { if (prev_active) { ATT_WB("vmcnt(8)"); } else { ATT_WB("vmcnt(4)"); } } else { if (prev_active) { ATT_WB("vmcnt(10)"); } else { ATT_WB("vmcnt(5)"); } } }
        else { if (prev_active) { asm volatile("s_waitcnt vmcnt(11)" ::: "memory"); } else { asm volatile("s_waitcnt vmcnt(6)" ::: "memory"); } }
        asm volatile("" : "+v"(ent2));
        ent0 = ent1; ent1 = ent2;
        const int t = (int)(ent0 >> 2), slot = (int)(ent0 & 3); const size_t qrow = (size_t)b * SEQ + t;
        bf16x8_t qr[4];
#pragma unroll
        for (int d0 = 0; d0 < 4; ++d0) qr[d0] = *(const LAS bf16x8_t*)(F.lds + ATT_Q + wave * 4096 + (2 * d0 + hi) * 512 + r32 * 16);
        { const int k2 = (k + 2 < nul) ? k + 2 : nul - 1;
          if (OWN) ent2 = ATT_ENT(k2);
          else { const unsigned short* lp = alist + (size_t)(um[k2 * 4] >> 6) * ALIST_BH + alist_off(um[k2 * 4] & 63) + um[k2 * 4 + 1] * 256 + wave * 32 + r32;
              asm volatile("global_load_ushort %0, %1, off" : "=v"(ent2) : "v"(lp) : "memory"); } }
        if (!OWN) { st_real = st_next < SIDE_TASKS; st_cur = st_real ? st_next : SIDE_TASKS - 1; if (st_real) st_next += st_step;
            int ln_ = F.lane; asm volatile("" : "+v"(ln_)); side_dma(st_cur, w_gu, w_d, ln_, stg_lds); }
        const int nv = OWN ? (jb < 3 ? jb : 3) : 0;
        const bool active = wave * 32 < nh;
        float mhat = 0.f, l_reg = 0.f; bool resc = false;
        f32x16 o[2]; o[0] = (f32x16){0.f,0.f,0.f,0.f,0.f,0.f,0.f,0.f,0.f,0.f,0.f,0.f,0.f,0.f,0.f,0.f}; o[1] = o[0];
        f32x16 negm = o[0]; asm volatile("" : "+v"(negm));
        f32x16 pA0, pA1, pB0, pB1; bf16x8_t kf[8]; s16x4_t vlo[8], vhi[8]; v4u pw0, pw1, pw2, pw3;
        if (active) {
#pragma unroll
            for (int j = 0; j < 4; ++j) { kf[2 * j] = *(const LAS bf16x8_t*)(kp0 + j * 8192); kf[2 * j + 1] = *(const LAS bf16x8_t*)(kp0 + j * 8192 + 512); }
            pA0 = A2_MFMA(kf[0], qr[0], negm); pA1 = A2_MFMA(kf[1], qr[0], negm);
#pragma unroll
            for (int d0 = 1; d0 < 4; ++d0) { pA0 = A2_MFMA(kf[2 * d0], qr[d0], pA0); pA1 = A2_MFMA(kf[2 * d0 + 1], qr[d0], pA1); }
            asm volatile("s_nop 15\n\ts_nop 7" : "+v"(pA0), "+v"(pA1));
        }
        LDS_WAIT();
        { int ln_ = F.lane; asm volatile("" : "+v"(ln_)); attn_dma_q(ldsb, Qb + ((size_t)ATT_B(more ? k + 1 : k) * SEQ + (ent1 >> 2)) * 1024 + ATT_H(more ? k + 1 : k) * 64, wave, ln_); }
        if (active) {
#pragma unroll
            for (int j = 0; j < 4; ++j) { kf[2 * j] = *(const LAS bf16x8_t*)(kp0 + 1024 + j * 8192); kf[2 * j + 1] = *(const LAS bf16x8_t*)(kp0 + 1024 + j * 8192 + 512); }
            if (OWN) { int q_ = qrel; asm volatile("" : "+v"(q_)); cmask(pA0, pA1, 0, q_, hi); }
            const float rm = rowmax32(pA0, pA1); mhat = rm;
#pragma unroll
            for (int r = 0; r < 16; ++r) { pA0[r] = fsub_s(pA0[r], rm); pA1[r] = fsub_s(pA1[r], rm); }
#pragma unroll
            for (int r = 0; r < 16; ++r) negm[r] = -mhat;
            asm volatile("" : "+v"(negm));
#pragma unroll
            for (int r = 0; r < 16; ++r) pA0[r] = __builtin_amdgcn_exp2f(pA0[r]);
#pragma unroll
            for (int r = 0; r < 16; ++r) pA1[r] = __builtin_amdgcn_exp2f(pA1[r]);
        }
        if (!same_prev) { if (OWN) { if (prev_active) { ATT_WB("vmcnt(8) lgkmcnt(0)"); } else { ATT_WB("vmcnt(4) lgkmcnt(0)"); } } else { if (prev_active) { ATT_WB("vmcnt(15) lgkmcnt(0)"); } else { ATT_WB("vmcnt(10) lgkmcnt(0)"); } } }
        const bool full = !OWN || wave >= 4;
        if (active) {
            A2_STEP(pB0, pB1, pA0, pA1, 1, true); A2_RESC();
            if (full) { A2_STEP(pA0, pA1, pB0, pB1, 2, true); A2_RESC(); }
        }
        if (!OWN) { asm volatile("s_waitcnt vmcnt(4)" ::: "memory");
            { int ln_ = F.lane; asm volatile("" : "+v"(ln_)); side_consume(st_cur, st_real, dummy, Wgu8, Wd8, ln_, F.lds + ATT_STG + wave * 4096); }
            LDS_WAIT();
            st_real = st_next < SIDE_TASKS; st_cur = st_real ? st_next : SIDE_TASKS - 1; if (st_real) st_next += st_step;
            { int ln_ = F.lane; asm volatile("" : "+v"(ln_)); side_dma(st_cur, w_gu, w_d, ln_, stg_lds); } }
        if (!same_next) { ATT_WB("lgkmcnt(0)");
            if (more) { int ln_ = F.lane; asm volatile("" : "+v"(ln_)); attn_dma_k(ldsb, Kb, ATT_ROWBASE(k + 1), ATT_H(k + 1), wave, ln_); } }
        if (active) {
            if (full) { A2_STEP(pB0, pB1, pA0, pA1, 3, false); A2_RESC(); }
            float sacc = pB0[0] + pB0[1];
#pragma unroll
            for (int r = 2; r < 16; ++r) sacc += pB0[r];
#pragma unroll
            for (int r = 0; r < 16; ++r) sacc += pB1[r];
            l_reg += sacc;
            pw0 = (v4u){A2_PKW(pB0, 0), A2_PKW(pB0, 2), A2_PKW(pB0, 4), A2_PKW(pB0, 6)}; pw1 = (v4u){A2_PKW(pB0, 8), A2_PKW(pB0, 10), A2_PKW(pB0, 12), A2_PKW(pB0, 14)};
            pw2 = (v4u){A2_PKW(pB1, 0), A2_PKW(pB1, 2), A2_PKW(pB1, 4), A2_PKW(pB1, 6)}; pw3 = (v4u){A2_PKW(pB1, 8), A2_PKW(pB1, 10), A2_PKW(pB1, 12), A2_PKW(pB1, 14)};
            { const LAS unsigned char* vp_ = vp0 + (full ? 3 * 4096 : 4096);
#pragma unroll
              for (int i = 0; i < 8; ++i) A2_VRD(i);
              o[0] = A2_MFMA(A2_PAF(0), A2_VFR(0), o[0]); o[1] = A2_MFMA(A2_PAF(0), A2_VFR(4), o[1]);
              o[0] = A2_MFMA(A2_PAF(1), A2_VFR(1), o[0]); o[1] = A2_MFMA(A2_PAF(1), A2_VFR(5), o[1]);
              o[0] = A2_MFMA(A2_PAF(2), A2_VFR(2), o[0]); o[1] = A2_MFMA(A2_PAF(2), A2_VFR(6), o[1]);
              o[0] = A2_MFMA(A2_PAF(3), A2_VFR(3), o[0]); o[1] = A2_MFMA(A2_PAF(3), A2_VFR(7), o[1]); }
            { auto rr = __builtin_amdgcn_permlane32_swap(__float_as_uint(l_reg), __float_as_uint(l_reg), false, false); l_reg = __uint_as_float(rr[0]) + __uint_as_float(rr[1]); }
        }
        if (!same_next) { ATT_WB("lgkmcnt(0)");
            if (more) { int ln_ = F.lane; asm volatile("" : "+v"(ln_)); attn_dma_v(ldsb, Vb, ATT_ROWBASE(k + 1), ATT_H(k + 1), wave, ln_); } }
        else { LDS_WAIT(); }
        if (!OWN) { if (!same_next && more) { asm volatile("s_waitcnt vmcnt(8)" ::: "memory"); } else { asm volatile("s_waitcnt vmcnt(0)" ::: "memory"); }
            { int ln_ = F.lane; asm volatile("" : "+v"(ln_)); side_consume(st_cur, st_real, dummy, Wgu8, Wd8, ln_, F.lds + ATT_STG + wave * 4096); }
            LDS_WAIT(); }
        const float mx = mhat, l = l_reg;
        if (active) {
            int r32e = r32, hie = hi, lne = F.lane; asm volatile("" : "+v"(r32e), "+v"(hie), "+v"(lne));
            LAS bf16* stg = (LAS bf16*)(F.lds + ATT_STG + wave * 4096);
            if (!OWN) {
                if (hie == 0) { wsc[r32e] = 1.0f / l; ((LAS int*)wsc)[32 + r32e] = valid ? (int)((qrow * 16 + h) * 3 + slot) : -1;
                    if (valid) { typedef float f32x2s __attribute__((ext_vector_type(2))); *(GAS f32x2s*)(PML + ((qrow * 16 + h) * 3 + slot) * 2) = (f32x2s){mx, l}; } }
                LDS_WAIT(); asm volatile("" ::: "memory");
#pragma unroll
                for (int r = 0; r < 16; ++r) { const int orow = crow(r, hie); const float rl = wsc[orow];
#pragma unroll
                    for (int dh = 0; dh < 2; ++dh) stg[orow * 64 + dh * 32 + r32e] = (bf16)(cvt_pk_bf16(o[dh][r] * rl, 0.f) & 0xffffu); }
                LDS_WAIT(); asm volatile("" ::: "memory");
#pragma unroll
                for (int i = 0; i < 4; ++i) { const int row = i * 8 + (lne >> 3), ch = lne & 7; const int pidx = ((LAS int*)wsc)[32 + row];
                    const v4u v = *(const LAS v4u*)(stg + row * 64 + ch * 8);
                    bf16* dst = (pidx >= 0) ? PO + (size_t)pidx * 64 + ch * 8 : (bf16*)(dummy + lne * 16);
                    *(GAS v4u*)dst = v; }
            } else {
                float pm_[3], pl_[3];
#pragma unroll
                for (int i = 0; i < 3; ++i) { pm_[i] = -INFINITY; pl_[i] = 0.f; if (i < nv) { const float* pm = PML + ((qrow * 16 + h) * 3 + i) * 2; pm_[i] = pm[0]; pl_[i] = pm[1]; } }
                const size_t grow0 = (size_t)b * SEQ + jb * 256 + wave * 32;
                v4u pp[4][3];
#pragma unroll
                for (int i = 0; i < 4; ++i)
#pragma unroll
                    for (int sl = 0; sl < 3; ++sl) { pp[i][sl] = (v4u){0u, 0u, 0u, 0u};
                        if (sl < nv) pp[i][sl] = *(const GAS v4u*)(PO + (((grow0 + i * 8 + (lne >> 3)) * 16 + h) * 3 + sl) * 64 + (lne & 7) * 8); }
                float Mx = mx;
#pragma unroll
                for (int i = 0; i < 3; ++i) Mx = fmaxf(Mx, pm_[i]);
                const float aown = __builtin_amdgcn_exp2f(mx - Mx); float W = l * aown; float wi[3];
#pragma unroll
                for (int i = 0; i < 3; ++i) { wi[i] = pl_[i] * __builtin_amdgcn_exp2f(pm_[i] - Mx); W += wi[i]; }
                const float rW = 1.0f / W;
                if (hie == 0) { wsc[r32e * 4 + 0] = aown * rW; wsc[r32e * 4 + 1] = wi[0] * rW; wsc[r32e * 4 + 2] = wi[1] * rW; wsc[r32e * 4 + 3] = wi[2] * rW; }
                LDS_WAIT(); asm volatile("" ::: "memory");
#pragma unroll
                for (int r = 0; r < 16; ++r) { const int orow = crow(r, hie); const float c0 = wsc[orow * 4];
#pragma unroll
                    for (int dh = 0; dh < 2; ++dh) stg[orow * 64 + dh * 32 + r32e] = (bf16)(cvt_pk_bf16(o[dh][r] * c0, 0.f) & 0xffffu); }
                LDS_WAIT(); asm volatile("" ::: "memory");
#pragma unroll
                for (int i = 0; i < 4; ++i) { const int row = i * 8 + (lne >> 3), ch = lne & 7;
                    const v4u ov = *(const LAS v4u*)(stg + row * 64 + ch * 8);
                    float a8[8] = {bf_lo(ov.x), bf_hi(ov.x), bf_lo(ov.y), bf_hi(ov.y), bf_lo(ov.z), bf_hi(ov.z), bf_lo(ov.w), bf_hi(ov.w)};
#pragma unroll
                    for (int sl = 0; sl < 3; ++sl) { const float c = wsc[row * 4 + 1 + sl]; const v4u pv = pp[i][sl];
                        a8[0] += c * bf_lo(pv.x); a8[1] += c * bf_hi(pv.x); a8[2] += c * bf_lo(pv.y); a8[3] += c * bf_hi(pv.y);
                        a8[4] += c * bf_lo(pv.z); a8[5] += c * bf_hi(pv.z); a8[6] += c * bf_lo(pv.w); a8[7] += c * bf_hi(pv.w); }
                    int w0 = 0, w1 = 0; w0 = __builtin_amdgcn_cvt_pk_fp8_f32(a8[0] * 16.f, a8[1] * 16.f, w0, false); w0 = __builtin_amdgcn_cvt_pk_fp8_f32(a8[2] * 16.f, a8[3] * 16.f, w0, true);
                    w1 = __builtin_amdgcn_cvt_pk_fp8_f32(a8[4] * 16.f, a8[5] * 16.f, w1, false); w1 = __builtin_amdgcn_cvt_pk_fp8_f32(a8[6] * 16.f, a8[7] * 16.f, w1, true);
                    v2u w; w.x = (unsigned)w0; w.y = (unsigned)w1; *(GAS v2u*)((unsigned char*)ATTO + (grow0 + row) * 1024 + h * 64 + ch * 8) = w; }
            }
        }
        asm volatile("" ::: "memory");
        prev_active = active;
    }
    st_tail = st_next;
    }
    asm volatile("s_waitcnt vmcnt(0) lgkmcnt(0)" ::: "memory");
#ifndef SIDE_IN_P0
    if (!OWN)
#else
    if (false)
#endif
    { float sv[16], sv1[16]; const int st_step = F.G * 8;
        for (int st = st_tail; st < SIDE_TASKS; st += 2 * st_step) { side_issue(st, w_gu, w_d, F.lane, sv); const bool two = st + st_step < SIDE_TASKS; if (two) side_issue(st + st_step, w_gu, w_d, F.lane, sv1);
            side_finish(st, Wgu8, Wd8, F.lane, sv); if (two) side_finish(st + st_step, Wgu8, Wd8, F.lane, sv1); } }
    asm volatile("s_waitcnt vmcnt(0) lgkmcnt(0)" ::: "memory");
    __syncthreads();
#undef ATT_ENT
#undef ATT_ROWBASE
#undef ATT_H
#undef ATT_B
}

#define DECL_PTRS() int z_ = 0; asm volatile("" : "+s"(z_)); unsigned char* ws = args.ws + z_; const float* x = args.in[0 + z_]; const float* g_mix = args.in[1 + z_]; const float* w_in = args.in[2 + z_]; const float* conv_w = args.in[3 + z_]; const float* w_co = args.in[4 + z_]; const float* w_ao = args.in[5 + z_]; const float* w_out = args.in[6 + z_]; const float* g_ffn = args.in[7 + z_]; const float* router_w = args.in[8 + z_]; const float* router_b = args.in[9 + z_]; const float* w_gu = args.in[10 + z_]; const float* b_gu = args.in[11 + z_]; const float* w_d = args.in[12 + z_]; const float* b_d = args.in[13 + z_]; const float* g_fin = args.in[14 + z_]; float* out = args.out + z_; bf16* Win_t = (bf16*)(ws + WS_WIN); bf16* Wco_t = (bf16*)(ws + WS_WCO); bf16* Wao_t = (bf16*)(ws + WS_WAO); bf16* Wout_t = (bf16*)(ws + WS_WOUT); bf16* Wgu_t = (bf16*)(ws + WS_WGU); bf16* Wd_t = (bf16*)(ws + WS_WD); bf16* XN = (bf16*)(ws + WS_XN); bf16* CB = (bf16*)(ws + WS_CB); bf16* U = (bf16*)(ws + WS_U); bf16* Qb = (bf16*)(ws + WS_Q); bf16* Kb = (bf16*)(ws + WS_K); bf16* Vb = (bf16*)(ws + WS_V); bf16* GC = (bf16*)(ws + WS_GC); bf16* GA = (bf16*)(ws + WS_GA); bf16* T1 = U; bf16* MERGED = Qb; bf16* ATTO = XN; bf16* HN = XN; bf16* ACT = (bf16*)(ws + WS_ACT); bf16* Y = (bf16*)(ws + WS_Y); float* cosT = (float*)(ws + WS_COS); float* sinT = (float*)(ws + WS_SIN); float* ksum = (float*)(ws + WS_KSUM); float* rwg = (float*)(ws + WS_RWG); bf16* PO = (bf16*)(ws + WS_PO); float* PML = (float*)(ws + WS_PML); unsigned short* alist = (unsigned short*)(ws + WS_ALIST); gu32* acnt = F.ctl + CW_ACNT; int* etok = (int*)(ws + WS_ETOK); float* ewt = (float*)(ws + WS_EWT); float* erstd = (float*)(ws + WS_ERSTD); (void)erstd; unsigned char* Win8 = ws + WS_WIN8; unsigned char* Wao8 = ws + WS_WAO8; unsigned char* XN8 = ws + WS_XN8; (void)Win8; (void)Wao8; (void)XN8; int* tokslot = (int*)(ws + WS_TOKSLOT); (void)x; (void)out;
struct Args { const float* in[15]; float* out; unsigned char* ws; int ph_lo, ph_hi; };
constexpr int NPHASE = 11;

__global__ void __launch_bounds__(512, 2) fwd_kernel(Args args) {
    extern __shared__ __attribute__((aligned(16))) unsigned char lds_raw[];
    Frame F;
    F.lds = (LAS unsigned char*)lds_raw;
    F.tid = threadIdx.x; F.lane = F.tid & 63; F.wave = __builtin_amdgcn_readfirstlane(F.tid >> 6);
    F.G = gridDim.x; { const int bx = blockIdx.x; F.vcu = (F.G % 8 == 0) ? (bx % 8) * (F.G / 8) + bx / 8 : bx; }
    F.ws = args.ws; F.ctl = (gu32*)(args.ws + WS_CTL);

    for (int u = F.tid; u < (LDS_BYTES - LDSCTL_OFF) / 4; u += 512) ((LAS unsigned*)(F.lds + LDSCTL_OFF))[u] = 0u;
    __syncthreads();
    XcdBarrier bar = xcd_barrier_post((unsigned*)(F.ctl + CW_BAR), (volatile LAS unsigned*)(F.lds + MISC_OFF) + 8);
    const int lo = args.ph_lo, hi = args.ph_hi;
#define IN(k) (lo <= (k) && (k) < hi)
#define SEAM(k) do { if (IN(k) && IN((k) + 1)) xcd_barrier(bar); } while (0)
    const int gw = F.vcu * 8 + F.wave, NGW = F.G * 8;
    LAS int* tab = (LAS int*)(F.lds + TAB_OFF);

    if (IN(0)) {
        DECL_PTRS();
        constexpr int I_IN = 16 * 128, I_SQ = 16 * 16;
        constexpr int NITEMS = I_IN + 3 * I_SQ;
        for (int it = gw; it < NITEMS; it += NGW) {
            int r = it;
            if (r < I_IN) { const int nb = r % 128; if (nb < 48 || (nb >= 96 && nb < 112)) p0_transpose_task<1>(w_in, 8192, Win_t, g_mix, r, F.lane); else p0_transpose_task8<1>(w_in, 8192, Win8, g_mix, r, F.lane); continue; } r -= I_IN;
            if (r < I_SQ) { p0_transpose_task8<0>(w_ao, 1024, Wao8, nullptr, r, F.lane); continue; } r -= I_SQ;
            if (r < I_SQ) { p0_transpose_task<0>(w_co, 1024, Wco_t, nullptr, r, F.lane); continue; } r -= I_SQ;
            p0_transpose_task<0>(w_out, 1024, Wout_t, nullptr, r, F.lane);
        }
        for (int m = gw; m < M; m += NGW) {
            const GAS f32x4* xr = (const GAS f32x4*)(x + (size_t)m * D) + F.lane; f32x4 v[4]; float s = 0.f;
#pragma unroll
            for (int j = 0; j < 4; ++j) { v[j] = xr[64 * j]; s += (v[j].x * v[j].x + v[j].y * v[j].y) + (v[j].z * v[j].z + v[j].w * v[j].w); }
            const float rstd = 1.0f / sqrtf(wave_sum(s) * (1.f / D) + EPS);
            GAS v2u* o8 = (GAS v2u*)(XN + (size_t)m * D) + F.lane; GAS unsigned* o4 = (GAS unsigned*)(XN8 + (size_t)m * D) + F.lane;
#pragma unroll
            for (int j = 0; j < 4; ++j) { v2u w; w.x = cvt_pk_bf16(v[j].x * rstd, v[j].y * rstd); w.y = cvt_pk_bf16(v[j].z * rstd, v[j].w * rstd); o8[64 * j] = w;
                int q8 = 0; q8 = __builtin_amdgcn_cvt_pk_fp8_f32(v[j].x * rstd, v[j].y * rstd, q8, false); q8 = __builtin_amdgcn_cvt_pk_fp8_f32(v[j].z * rstd, v[j].w * rstd, q8, true); o4[64 * j] = (unsigned)q8; }
        }
        const int gt = F.vcu * 512 + F.tid, NT = F.G * 512;
        for (int i = gt; i < SEQ * 32; i += NT) { const int pos = i >> 5, k = i & 31; const float inv = powf(10000.0f, -(float)k / 32.0f); const float ang = (float)pos * inv; cosT[i] = cosf(ang); sinT[i] = sinf(ang); }
        for (int i = gt; i < BATCH * NBLK * 1024; i += NT) ksum[i] = 0.f;
        { unsigned short* rwgH = (unsigned short*)rwg; unsigned short* rwgL = rwgH + 64 * 64 * 8;
          for (int i = gt; i < 64 * 64 * 8; i += NT) { const int jj = i & 7, ln = (i >> 3) & 63, st = i >> 9, k = 16 * st + 8 * (ln >> 5) + jj, e = ln & 31;
              const float v = router_w[k * 32 + e] * g_ffn[k]; const unsigned hb = cvt_pk_bf16(v, 0.f) & 0xffffu; const float vh = __uint_as_float(hb << 16);
              rwgH[i] = (unsigned short)hb; rwgL[i] = (unsigned short)(cvt_pk_bf16(v - vh, 0.f) & 0xffffu); } }
#ifdef SIDE_IN_P0
        { float sv[16], sv1[16]; const int st_step = F.G * 8;
          for (int st = F.vcu * 8 + F.wave; st < SIDE_TASKS; st += 2 * st_step) { side_issue(st, w_gu, w_d, F.lane, sv); const bool two = st + st_step < SIDE_TASKS; if (two) side_issue(st + st_step, w_gu, w_d, F.lane, sv1);
              side_finish(st, (unsigned char*)Wgu_t, (unsigned char*)Wd_t, F.lane, sv); if (two) side_finish(st + st_step, (unsigned char*)Wgu_t, (unsigned char*)Wd_t, F.lane, sv1); } }
#endif
    }
    SEAM(0);
    if (IN(1)) {
        DECL_PTRS();
        { DensePol P{XN, Win_t, M / 256, 16, F.G, (int)blockIdx.x, 2, 12, 0, 12}; EpiInProj E{CB, U, Qb, Kb, Vb, GC, GA, cosT, sinT, ksum, 1.0f};
          pg8::gemm_phase<EpiInProj, DensePol, true>(F.lds, P, E); }
        { DensePol P{XN8, Win8, M / 256, 16, F.G, (int)blockIdx.x, 1, 12, 12, 16}; EpiInProj E{CB, U, Qb, Kb, Vb, GC, GA, cosT, sinT, ksum, 1.0f / 32.0f};
          pg8::gemm_phase<EpiInProj, DensePol, true, true>(F.lds, P, E); }
    }
    SEAM(1);
    if (IN(2)) {
        DECL_PTRS();
        bf16* CBW = CB;
        {
            const int cg = F.tid & 127, rs = F.tid >> 7;
            float w0[8], w1[8], w2[8];
#pragma unroll
            for (int e = 0; e < 8; ++e) { w0[e] = conv_w[cg * 8 + e]; w1[e] = conv_w[1024 + cg * 8 + e]; w2[e] = conv_w[2048 + cg * 8 + e]; }
            const int row0 = F.vcu * (M / F.G) + rs * 32, pos0 = row0 & (SEQ - 1);
            const size_t off0 = (size_t)row0 * 1024 + cg * 8;
            v4u u1 = (v4u){0u, 0u, 0u, 0u}, u2 = (v4u){0u, 0u, 0u, 0u};
            if (pos0 >= 1) u1 = *(const GAS v4u*)(U + off0 - 1024);
            if (pos0 >= 2) u2 = *(const GAS v4u*)(U + off0 - 2048);
#pragma unroll 1
            for (int r = 0; r < 32; r += 4) {
                v4u cb[4], uu[4];
#pragma unroll
                for (int q = 0; q < 4; ++q) { cb[q] = *(const GAS v4u*)(CB + off0 + (size_t)(r + q) * 1024); uu[q] = *(const GAS v4u*)(U + off0 + (size_t)(r + q) * 1024); }
#pragma unroll
                for (int q = 0; q < 4; ++q) {
                    const v4u u0 = uu[q]; float o[8];
#define CV(i, cw, a0, a1, a2, sel) o[i] = sel(cw) * (w0[i] * sel(a2) + w1[i] * sel(a1) + w2[i] * sel(a0))
                    CV(0, cb[q].x, u0.x, u1.x, u2.x, bf_lo); CV(1, cb[q].x, u0.x, u1.x, u2.x, bf_hi); CV(2, cb[q].y, u0.y, u1.y, u2.y, bf_lo); CV(3, cb[q].y, u0.y, u1.y, u2.y, bf_hi);
                    CV(4, cb[q].z, u0.z, u1.z, u2.z, bf_lo); CV(5, cb[q].z, u0.z, u1.z, u2.z, bf_hi); CV(6, cb[q].w, u0.w, u1.w, u2.w, bf_lo); CV(7, cb[q].w, u0.w, u1.w, u2.w, bf_hi);
#undef CV
                    v4u w; w.x = cvt_pk_bf16(o[0], o[1]); w.y = cvt_pk_bf16(o[2], o[3]); w.z = cvt_pk_bf16(o[4], o[5]); w.w = cvt_pk_bf16(o[6], o[7]);
                    *(GAS v4u*)(CBW + off0 + (size_t)(r + q) * 1024) = w;
                    u2 = u1; u1 = u0;
                }
            }
        }
        __syncthreads();
        {
            LAS unsigned char* kmH = F.lds; LAS unsigned char* kmL = F.lds + 8192;
            LAS int* lc = (LAS int*)(F.lds + 16384); LAS int* gb = lc + 64;
            const int r32 = F.lane & 31, hi = F.lane >> 5;
            for (int task = F.vcu; task < 32 * 32; task += F.G) {
                const int bh = task >> 5, chunk = task & 31, b = bh >> 4, h = bh & 15;
                { const int j = F.tid >> 3, c = F.tid & 7;
                  const f32x4 k0 = *(const f32x4*)(ksum + (size_t)(b * 64 + j) * 1024 + h * 64 + c * 8), k1 = *(const f32x4*)(ksum + (size_t)(b * 64 + j) * 1024 + h * 64 + c * 8 + 4);
                  v4u vh; vh.x = cvt_pk_bf16(k0.x, k0.y); vh.y = cvt_pk_bf16(k0.z, k0.w); vh.z = cvt_pk_bf16(k1.x, k1.y); vh.w = cvt_pk_bf16(k1.z, k1.w);
                  v4u vl; vl.x = cvt_pk_bf16(k0.x - bf_lo(vh.x), k0.y - bf_hi(vh.x)); vl.y = cvt_pk_bf16(k0.z - bf_lo(vh.y), k0.w - bf_hi(vh.y));
                  vl.z = cvt_pk_bf16(k1.x - bf_lo(vh.z), k1.y - bf_hi(vh.z)); vl.w = cvt_pk_bf16(k1.z - bf_lo(vh.w), k1.w - bf_hi(vh.w));
                  *(LAS v4u*)(kmH + c * 1024 + j * 16) = vh; *(LAS v4u*)(kmL + c * 1024 + j * 16) = vl; }
                if (F.tid < 64) lc[F.tid] = 0;
                __syncthreads();
                const int own = chunk * 2 + (F.wave >> 2), nv = own < 3 ? own : 3;
                int sel[2][3] = {{0, 0, 0}, {0, 0, 0}}, rk[2][3] = {{0, 0, 0}, {0, 0, 0}};
                if (own > 0) {
#pragma unroll
                    for (int ps = 0; ps < 2; ++ps) {
                        const int t = chunk * 512 + F.wave * 64 + ps * 32 + r32;
                        bf16x8_t qr[4];
#pragma unroll
                        for (int d0 = 0; d0 < 4; ++d0) qr[d0] = *(const bf16x8_t*)(Qb + (size_t)(b * SEQ + t) * 1024 + h * 64 + d0 * 16 + hi * 8);
                        float v0 = -INFINITY, v1 = -INFINITY, v2 = -INFINITY; int i0 = 0, i1 = 0, i2 = 0;
#pragma unroll
                        for (int tl = 0; tl < 2; ++tl) {
                            if (tl * 32 < own) {
                                f32x16 g = {0.f, 0.f, 0.f, 0.f, 0.f, 0.f, 0.f, 0.f, 0.f, 0.f, 0.f, 0.f, 0.f, 0.f, 0.f, 0.f};
#pragma unroll
                                for (int d0 = 0; d0 < 4; ++d0) { const bf16x8_t ah = *(const LAS bf16x8_t*)(kmH + (2 * d0 + hi) * 1024 + (tl * 32 + r32) * 16), al = *(const LAS bf16x8_t*)(kmL + (2 * d0 + hi) * 1024 + (tl * 32 + r32) * 16);
                                    g = __builtin_amdgcn_mfma_f32_32x32x16_bf16(ah, qr[d0], g, 0, 0, 0); g = __builtin_amdgcn_mfma_f32_32x32x16_bf16(al, qr[d0], g, 0, 0, 0); }
#pragma unroll
                                for (int r = 0; r < 16; ++r) { const int j = tl * 32 + crow(r, hi); const float gv = (j < own) ? g[r] : -INFINITY;
                                    if (gv > v0) { v2 = v1; i2 = i1; v1 = v0; i1 = i0; v0 = gv; i0 = j; }
                                    else if (gv > v1) { v2 = v1; i2 = i1; v1 = gv; i1 = j; }
                                    else if (gv > v2) { v2 = gv; i2 = j; } }
                            }
                        }
                        float pv[3] = {__shfl_xor(v0, 32), __shfl_xor(v1, 32), __shfl_xor(v2, 32)}; int pi[3] = {__shfl_xor(i0, 32), __shfl_xor(i1, 32), __shfl_xor(i2, 32)};
#pragma unroll
                        for (int e = 0; e < 3; ++e) { const float gv = pv[e]; const int j = pi[e];
                            if (gv > v0 || (gv == v0 && j < i0)) { v2 = v1; i2 = i1; v1 = v0; i1 = i0; v0 = gv; i0 = j; }
                            else if (gv > v1 || (gv == v1 && j < i1)) { v2 = v1; i2 = i1; v1 = gv; i1 = j; }
                            else if (gv > v2 || (gv == v2 && j < i2)) { v2 = gv; i2 = j; } }
                        sel[ps][0] = i0; sel[ps][1] = i1; sel[ps][2] = i2;
                        if (hi == 0) {
                            rk[ps][0] = __hip_atomic_fetch_add(&lc[i0], 1, __ATOMIC_RELAXED, __HIP_MEMORY_SCOPE_WORKGROUP);
                            if (nv > 1) rk[ps][1] = __hip_atomic_fetch_add(&lc[i1], 1, __ATOMIC_RELAXED, __HIP_MEMORY_SCOPE_WORKGROUP);
                            if (nv > 2) rk[ps][2] = __hip_atomic_fetch_add(&lc[i2], 1, __ATOMIC_RELAXED, __HIP_MEMORY_SCOPE_WORKGROUP);
                        }
                    }
                }
                __syncthreads();
                if (F.tid < 64) { const int c = lc[F.tid]; gb[F.tid] = c ? (int)__hip_atomic_fetch_add((unsigned*)(acnt + bh * 64 + F.tid), (unsigned)c, RLX_AGENT) : 0; }
                __syncthreads();
                if (own > 0 && hi == 0) {
                    unsigned short* lb = alist + (size_t)bh * ALIST_BH;
#pragma unroll
                    for (int ps = 0; ps < 2; ++ps) { const int t = chunk * 512 + F.wave * 64 + ps * 32 + r32;
                        lb[alist_off(sel[ps][0]) + gb[sel[ps][0]] + rk[ps][0]] = (unsigned short)((t << 2) | 0);
                        if (nv > 1) lb[alist_off(sel[ps][1]) + gb[sel[ps][1]] + rk[ps][1]] = (unsigned short)((t << 2) | 1);
                        if (nv > 2) lb[alist_off(sel[ps][2]) + gb[sel[ps][2]] + rk[ps][2]] = (unsigned short)((t << 2) | 2); }
                }
                __syncthreads();
            }
        }
    }
    SEAM(2);
    if (IN(3)) {
        DECL_PTRS();
        attn_phase<false>(F, Qb, Kb, Vb, PO, PML, alist, acnt, ATTO, w_gu, w_d, (unsigned char*)Wgu_t, (unsigned char*)Wd_t);
    }
    SEAM(3);
    if (IN(4)) {
        DECL_PTRS();
        attn_phase<true>(F, Qb, Kb, Vb, PO, PML, alist, acnt, ATTO, w_gu, w_d, (unsigned char*)Wgu_t, (unsigned char*)Wd_t);
    }
    SEAM(4);
    if (IN(5)) {
        DECL_PTRS();
        { DensePol P{CB, Wco_t, M / 256, 4, F.G, (int)blockIdx.x, 2, 4, 0, 0}; EpiGate<0> E{GC, nullptr, T1, 1.0f}; pg8::gemm_phase<EpiGate<0>, DensePol, true>(F.lds, P, E); }
        VM_WAIT(); __syncthreads();
        { DensePol P{ATTO, Wao8, M / 256, 4, F.G, (int)blockIdx.x, 1, 4, 0, 0}; EpiGate<1> E{GA, T1, MERGED, 1.0f / 512.0f}; pg8::gemm_phase<EpiGate<1>, DensePol, true, true>(F.lds, P, E); }
    }
    SEAM(5);
    if (IN(6)) {
        DECL_PTRS();
        DensePol P{MERGED, Wout_t, M / 256, 4, F.G, (int)blockIdx.x, 2, 4, 0, 0}; EpiResid E{x, out};
        pg8::gemm_phase<EpiResid, DensePol, true>(F.lds, P, E);
    }
    SEAM(6);
    if (IN(7)) {
        DECL_PTRS();
        LAS int* lcnt = (LAS int*)(F.lds + 98304); LAS int* gbase = lcnt + 32; LAS float* rbl = (LAS float*)(lcnt + 64);
        if (F.tid < 32) { lcnt[F.tid] = 0; rbl[F.tid] = router_b[F.tid]; }
        __syncthreads();
        const int rows_per_wg = M / F.G;
        int myrank[4] = {0, 0, 0, 0}, mye[4] = {0, 0, 0, 0}; float myw[4] = {0.f, 0.f, 0.f, 0.f}; int mytok = -1; float myrstd = 0.f;
        {
            const int r32 = F.lane & 31, hh = F.lane >> 5, rt = F.wave & 3, kh = F.wave >> 2, row = F.vcu * rows_per_wg + rt * 32 + r32;
            const float* hrow = out + (size_t)row * 1024 + kh * 512 + 8 * hh;
            unsigned char* hn = (unsigned char*)HN + (size_t)row * 1024 + kh * 512 + 8 * hh;
            const float* gfr = g_ffn + kh * 512 + 8 * hh;
            const unsigned short* rwgH = (const unsigned short*)rwg + ((size_t)(kh * 32) * 64 + F.lane) * 8; const unsigned short* rwgL = rwgH + 64 * 64 * 8;
            f32x16 acc = {0.f, 0.f, 0.f, 0.f, 0.f, 0.f, 0.f, 0.f, 0.f, 0.f, 0.f, 0.f, 0.f, 0.f, 0.f, 0.f}; float ss = 0.f;
#pragma unroll 4
            for (int st = 0; st < 32; ++st) {
                const f32x4 a0 = *(const f32x4*)(hrow + 16 * st), a1 = *(const f32x4*)(hrow + 16 * st + 4);
                const v4u bh = *(const v4u*)(rwgH + (size_t)st * 512), bl = *(const v4u*)(rwgL + (size_t)st * 512);
                ss += (a0.x * a0.x + a0.y * a0.y) + (a0.z * a0.z + a0.w * a0.w) + (a1.x * a1.x + a1.y * a1.y) + (a1.z * a1.z + a1.w * a1.w);
                v4u ah; ah.x = cvt_pk_bf16(a0.x, a0.y); ah.y = cvt_pk_bf16(a0.z, a0.w); ah.z = cvt_pk_bf16(a1.x, a1.y); ah.w = cvt_pk_bf16(a1.z, a1.w);
                v4u al; al.x = cvt_pk_bf16(a0.x - bf_lo(ah.x), a0.y - bf_hi(ah.x)); al.y = cvt_pk_bf16(a0.z - bf_lo(ah.y), a0.w - bf_hi(ah.y));
                al.z = cvt_pk_bf16(a1.x - bf_lo(ah.z), a1.y - bf_hi(ah.z)); al.w = cvt_pk_bf16(a1.z - bf_lo(ah.w), a1.w - bf_hi(ah.w));
                { const f32x4 g0 = *(const f32x4*)(gfr + 16 * st), g1 = *(const f32x4*)(gfr + 16 * st + 4); int w0 = 0, w1 = 0;
                  w0 = __builtin_amdgcn_cvt_pk_fp8_f32(a0.x * g0.x, a0.y * g0.y, w0, false); w0 = __builtin_amdgcn_cvt_pk_fp8_f32(a0.z * g0.z, a0.w * g0.w, w0, true);
                  w1 = __builtin_amdgcn_cvt_pk_fp8_f32(a1.x * g1.x, a1.y * g1.y, w1, false); w1 = __builtin_amdgcn_cvt_pk_fp8_f32(a1.z * g1.z, a1.w * g1.w, w1, true);
                  v2u w; w.x = (unsigned)w0; w.y = (unsigned)w1; *(GAS v2u*)(hn + 16 * st) = w; }
                const bf16x8_t fah = __builtin_bit_cast(bf16x8_t, ah), fal = __builtin_bit_cast(bf16x8_t, al), fbh = __builtin_bit_cast(bf16x8_t, bh), fbl = __builtin_bit_cast(bf16x8_t, bl);
                acc = __builtin_amdgcn_mfma_f32_32x32x16_bf16(fah, fbh, acc, 0, 0, 0);
                acc = __builtin_amdgcn_mfma_f32_32x32x16_bf16(fah, fbl, acc, 0, 0, 0);
                acc = __builtin_amdgcn_mfma_f32_32x32x16_bf16(fal, fbh, acc, 0, 0, 0);
            }
            LAS float* xch = (LAS float*)(F.lds + 32768 + rt * 8192);
            if (kh == 1) {
#pragma unroll
                for (int r = 0; r < 16; ++r) xch[r * 64 + F.lane] = acc[r];
                xch[16 * 64 + F.lane] = ss; }
            LDS_WAIT(); __syncthreads();
            if (kh == 0) {
#pragma unroll
                for (int r = 0; r < 16; ++r) acc[r] += xch[r * 64 + F.lane];
                ss += xch[16 * 64 + F.lane];
                ss += __shfl_xor(ss, 32);
                const float rstd = 1.0f / sqrtf(ss * (1.f / D) + EPS);
                LAS float* scr = (LAS float*)(F.lds + rt * 8192);
#pragma unroll
                for (int r = 0; r < 16; ++r) scr[crow(r, hh) * 33 + r32] = acc[r];
                LDS_WAIT(); asm volatile("" ::: "memory");
                if (hh == 0) {
                    float v0 = -INFINITY, v1 = -INFINITY, v2 = -INFINITY, v3 = -INFINITY; int i0 = 0, i1 = 0, i2 = 0, i3 = 0;
#pragma unroll 4
                    for (int e = 0; e < 32; ++e) { const float g = scr[r32 * 33 + e] * rstd + rbl[e];
                        if (g > v0) { v3 = v2; i3 = i2; v2 = v1; i2 = i1; v1 = v0; i1 = i0; v0 = g; i0 = e; }
                        else if (g > v1) { v3 = v2; i3 = i2; v2 = v1; i2 = i1; v1 = g; i1 = e; }
                        else if (g > v2) { v3 = v2; i3 = i2; v2 = g; i2 = e; }
                        else if (g > v3) { v3 = g; i3 = e; } }
                    const float e1 = __expf(v1 - v0), e2 = __expf(v2 - v0), e3 = __expf(v3 - v0), inv = 1.0f / (1.0f + e1 + e2 + e3);
                    mye[0] = i0; mye[1] = i1; mye[2] = i2; mye[3] = i3; myw[0] = inv; myw[1] = e1 * inv; myw[2] = e2 * inv; myw[3] = e3 * inv; mytok = row; myrstd = rstd;
#pragma unroll
                    for (int k = 0; k < 4; ++k) myrank[k] = __hip_atomic_fetch_add(&lcnt[mye[k]], 1, __ATOMIC_RELAXED, __HIP_MEMORY_SCOPE_WORKGROUP);
                }
            }
        }
        __syncthreads();
        if (F.tid < 32) gbase[F.tid] = (int)__hip_atomic_fetch_add((unsigned*)(F.ctl + CW_ECNT + 64 * F.tid), (unsigned)lcnt[F.tid], RLX_AGENT);
        __syncthreads();
        if (mytok >= 0) {
#pragma unroll
            for (int k = 0; k < 4; ++k) { const int e = mye[k], pos = gbase[e] + myrank[k]; etok[e * 32768 + pos] = mytok; ewt[e * 32768 + pos] = myw[k]; erstd[e * 32768 + pos] = myrstd; tokslot[mytok * 4 + k] = e * 32768 + pos; }
        }
    }
    SEAM(7);
    if (IN(8) || IN(9) || IN(10)) {
        __syncthreads();
        if (F.tid < 64) {
            const int e = F.tid & 31; const int c = (int)__hip_atomic_load(F.ctl + CW_ECNT + 64 * e, RLX_AGENT); const int t = (c + 255) >> 8;
            int inc = t;
#pragma unroll
            for (int o = 1; o < 32; o <<= 1) { const int v = __shfl_up(inc, o, 32); if (e >= o) inc += v; }
            if (F.tid < 32) { tab[e] = c; tab[32 + e] = inc - t; if (e == 31) { tab[64] = inc; tab[65] = inc; } }
        }
        __syncthreads();
    }
    if (IN(8)) {
        DECL_PTRS();
        LAS int* ul = (LAS int*)(F.lds + UMETA_OFF); __syncthreads(); const int nul = moe_unit_list(ul, tab, 8, F.G, (int)blockIdx.x, F.tid); __syncthreads();
        MoePol1 P{HN, Wgu_t, etok, tab, ul, nul}; EpiSwiglu E{b_gu, erstd, (unsigned char*)ACT};
        pg8::gemm_phase<EpiSwiglu, MoePol1, true, true>(F.lds, P, E);
    }
    SEAM(8);
    if (IN(9)) {
        DECL_PTRS();
        LAS int* ul = (LAS int*)(F.lds + UMETA_OFF); __syncthreads(); const int nul = moe_unit_list(ul, tab, 4, F.G, (int)blockIdx.x, F.tid); __syncthreads();
        MoePol2 P{ACT, Wd_t, ul, nul}; EpiDown E{b_d, ewt, (unsigned char*)Y};
        pg8::gemm_phase<EpiDown, MoePol2, true, true>(F.lds, P, E);
    }
    SEAM(9);
    if (IN(10)) {
        DECL_PTRS();
        const unsigned tmo = __hip_atomic_load(F.ctl + CW_BAR + XB_TMO, RLX_AGENT);
        f32x4 gfv[4];
#pragma unroll
        for (int j = 0; j < 4; ++j) gfv[j] = ((const GAS f32x4*)g_fin + F.lane)[64 * j];
        for (int m = gw; m < M; m += NGW) {
            GAS f32x4* hr = (GAS f32x4*)(out + (size_t)m * D) + F.lane; f32x4 v[4];
#pragma unroll
            for (int j = 0; j < 4; ++j) v[j] = hr[64 * j];
#pragma unroll
            for (int k = 0; k < 4; ++k) { const int ts = tokslot[m * 4 + k], e = ts >> 15, pos = ts & 32767; const size_t srow = (size_t)tab[32 + e] * 256 + pos;
                const GAS unsigned* yr = (const GAS unsigned*)((const unsigned char*)Y + srow * 1024) + F.lane;
#pragma unroll
                for (int j = 0; j < 4; ++j) { const unsigned w = yr[64 * j]; const pg8::f32x2 lo2 = __builtin_amdgcn_cvt_pk_f32_fp8((int)w, false), hi2 = __builtin_amdgcn_cvt_pk_f32_fp8((int)w, true);
                    v[j].x += lo2[0] * (1.0f / 16.0f); v[j].y += lo2[1] * (1.0f / 16.0f); v[j].z += hi2[0] * (1.0f / 16.0f); v[j].w += hi2[1] * (1.0f / 16.0f); } }
            float s = 0.f;
#pragma unroll
            for (int j = 0; j < 4; ++j) s += (v[j].x * v[j].x + v[j].y * v[j].y) + (v[j].z * v[j].z + v[j].w * v[j].w);
            float rstd = 1.0f / sqrtf(wave_sum(s) * (1.f / D) + EPS);
            if (tmo) rstd = __builtin_nanf("");
#pragma unroll
            for (int j = 0; j < 4; ++j) hr[64 * j] = v[j] * rstd * gfv[j];
        }
    }
#undef IN
#undef SEAM
}

extern "C" void kernel_launch(void* const* d_in, const int* in_sizes, int n_in, void* d_out, int out_size, void* d_ws, size_t ws_size, hipStream_t stream) {
    static int grid = 0;
    if (grid == 0) {
        if (n_in != 15 || out_size != M * D || ws_size < WS_END) { fprintf(stderr, "kernel_launch: unexpected shapes (n_in %d out %d ws %zu); nothing launched\n", n_in, out_size, ws_size); grid = -1; return; }
        int dev = 0, cus = 0, per_cu = 0;
        if (hipGetDevice(&dev) != hipSuccess || hipDeviceGetAttribute(&cus, hipDeviceAttributeMultiprocessorCount, dev) != hipSuccess) { grid = -1; return; }
        if (hipFuncSetAttribute((const void*)fwd_kernel, hipFuncAttributeMaxDynamicSharedMemorySize, LDS_BYTES) != hipSuccess) { fprintf(stderr, "kernel_launch: hipFuncSetAttribute failed\n"); grid = -1; return; }
        if (hipOccupancyMaxActiveBlocksPerMultiprocessor(&per_cu, (const void*)fwd_kernel, 512, LDS_BYTES) != hipSuccess || per_cu < 1) { fprintf(stderr, "kernel_launch: occupancy query reports %d blocks per CU; nothing launched\n", per_cu); (void)hipGetLastError(); grid = -1; return; }
        (void)hipGetLastError();
        grid = cus;
    }
    if (grid < 0) return;
    (void)hipMemsetAsync((char*)d_ws + WS_CTL, 0, CTL_ZERO_BYTES, stream);
    Args a{};
    for (int i = 0; i < 15; ++i) a.in[i] = (const float*)d_in[i];
    a.out = (float*)d_out; a.ws = (unsigned char*)d_ws;
    a.ph_lo = 0; a.ph_hi = NPHASE;
#ifndef LAUNCH_PLAN
    hipLaunchKernelGGL(fwd_kernel, dim3(grid), dim3(512), LDS_BYTES, stream, a);
#else
    { static const int plan[] = {LAUNCH_PLAN}; for (unsigned i = 0; i < sizeof(plan) / sizeof(plan[0]); ++i) { a.ph_lo = plan[i]; a.ph_hi = plan[i] + 1; hipLaunchKernelGGL(fwd_kernel, dim3(grid), dim3(512), LDS_BYTES, stream, a); } }
#endif
}
```

```cpp
#include <hip/hip_runtime.h>
#include <cstdio>
#include <cstdint>
#include <cmath>


constexpr int BATCH = 2, SEQ = 16384, D = 1024, M = BATCH * SEQ, NH = 16, HD = 64, NBLK = SEQ / 256, NE = 32, NIN = 8192;
constexpr float EPS = 1e-5f;
constexpr float C2 = 0.125f * 1.4426950408889634f;

namespace pg8 {
#define PG8_LAS __attribute__((address_space(3)))
typedef unsigned short bf16_t;
typedef short bf16x8 __attribute__((ext_vector_type(8)));
typedef float f32x4 __attribute__((ext_vector_type(4)));
typedef float f32x2 __attribute__((ext_vector_type(2)));
typedef unsigned u32x4 __attribute__((ext_vector_type(4)));
typedef unsigned u32x2 __attribute__((ext_vector_type(2)));
constexpr int BM = 256, BK = 64, HALF = 128, HTB = HALF * BK * 2, STAGE_BYTES = 8 * HTB, NXCD = 8, WGM = 8, KD = 1024;

__host__ __device__ __forceinline__ int lds_byte(int r, int c) { const int st = (r >> 4) * 2 + (c >> 5), rr = r & 15, cc = c & 31, ob = rr * 64 + cc * 2; return st * 1024 + (ob ^ (((ob >> 9) & 1) << 5)); }
__host__ __device__ __forceinline__ void stage_rc(int b, int& R, int& C) { const int st = b / 1024, sb = b % 1024, swz = sb ^ (((sb >> 9) & 1) << 5); R = (st >> 1) * 16 + swz / 64; C = (st & 1) * 32 + (swz % 64) / 2; }
__host__ __device__ __forceinline__ int perm32(int rho) { const int n = rho >> 4, i = rho & 15; return 8 * (i >> 2) + 4 * n + (i & 3); }

struct Unit { int pm, pn, e, rt; };

typedef float f32x2_cv __attribute__((ext_vector_type(2))); typedef __bf16 bf16x2_cv __attribute__((ext_vector_type(2)));
__device__ __forceinline__ unsigned cvt_pk_bf16(float lo, float hi) { const f32x2_cv v = {lo, hi}; const bf16x2_cv b = __builtin_convertvector(v, bf16x2_cv); return __builtin_bit_cast(unsigned, b); }
__device__ __forceinline__ float bf_lo(unsigned w) { return __uint_as_float(w << 16); }
__device__ __forceinline__ float bf_hi(unsigned w) { return __uint_as_float(w & 0xffff0000u); }

__device__ __forceinline__ bool tile_order(int i, int G, int c, int nM, int nN, int& pm, int& pn) {
    const int nwg = nM * nN; const long L = (long)i * G + c; if (L >= nwg) return false;
    int wgid = (int)L;
    { const int q = nwg / NXCD, r = nwg % NXCD, xcd = wgid % NXCD, off = wgid / NXCD; wgid = (xcd < r ? xcd * (q + 1) : r * (q + 1) + (xcd - r) * q) + off; }
    const int nig = WGM * nN, gid = wgid / nig, fm = gid * WGM, gsz = (nM - fm) < WGM ? (nM - fm) : WGM;
    pm = fm + ((wgid % nig) % gsz); pn = (wgid % nig) / gsz; return true;
}

typedef int v8i __attribute__((ext_vector_type(8)));
typedef int v4i __attribute__((ext_vector_type(4)));
template <class Epi, class Pol, bool ALIGN_EPI, bool FP8 = false>
__device__ __forceinline__ void gemm_phase(PG8_LAS unsigned char* lds, const Pol& S, const Epi& E) {
    constexpr int K = KD, KB = FP8 ? KD : 2 * KD  , nt = KB / 128;
    const int tid = threadIdx.x, wid = __builtin_amdgcn_readfirstlane(tid >> 6), lane = tid & 63, wr = wid >> 2, wc = wid & 3, fr = lane & 15, fq = lane >> 4;
    int RA[2], CA[2]; unsigned voffB[2];
#pragma unroll
    for (int i = 0; i < 2; ++i) { int R, C; stage_rc(tid * 16 + i * 8192, R, C); const int Rb = Epi::PERM ? ((R & ~31) + perm32(R & 31)) : R;
        RA[i] = R; CA[i] = C; voffB[i] = (unsigned)(Rb * KB + C * 2); }
    constexpr unsigned kstep = BK * 2, hstep = (unsigned)HALF * KB;
    const unsigned ldsw = (unsigned)wid * 1024u;
    const int aoff = lds_byte(wr * 64 + fr, fq * 8), boff = lds_byte(wc * 32 + fr, fq * 8);
#define PG8_SA(b, h) (((b) * 2 + (h)) * HTB)
#define PG8_SB(b, h) ((4 + (b) * 2 + (h)) * HTB)
#define PG8_GLDS(bufoff, ptr, o0, o1) do { \
        __builtin_amdgcn_global_load_lds((const unsigned*)((const char*)(ptr) + (o0)), (PG8_LAS unsigned*)(lds + (bufoff) + ldsw), 16, 0, 0); \
        __builtin_amdgcn_global_load_lds((const unsigned*)((const char*)(ptr) + (o1)), (PG8_LAS unsigned*)(lds + (bufoff) + ldsw + 8192), 16, 0, 0); } while (0)
#define PG8_STAGE_B(bufoff, ptr) PG8_GLDS(bufoff, ptr, voffB[0], voffB[1])
#define PG8_LDA(dst, b, h) do { if constexpr (FP8) { _Pragma("unroll") for (int m = 0; m < 4; ++m) { const v4i l_ = *(const PG8_LAS v4i*)(lds + PG8_SA(b, h) + aoff + m * 2048), h_ = *(const PG8_LAS v4i*)(lds + PG8_SA(b, h) + aoff + m * 2048 + 1024); \
            dst##8[m] = (v8i){l_[0], l_[1], l_[2], l_[3], h_[0], h_[1], h_[2], h_[3]}; } } \
        else { _Pragma("unroll") for (int m = 0; m < 4; ++m) _Pragma("unroll") for (int k = 0; k < 2; ++k) dst[m][k] = *(const PG8_LAS bf16x8*)(lds + PG8_SA(b, h) + aoff + m * 2048 + k * 1024); } } while (0)
#define PG8_LDB(dst, b, h) do { if constexpr (FP8) { _Pragma("unroll") for (int n = 0; n < 2; ++n) { const v4i l_ = *(const PG8_LAS v4i*)(lds + PG8_SB(b, h) + boff + n * 2048), h_ = *(const PG8_LAS v4i*)(lds + PG8_SB(b, h) + boff + n * 2048 + 1024); \
            dst##8[n] = (v8i){l_[0], l_[1], l_[2], l_[3], h_[0], h_[1], h_[2], h_[3]}; } } \
        else { _Pragma("unroll") for (int n = 0; n < 2; ++n) _Pragma("unroll") for (int k = 0; k < 2; ++k) dst[n][k] = *(const PG8_LAS bf16x8*)(lds + PG8_SB(b, h) + boff + n * 2048 + k * 1024); } } while (0)
#define PG8_MMA(ai, bj, At, Bt) do { __builtin_amdgcn_s_setprio(1); if constexpr (FP8) { _Pragma("unroll") for (int m = 0; m < 4; ++m) _Pragma("unroll") for (int n = 0; n < 2; ++n) \
        asm volatile("s_nop 1\n\tv_mfma_scale_f32_16x16x128_f8f6f4 %0, %1, %2, %0, %3, %3 op_sel_hi:[0,0,0]" : "+v"(acc[ai][bj][m][n]) : "v"(Bt##8[n]), "v"(At##8[m]), "v"(one_scale)); } \
        else { _Pragma("unroll") for (int m = 0; m < 4; ++m) _Pragma("unroll") for (int n = 0; n < 2; ++n) _Pragma("unroll") for (int k = 0; k < 2; ++k) \
        acc[ai][bj][m][n] = __builtin_amdgcn_mfma_f32_16x16x32_bf16(Bt[n][k], At[m][k], acc[ai][bj][m][n], 0, 0, 0); } __builtin_amdgcn_s_setprio(0); } while (0)
#define PG8_WAIT_V(n) asm volatile("s_waitcnt vmcnt(" #n ")" ::: "memory")
#define PG8_WAIT_L(n) asm volatile("s_waitcnt lgkmcnt(" #n ")" ::: "memory")
#define PG8_BAR __builtin_amdgcn_s_barrier()
#define PG8_SCHED __builtin_amdgcn_sched_barrier(0)
#define PG8_AOFF(vo, u) do { _Pragma("unroll") for (int h_ = 0; h_ < 2; ++h_) _Pragma("unroll") for (int i_ = 0; i_ < 2; ++i_) { \
        if constexpr (Pol::GATHER) vo[h_][i_] = (unsigned)(S.gather(u, h_ * HALF + RA[i_]) * KB + CA[i_] * 2); \
        else vo[h_][i_] = (unsigned)((h_ * HALF + RA[i_]) * KB + CA[i_] * 2); } } while (0)
    Unit cur, nxt; int ui = 0;
    if (!S.next(0, cur)) return;
    f32x4 acc[2][2][4][2];
#pragma unroll
    for (int a = 0; a < 2; ++a)
#pragma unroll
        for (int b = 0; b < 2; ++b)
#pragma unroll
            for (int m = 0; m < 4; ++m)
#pragma unroll
                for (int n = 0; n < 2; ++n) acc[a][b][m][n] = (f32x4){0.f, 0.f, 0.f, 0.f};
    bf16x8 At[4][2], B0[2][2], B1[2][2]; v8i At8[4], B08[2], B18[2];
    int one_scale = 0x7f7f7f7f; asm volatile("" : "+v"(one_scale));
    unsigned voC[2][2], voN[2][2];
    PG8_AOFF(voC, cur);
#pragma unroll
    for (int h_ = 0; h_ < 2; ++h_)
#pragma unroll
        for (int i_ = 0; i_ < 2; ++i_) voN[h_][i_] = voC[h_][i_];
    const char* cA = S.a_base(cur); const char* cB = S.b_base(cur);
    PG8_STAGE_B(PG8_SB(0, 0), cB); PG8_STAGE_B(PG8_SB(0, 1), cB + hstep); PG8_GLDS(PG8_SA(0, 0), cA, voC[0][0], voC[0][1]); PG8_GLDS(PG8_SA(0, 1), cA, voC[1][0], voC[1][1]);
    if (wr == 1) PG8_BAR;
    PG8_WAIT_V(2); PG8_BAR;
    PG8_STAGE_B(PG8_SB(1, 0), cB + kstep); PG8_GLDS(PG8_SA(1, 0), cA + kstep, voC[0][0], voC[0][1]); PG8_STAGE_B(PG8_SB(1, 1), cB + hstep + kstep);
    PG8_WAIT_V(6); PG8_BAR;
    for (;;) {
        const bool has_next = S.next(ui + 1, nxt);
        const char* nA = cA; const char* nB = cB;
        if (has_next) { nA = S.a_base(nxt); nB = S.b_base(nxt); if constexpr (Pol::GATHER) { PG8_AOFF(voN, nxt); } }
        else { if constexpr (Pol::GATHER) {
#pragma unroll
            for (int h_ = 0; h_ < 2; ++h_)
#pragma unroll
                for (int i_ = 0; i_ < 2; ++i_) voN[h_][i_] = voC[h_][i_]; } }
#pragma unroll 1
        for (int t = 0; t < nt; t += 2) {
            const bool last = (t == nt - 2);
            const char* a1 = cA + (size_t)(t + 1) * kstep;
            const char* a2 = last ? nA : cA + (size_t)(t + 2) * kstep; const char* b2 = last ? nB : cB + (size_t)(t + 2) * kstep;
            const char* a3 = a2 + kstep; const char* b3 = b2 + kstep;
            unsigned o00, o01, o10, o11;
            if constexpr (Pol::GATHER) { o00 = last ? voN[0][0] : voC[0][0]; o01 = last ? voN[0][1] : voC[0][1]; o10 = last ? voN[1][0] : voC[1][0]; o11 = last ? voN[1][1] : voC[1][1]; }
            else { o00 = voC[0][0]; o01 = voC[0][1]; o10 = voC[1][0]; o11 = voC[1][1]; }
            PG8_LDB(B0, 0, 0); PG8_LDB(B1, 0, 1); PG8_SCHED; PG8_LDA(At, 0, 0); PG8_GLDS(PG8_SA(1, 1), a1, voC[1][0], voC[1][1]);
            PG8_WAIT_V(8); PG8_WAIT_L(0); PG8_BAR; PG8_MMA(0, 0, At, B0); PG8_MMA(0, 1, At, B1); PG8_BAR; PG8_SCHED;
            PG8_LDA(At, 0, 1); PG8_STAGE_B(PG8_SB(0, 0), b2); PG8_STAGE_B(PG8_SB(0, 1), b2 + hstep); PG8_GLDS(PG8_SA(0, 0), a2, o00, o01);
            PG8_WAIT_V(8); PG8_WAIT_L(0); PG8_BAR; PG8_MMA(1, 0, At, B0); PG8_MMA(1, 1, At, B1); PG8_BAR; PG8_SCHED;
            PG8_LDB(B0, 1, 0); PG8_LDB(B1, 1, 1); PG8_SCHED; PG8_LDA(At, 1, 0); PG8_GLDS(PG8_SA(0, 1), a2, o10, o11);
            PG8_WAIT_V(8); PG8_WAIT_L(0); PG8_BAR; PG8_MMA(0, 0, At, B0); PG8_MMA(0, 1, At, B1); PG8_BAR; PG8_SCHED;
            PG8_LDA(At, 1, 1); PG8_STAGE_B(PG8_SB(1, 0), b3); PG8_STAGE_B(PG8_SB(1, 1), b3 + hstep); PG8_GLDS(PG8_SA(1, 0), a3, o00, o01);
            PG8_WAIT_V(8); PG8_WAIT_L(0); PG8_BAR; PG8_MMA(1, 0, At, B0); PG8_MMA(1, 1, At, B1); PG8_BAR; PG8_SCHED;
        }
        if constexpr (FP8) asm volatile("s_nop 15\n\ts_nop 15" ::: "memory");
        if constexpr (ALIGN_EPI) { if (wr == 0) PG8_BAR; }
        E(acc, cur, wr, wc, fr, fq);
        if (!has_next) break;
#pragma unroll
        for (int a = 0; a < 2; ++a)
#pragma unroll
            for (int b = 0; b < 2; ++b)
#pragma unroll
                for (int m = 0; m < 4; ++m)
#pragma unroll
                    for (int n = 0; n < 2; ++n) acc[a][b][m][n] = (f32x4){0.f, 0.f, 0.f, 0.f};
        cur = nxt; cA = nA; cB = nB; ++ui;
#pragma unroll
        for (int h_ = 0; h_ < 2; ++h_)
#pragma unroll
            for (int i_ = 0; i_ < 2; ++i_) voC[h_][i_] = voN[h_][i_];
        if constexpr (ALIGN_EPI) { if (wr == 1) PG8_BAR; }
    }
    PG8_WAIT_V(0);
    if constexpr (!ALIGN_EPI) { if (wr == 0) PG8_BAR; }
    PG8_BAR;
#undef PG8_SA
#undef PG8_SB
#undef PG8_GLDS
#undef PG8_STAGE_B
#undef PG8_LDA
#undef PG8_LDB
#undef PG8_MMA
#undef PG8_WAIT_V
#undef PG8_WAIT_L
#undef PG8_BAR
#undef PG8_SCHED
#undef PG8_AOFF
}
}

constexpr size_t MiB = 1u << 20;
constexpr size_t WS_CTL = 0, CTL_ZERO_BYTES = 1 * MiB;
constexpr size_t WS_RWG = 1 * MiB;
constexpr size_t WS_KSUM = 1 * MiB + 512 * 1024;
constexpr size_t WS_ETOK = 2 * MiB;
constexpr size_t WS_EWT = 6 * MiB;
constexpr size_t WS_TOKSLOT = 10 * MiB;
constexpr size_t WS_COS = 11 * MiB, WS_SIN = 13 * MiB;
constexpr size_t WS_WCO = 16 * MiB, WS_WAO = 18 * MiB, WS_WOUT = 20 * MiB;
constexpr size_t WS_WIN = 24 * MiB;
constexpr size_t WS_WGU = 40 * MiB;
constexpr size_t WS_WD = 168 * MiB;
constexpr size_t WS_XN = 232 * MiB;
constexpr size_t WS_CB = 296 * MiB;
constexpr size_t WS_U = 360 * MiB;
constexpr size_t WS_Q = 424 * MiB;
constexpr size_t WS_K = 488 * MiB;
constexpr size_t WS_V = 552 * MiB;
constexpr size_t WS_GC = 616 * MiB;
constexpr size_t WS_GA = 680 * MiB;
constexpr size_t WS_PO = 744 * MiB;
constexpr size_t WS_PML = 936 * MiB;
constexpr size_t WS_ALIST = 952 * MiB;
constexpr size_t WS_ACT = 296 * MiB;
constexpr size_t WS_Y = 616 * MiB;
constexpr size_t WS_WIN8 = 104 * MiB;
constexpr size_t WS_WAO8 = 112 * MiB;
constexpr size_t WS_XN8 = 744 * MiB;
constexpr size_t WS_ERSTD = 986 * MiB;
constexpr size_t WS_SIDE_DUMMY = 990 * MiB;
constexpr size_t WS_END = 992 * MiB;
constexpr int CW_BAR = 4096;
constexpr int CW_ECNT = 8192;
constexpr int CW_ACNT = 16384;
constexpr int CW_DBG = 20000;

constexpr int RING_BYTES = 131072, LDSCTL_OFF = RING_BYTES, MISC_OFF = LDSCTL_OFF + 320, TAB_OFF = LDSCTL_OFF + 512, LDS_BYTES = 147456;

#define GAS __attribute__((address_space(1)))
#define LAS __attribute__((address_space(3)))
typedef unsigned short bf16;
typedef unsigned v4u __attribute__((ext_vector_type(4)));
typedef unsigned v2u __attribute__((ext_vector_type(2)));
typedef float f32x4 __attribute__((ext_vector_type(4)));
typedef float f32x16 __attribute__((ext_vector_type(16)));
typedef GAS unsigned gu32;
#define RLX_AGENT __ATOMIC_RELAXED, __HIP_MEMORY_SCOPE_AGENT
#define LDS_WAIT() asm volatile("s_waitcnt lgkmcnt(0)" ::: "memory")
#define VM_WAIT() asm volatile("s_waitcnt vmcnt(0)" ::: "memory")
using pg8::cvt_pk_bf16; using pg8::bf_lo; using pg8::bf_hi;

#define XB_TMO      128
#define XB_XCNT(j)  (256  + 64 * (j))
#define XB_XSUB(j)  (1280 + 64 * (j))
#define XB_XGEN(j)  (2304 + 64 * (j))
#define XB_TOP      3328
#define XB_TOPGEN   3392
#define XCD_BAR_WORDS 3456
#define XB_SPIN_CAP (1u << 18)
__device__ __forceinline__ unsigned xb_ld(unsigned* p)              { return __hip_atomic_load(p, __ATOMIC_RELAXED, __HIP_MEMORY_SCOPE_AGENT); }
__device__ __forceinline__ unsigned xb_add(unsigned* p, unsigned v) { return __hip_atomic_fetch_add(p, v, __ATOMIC_RELAXED, __HIP_MEMORY_SCOPE_AGENT); }
__device__ __forceinline__ unsigned xb_xcc_id() { return (unsigned)__builtin_amdgcn_s_getreg((3 << 11) | 20) & 0xFu; }
#define XB_SPIN(cond, bar) do { unsigned _sp = 0; while (cond) { __builtin_amdgcn_s_sleep(1); \
    if ((++_sp & 255u) == 0u) { if (xb_ld(&(bar)[XB_TMO])) break; if (_sp > XB_SPIN_CAP) { atomicAdd(&(bar)[XB_TMO], 1u); break; } } } } while (0)
struct XcdBarrier { unsigned* bar; unsigned x; volatile LAS unsigned* st; };
__device__ __forceinline__ XcdBarrier xcd_barrier_post(unsigned* bar, volatile LAS unsigned* st) {
    XcdBarrier b; b.bar = bar; b.x = xb_xcc_id(); b.st = st;
    if (threadIdx.x == 0) (void)xb_add(&bar[XB_XCNT(b.x)], 1u);
    return b;
}
__device__ __forceinline__ void xcd_barrier_complete(unsigned* bar, unsigned x, unsigned& nloc, unsigned& nx) {
    const unsigned G = gridDim.x * gridDim.y * gridDim.z;
    unsigned sum, cnt, mine, sp = 0u;
    for (;;) {
        sum = 0u; cnt = 0u; mine = 0u;
#pragma unroll
        for (unsigned j = 0; j < 16; ++j) { const unsigned c = xb_ld(&bar[XB_XCNT(j)]); sum += c; cnt += (c > 0u) ? 1u : 0u; mine = (j == x) ? c : mine; }
        if (sum == G) break;
        __builtin_amdgcn_s_sleep(1);
        if ((++sp & 255u) == 0u) { if (xb_ld(&bar[XB_TMO])) break; if (sp > XB_SPIN_CAP) { atomicAdd(&bar[XB_TMO], 1u); break; } }
    }
    nloc = mine > 0u ? mine : 1u; nx = cnt > 0u ? cnt : 1u;
}
__device__ __forceinline__ void xcd_barrier(const XcdBarrier& b) {
    asm volatile("s_waitcnt vmcnt(0)" ::: "memory");
    __syncthreads();
    if (threadIdx.x == 0) {
        unsigned* bar = b.bar;
        __builtin_amdgcn_s_waitcnt(0);
        unsigned nloc = b.st[0], nx = b.st[1];
        if (nloc == 0u) { xcd_barrier_complete(bar, b.x, nloc, nx); b.st[0] = nloc; b.st[1] = nx; }
        const unsigned old = xb_add(&bar[XB_XSUB(b.x)], 1u);
        const unsigned gen = old / nloc;
        if (old + 1u == (gen + 1u) * nloc) {
            __builtin_amdgcn_fence(__ATOMIC_RELEASE, "agent");
            asm volatile("s_waitcnt vmcnt(0)" ::: "memory");
            const unsigned og = xb_add(&bar[XB_TOP], 1u);
            const unsigned tg = og / nx;
            if (og + 1u == (tg + 1u) * nx) xb_add(&bar[XB_TOPGEN], 1u);
            else XB_SPIN(xb_ld(&bar[XB_TOPGEN]) == tg, bar);
            __builtin_amdgcn_fence(__ATOMIC_ACQUIRE, "agent");
            xb_add(&bar[XB_XGEN(b.x)], 1u);
            asm volatile("s_waitcnt vmcnt(0)" ::: "memory");
        } else {
            XB_SPIN(xb_ld(&bar[XB_XGEN(b.x)]) == gen, bar);
            __builtin_amdgcn_fence(__ATOMIC_ACQUIRE, "agent");
            asm volatile("s_waitcnt vmcnt(0)" ::: "memory");
        }
    }
    __syncthreads();
}

struct Frame {
    LAS unsigned char* lds;
    gu32* ctl;
    int tid, lane, wave, vcu, G;
    unsigned char* ws;
};
__device__ __forceinline__ float wave_sum(float v) {
#pragma unroll
    for (int o = 1; o < 64; o <<= 1) v += __shfl_xor(v, o);
    return v;
}

template <int MODE> __device__ __forceinline__ int dst_row(int n) {
    if (MODE == 1) {
        if (n < 1024) return n;
        if (n < 3072) { const int ch = (n - 1024) & 1023; return 1024 + (ch >> 7) * 256 + (n < 2048 ? 0 : 128) + (ch & 127); }
        if (n < 5120) { const int base = n < 4096 ? 3072 : 4096, r = n - base, h = r >> 6, d = r & 63; return base + 64 * h + 2 * (d & 31) + (d >> 5); }
        return n;
    }
    if (MODE == 2) return n < 1024 ? 2 * n : 2 * (n - 1024) + 1;
    if (MODE == 3) { const int ch = n & 1023; return (ch >> 7) * 256 + (n < 1024 ? 0 : 128) + (ch & 127); }
    return n;
}
template <int MODE> __device__ __forceinline__ void p0_transpose_item(const float* W, int K, int N, bf16* WT, const float* g, LAS float* scr, int item, int lane) {
    const int nblk = N / 32, kb = item / nblk, nb = item % nblk, k0 = 64 * kb, n0 = 32 * nb;
#pragma unroll 8
    for (int i = 0; i < 32; ++i) { const int kk = 2 * i + (lane >> 5); float v = W[(size_t)(k0 + kk) * N + n0 + (lane & 31)]; if (g) v *= g[k0 + kk]; scr[kk * 33 + (lane & 31)] = v; }
    LDS_WAIT(); asm volatile("" ::: "memory");
    const int c = lane & 7;
#pragma unroll
    for (int j = 0; j < 4; ++j) { const int n = (lane >> 3) + 8 * j; const LAS float* s = scr + (8 * c) * 33 + n;
        v4u o; o.x = cvt_pk_bf16(s[0 * 33], s[1 * 33]); o.y = cvt_pk_bf16(s[2 * 33], s[3 * 33]); o.z = cvt_pk_bf16(s[4 * 33], s[5 * 33]); o.w = cvt_pk_bf16(s[6 * 33], s[7 * 33]);
        *(GAS v4u*)(WT + (size_t)dst_row<MODE>(n0 + n) * K + k0 + 8 * c) = o; }
    LDS_WAIT(); asm volatile("" ::: "memory");
}

template <int MODE> __device__ __forceinline__ void p0_transpose_task(const float* W, int N, bf16* WT, const float* g, int task, int lane) {
    const int nblk = N / 64, kb = task / nblk, nb = task % nblk, kq = lane >> 4, n4 = lane & 15, k0 = 64 * kb + 16 * kq, n = 64 * nb + 4 * n4;
    const float* src = W + (size_t)k0 * N + n;
    f32x4 v[16];
#pragma unroll
    for (int i = 0; i < 16; ++i) v[i] = __builtin_nontemporal_load((const f32x4*)(src + (size_t)i * N));
    if (g) {
#pragma unroll
        for (int i = 0; i < 16; i += 4) { const f32x4 g4 = *(const f32x4*)(g + k0 + i); v[i] *= g4.x; v[i + 1] *= g4.y; v[i + 2] *= g4.z; v[i + 3] *= g4.w; }
    }
#pragma unroll
    for (int e = 0; e < 4; ++e) { bf16* dst = WT + (size_t)dst_row<MODE>(n + e) * 1024 + k0;
#pragma unroll
        for (int c = 0; c < 2; ++c) { v4u o; o.x = cvt_pk_bf16(v[8 * c][e], v[8 * c + 1][e]); o.y = cvt_pk_bf16(v[8 * c + 2][e], v[8 * c + 3][e]); o.z = cvt_pk_bf16(v[8 * c + 4][e], v[8 * c + 5][e]); o.w = cvt_pk_bf16(v[8 * c + 6][e], v[8 * c + 7][e]);
            *(GAS v4u*)(dst + 8 * c) = o; } }
}
template <int MODE> __device__ __forceinline__ void p0_transpose_task8(const float* W, int N, unsigned char* WT, const float* g, int task, int lane) {
    const int nblk = N / 64, kb = task / nblk, nb = task % nblk, kq = lane >> 4, n4 = lane & 15, k0 = 64 * kb + 16 * kq, n = 64 * nb + 4 * n4;
    const float* src = W + (size_t)k0 * N + n;
    f32x4 v[16];
#pragma unroll
    for (int i = 0; i < 16; ++i) v[i] = __builtin_nontemporal_load((const f32x4*)(src + (size_t)i * N));
#pragma unroll
    for (int i = 0; i < 16; i += 4) { f32x4 g4 = (f32x4){32.0f, 32.0f, 32.0f, 32.0f}; if (g) g4 = *(const f32x4*)(g + k0 + i) * 32.0f; v[i] *= g4.x; v[i + 1] *= g4.y; v[i + 2] *= g4.z; v[i + 3] *= g4.w; }
#pragma unroll
    for (int e = 0; e < 4; ++e) { unsigned char* dst = WT + (size_t)dst_row<MODE>(n + e) * 1024 + k0; v4u o;
#define PK8(j) ({ int w_ = 0; w_ = __builtin_amdgcn_cvt_pk_fp8_f32(v[4 * (j)][e], v[4 * (j) + 1][e], w_, false); w_ = __builtin_amdgcn_cvt_pk_fp8_f32(v[4 * (j) + 2][e], v[4 * (j) + 3][e], w_, true); (unsigned)w_; })
        o.x = PK8(0); o.y = PK8(1); o.z = PK8(2); o.w = PK8(3);
#undef PK8
        *(GAS v4u*)dst = o; }
}

using pg8::Unit; using pg8::bf16_t;
struct DensePol {
    static constexpr bool GATHER = false;
    const void* A; const void* Bt; int nM, nN, G, c; int esz  , split, off0, off1;
    __device__ __forceinline__ bool next(int i, Unit& u) const { u.e = 0; u.rt = 0; int j; if (!pg8::tile_order(i, G, c, nM, nN, u.pm, j)) return false; u.pn = j < split ? j + off0 : j + off1; return true; }
    __device__ __forceinline__ const char* a_base(const Unit& u) const { return (const char*)A + (size_t)u.pm * 256 * 1024 * esz; }
    __device__ __forceinline__ const char* b_base(const Unit& u) const { return (const char*)Bt + (size_t)u.pn * 256 * 1024 * esz; }
    __device__ __forceinline__ int gather(const Unit&, int) const { return 0; }
};
struct MoePol1 {
    static constexpr bool GATHER = true;
    const void* A; const void* Bt; const int* etok; const LAS int* tab; const LAS int* ul; int nul;
    __device__ __forceinline__ bool next(int i, Unit& u) const { if (i >= nul) return false; const LAS int* p = ul + 4 * i; u.pm = p[0]; u.pn = p[1]; u.e = p[2]; u.rt = p[3]; return true; }
    __device__ __forceinline__ const char* a_base(const Unit&) const { return (const char*)A; }
    __device__ __forceinline__ const char* b_base(const Unit& u) const { return (const char*)Bt + ((size_t)u.e * 2048 + (size_t)u.pn * 256) * 1024; }
    __device__ __forceinline__ int gather(const Unit& u, int r) const { const int pos = u.rt * 256 + r; return pos < tab[u.e] ? etok[u.e * 32768 + pos] : 0; }
};
struct MoePol2 {
    static constexpr bool GATHER = false;
    const void* A; const void* Bt; const LAS int* ul; int nul;
    __device__ __forceinline__ bool next(int i, Unit& u) const { const int k = i; if (k >= nul) return false; const LAS int* p = ul + 4 * k; u.pm = p[0]; u.pn = p[1]; u.e = p[2]; u.rt = p[3]; return true; }
    __device__ __forceinline__ const char* a_base(const Unit& u) const { return (const char*)A + (size_t)u.pm * 256 * 1024; }
    __device__ __forceinline__ const char* b_base(const Unit& u) const { return (const char*)Bt + ((size_t)u.e * 1024 + (size_t)u.pn * 256) * 1024; }
    __device__ __forceinline__ int gather(const Unit&, int) const { return 0; }
};

__device__ __forceinline__ int moe_unit_list(LAS int* ul, const LAS int* tab, int ncol, int G, int c, int tid) {
    const int T = tab[65], nun = T * ncol; const int nul = (c < nun) ? (nun - 1 - c) / G + 1 : 0;
    if (tid < nul && tid < 64) { int g, pn; pg8::tile_order(tid, G, c, T, ncol, g, pn); int e = 0;
        for (int k = 1; k < 32; ++k) e += (tab[32 + k] <= g) ? 1 : 0;
        ul[4 * tid + 0] = g; ul[4 * tid + 1] = pn; ul[4 * tid + 2] = e; ul[4 * tid + 3] = g - tab[32 + e]; }
    return nul < 64 ? nul : 64;
}

typedef pg8::f32x4 (AccT)[2][2][4][2];
__device__ __forceinline__ float sigmoidf_(float x) { return __builtin_amdgcn_rcpf(1.0f + __builtin_amdgcn_exp2f(x * -1.4426950408889634f)); }

__device__ __forceinline__ size_t hm_idx(int row, int col) { return ((size_t)((row >> 14) * 16 + (col >> 6)) * SEQ + (size_t)(row & (SEQ - 1))) * 64 + (col & 63); }
struct EpiInProj {
    static constexpr bool PERM = true;
    bf16_t *CB, *U, *Q, *Kb, *V, *GC, *GA; const float* cosT; const float* sinT; float* ksum; float asc;
    __device__ __forceinline__ void operator()(const AccT& acc, const Unit& u, int wr, int wc, int fr, int fq) const {
        using pg8::u32x4; using pg8::u32x2; using pg8::f32x4;
        const int pn = u.pn, row0_ = u.pm * 256 + wr * 64 + fr, cl = wc * 32 + 8 * fq;
        int row0 = row0_;
        if (pn < 4 || (pn >= 20 && pn < 24)) {
            asm volatile("" : "+v"(row0));
            bf16_t* base = (pn < 4) ? CB : V; const int col0 = (pn & 3) * 256 + cl;
#pragma unroll
            for (int ai = 0; ai < 2; ++ai)
#pragma unroll
                for (int m = 0; m < 4; ++m) { const int row = row0 + ai * 128 + m * 16;
#pragma unroll
                    for (int bj = 0; bj < 2; ++bj) { const f32x4 v0 = acc[ai][bj][m][0] * asc, v1 = acc[ai][bj][m][1] * asc; u32x4 w;
                        w.x = cvt_pk_bf16(v0[0], v0[1]); w.y = cvt_pk_bf16(v0[2], v0[3]); w.z = cvt_pk_bf16(v1[0], v1[1]); w.w = cvt_pk_bf16(v1[2], v1[3]);
                        bf16_t* dst = (pn < 4) ? base + (size_t)row * 1024 + col0 + bj * 128 : base + hm_idx(row, col0 + bj * 128);
                        *(u32x4*)dst = w; } }
        } else if (pn >= 24) {
            asm volatile("" : "+v"(row0));
            bf16_t* base = (pn < 28) ? GC : GA; const int col0 = (pn & 3) * 256 + cl;
#pragma unroll
            for (int ai = 0; ai < 2; ++ai)
#pragma unroll
                for (int m = 0; m < 4; ++m) { bf16_t* rowp = base + (size_t)(row0 + ai * 128 + m * 16) * 1024 + col0;
#pragma unroll
                    for (int bj = 0; bj < 2; ++bj) { const f32x4 v0 = acc[ai][bj][m][0] * asc, v1 = acc[ai][bj][m][1] * asc; u32x4 w;
                        w.x = cvt_pk_bf16(sigmoidf_(v0[0]), sigmoidf_(v0[1])); w.y = cvt_pk_bf16(sigmoidf_(v0[2]), sigmoidf_(v0[3]));
                        w.z = cvt_pk_bf16(sigmoidf_(v1[0]), sigmoidf_(v1[1])); w.w = cvt_pk_bf16(sigmoidf_(v1[2]), sigmoidf_(v1[3]));
                        *(u32x4*)(rowp + bj * 128) = w; } }
        } else if (pn < 12) {
            asm volatile("" : "+v"(row0));
            const int ch0 = (pn - 4) * 128 + cl;
#pragma unroll
            for (int ai = 0; ai < 2; ++ai)
#pragma unroll
                for (int m = 0; m < 4; ++m) { bf16_t* rowp = U + (size_t)(row0 + ai * 128 + m * 16) * 1024 + ch0;
                    const f32x4 a0 = acc[ai][0][m][0], a1 = acc[ai][0][m][1], b0 = acc[ai][1][m][0], b1 = acc[ai][1][m][1]; u32x4 w;
                    w.x = cvt_pk_bf16(a0[0] * b0[0], a0[1] * b0[1]); w.y = cvt_pk_bf16(a0[2] * b0[2], a0[3] * b0[3]); w.z = cvt_pk_bf16(a1[0] * b1[0], a1[1] * b1[1]); w.w = cvt_pk_bf16(a1[2] * b1[2], a1[3] * b1[3]);
                    *(u32x4*)rowp = w; }
        } else {
            asm volatile("" : "+v"(row0));
            const bool isq = pn < 16; bf16_t* base = isq ? Q : Kb; const int col0 = (pn & 3) * 256 + cl; const float sc = (isq ? C2 : 1.0f) * asc;
            const int i0 = 16 * (wc & 1) + 4 * fq;
            float ks[2][8];
#pragma unroll
            for (int bj = 0; bj < 2; ++bj)
#pragma unroll
                for (int e = 0; e < 8; ++e) ks[bj][e] = 0.f;
#pragma unroll
            for (int ai = 0; ai < 2; ++ai) {
                f32x4 csv[4], snv[4];
#pragma unroll
                for (int m = 0; m < 4; ++m) { const int pos = (row0 + ai * 128 + m * 16) & (SEQ - 1); csv[m] = *(const f32x4*)(cosT + pos * 32 + i0); snv[m] = *(const f32x4*)(sinT + pos * 32 + i0); }
                asm volatile("" ::: "memory");
#pragma unroll
                for (int m = 0; m < 4; ++m)
#pragma unroll
                    for (int bj = 0; bj < 2; ++bj) { const int row = row0 + ai * 128 + m * 16;
                        const f32x4 cs = csv[m], sn = snv[m];
                        bf16_t* rowp = base + hm_idx(row, col0 + bj * 128);
                        const f32x4 v0 = acc[ai][bj][m][0], v1 = acc[ai][bj][m][1]; float o[8];
                        o[0] = (v0[0] * cs[0] - v0[1] * sn[0]) * sc; o[1] = (v0[1] * cs[0] + v0[0] * sn[0]) * sc;
                        o[2] = (v0[2] * cs[1] - v0[3] * sn[1]) * sc; o[3] = (v0[3] * cs[1] + v0[2] * sn[1]) * sc;
                        o[4] = (v1[0] * cs[2] - v1[1] * sn[2]) * sc; o[5] = (v1[1] * cs[2] + v1[0] * sn[2]) * sc;
                        o[6] = (v1[2] * cs[3] - v1[3] * sn[3]) * sc; o[7] = (v1[3] * cs[3] + v1[2] * sn[3]) * sc;
#pragma unroll
                        for (int e = 0; e < 8; ++e) { ks[bj][e] += o[e]; asm volatile("" : "+v"(ks[bj][e])); }
                        u32x4 w; w.x = cvt_pk_bf16(o[0], o[1]); w.y = cvt_pk_bf16(o[2], o[3]); w.z = cvt_pk_bf16(o[4], o[5]); w.w = cvt_pk_bf16(o[6], o[7]);
                        *(u32x4*)(rowp) = w; }
                asm volatile("" ::: "memory");
            }
            if (!isq) {
#pragma unroll
                for (int bj = 0; bj < 2; ++bj)
#pragma unroll
                    for (int e = 0; e < 8; ++e) { float s = ks[bj][e]; s += __shfl_xor(s, 1); s += __shfl_xor(s, 2); s += __shfl_xor(s, 4); s += __shfl_xor(s, 8);
                        if (fr == 0) atomicAdd(ksum + (size_t)u.pm * 1024 + col0 + bj * 128 + e, s); }
            }
        }
    }
};
template <int MODE> struct EpiGate {
    static constexpr bool PERM = true;
    const bf16_t* G; const bf16_t* T1in; bf16_t* O; float asc;
    __device__ __forceinline__ void operator()(const AccT& acc, const Unit& u, int wr, int wc, int fr, int fq) const {
        using pg8::u32x4; using pg8::f32x4;
        asm volatile("" : "+v"(fr), "+v"(fq));
        const int row0 = u.pm * 256 + wr * 64 + fr, col0 = u.pn * 256 + wc * 32 + 8 * fq;
#pragma unroll
        for (int ai = 0; ai < 2; ++ai) {
            u32x4 gg[4][2], tt[4][2];
#pragma unroll
            for (int m = 0; m < 4; ++m)
#pragma unroll
                for (int bj = 0; bj < 2; ++bj) { const size_t off = (size_t)(row0 + ai * 128 + m * 16) * 1024 + col0 + bj * 128;
                    gg[m][bj] = *(const u32x4*)(G + off); if (MODE == 1) tt[m][bj] = *(const u32x4*)(T1in + off); }
            asm volatile("" ::: "memory");
#pragma unroll
            for (int m = 0; m < 4; ++m)
#pragma unroll
                for (int bj = 0; bj < 2; ++bj) { const size_t off = (size_t)(row0 + ai * 128 + m * 16) * 1024 + col0 + bj * 128;
                    const f32x4 v0 = acc[ai][bj][m][0] * asc, v1 = acc[ai][bj][m][1] * asc; const u32x4 g = gg[m][bj]; float o[8];
                    o[0] = bf_lo(g.x) * v0[0]; o[1] = bf_hi(g.x) * v0[1]; o[2] = bf_lo(g.y) * v0[2]; o[3] = bf_hi(g.y) * v0[3];
                    o[4] = bf_lo(g.z) * v1[0]; o[5] = bf_hi(g.z) * v1[1]; o[6] = bf_lo(g.w) * v1[2]; o[7] = bf_hi(g.w) * v1[3];
                    if (MODE == 1) { const u32x4 t = tt[m][bj];
                        o[0] += bf_lo(t.x); o[1] += bf_hi(t.x); o[2] += bf_lo(t.y); o[3] += bf_hi(t.y); o[4] += bf_lo(t.z); o[5] += bf_hi(t.z); o[6] += bf_lo(t.w); o[7] += bf_hi(t.w); }
                    u32x4 w; w.x = cvt_pk_bf16(o[0], o[1]); w.y = cvt_pk_bf16(o[2], o[3]); w.z = cvt_pk_bf16(o[4], o[5]); w.w = cvt_pk_bf16(o[6], o[7]);
                    *(u32x4*)(O + off) = w; }
            asm volatile("" ::: "memory");
        }
    }
};
struct EpiResid {
    static constexpr bool PERM = false;
    const float* X; float* H;
    __device__ __forceinline__ void operator()(const AccT& acc, const Unit& u, int wr, int wc, int fr, int fq) const {
        using pg8::f32x4;
        asm volatile("" : "+v"(fr), "+v"(fq));
        const int row0 = u.pm * 256 + wr * 64 + fr, col0 = u.pn * 256 + wc * 32 + 4 * fq;
#pragma unroll
        for (int ai = 0; ai < 2; ++ai) {
            f32x4 xv[4][2][2];
#pragma unroll
            for (int m = 0; m < 4; ++m)
#pragma unroll
                for (int bj = 0; bj < 2; ++bj)
#pragma unroll
                    for (int n = 0; n < 2; ++n) xv[m][bj][n] = *(const f32x4*)(X + (size_t)(row0 + ai * 128 + m * 16) * 1024 + col0 + bj * 128 + n * 16);
            asm volatile("" ::: "memory");
#pragma unroll
            for (int m = 0; m < 4; ++m)
#pragma unroll
                for (int bj = 0; bj < 2; ++bj)
#pragma unroll
                    for (int n = 0; n < 2; ++n) *(f32x4*)(H + (size_t)(row0 + ai * 128 + m * 16) * 1024 + col0 + bj * 128 + n * 16) = xv[m][bj][n] + acc[ai][bj][m][n];
            asm volatile("" ::: "memory");
        }
    }
};
struct EpiSwiglu {
    static constexpr bool PERM = true;
    const float* bgu; const float* erstd; unsigned char* ACT;
    __device__ __forceinline__ float act1(float g, float up) const { g = fminf(g, 7.0f); up = fminf(fmaxf(up, -7.0f), 7.0f); return (up + 1.0f) * (g * sigmoidf_(1.702f * g)); }
    __device__ __forceinline__ void operator()(const AccT& acc, const Unit& u, int wr, int wc, int fr, int fq) const {
        using pg8::u32x2; using pg8::f32x4;
        asm volatile("" : "+v"(fr), "+v"(fq));
        const int row0 = u.pm * 256 + wr * 64 + fr, ch0 = u.pn * 128 + wc * 32 + 8 * fq;
        const float* bg = bgu + (size_t)u.e * 2048; const float* rsp = erstd + (size_t)u.e * 32768 + u.rt * 256 + wr * 64 + fr;
        f32x4 bgv[2], buv[2];
#pragma unroll
        for (int n = 0; n < 2; ++n) { bgv[n] = *(const f32x4*)(bg + ch0 + 4 * n); buv[n] = *(const f32x4*)(bg + 1024 + ch0 + 4 * n); }
        float rss[2][4];
#pragma unroll
        for (int ai = 0; ai < 2; ++ai)
#pragma unroll
            for (int m = 0; m < 4; ++m) rss[ai][m] = rsp[ai * 128 + m * 16];
        asm volatile("" ::: "memory");
#pragma unroll
        for (int ai = 0; ai < 2; ++ai)
#pragma unroll
            for (int m = 0; m < 4; ++m) { unsigned char* rowp = ACT + (size_t)(row0 + ai * 128 + m * 16) * 1024 + ch0; const float rs = rss[ai][m] * (1.0f / 32.0f);
                float a8[8];
#pragma unroll
                for (int n = 0; n < 2; ++n) { const f32x4 g4 = acc[ai][0][m][n] * rs + bgv[n], u4 = acc[ai][1][m][n] * rs + buv[n];
                    a8[4 * n + 0] = act1(g4[0], u4[0]); a8[4 * n + 1] = act1(g4[1], u4[1]); a8[4 * n + 2] = act1(g4[2], u4[2]); a8[4 * n + 3] = act1(g4[3], u4[3]); }
                int w0 = 0, w1 = 0;
                w0 = __builtin_amdgcn_cvt_pk_fp8_f32(a8[0], a8[1], w0, false); w0 = __builtin_amdgcn_cvt_pk_fp8_f32(a8[2], a8[3], w0, true);
                w1 = __builtin_amdgcn_cvt_pk_fp8_f32(a8[4], a8[5], w1, false); w1 = __builtin_amdgcn_cvt_pk_fp8_f32(a8[6], a8[7], w1, true);
                u32x2 w; w.x = (unsigned)w0; w.y = (unsigned)w1; *(u32x2*)rowp = w; }
    }
};
struct EpiDown {
    static constexpr bool PERM = true;
    const float* bd; const float* ewt; unsigned char* Y;
    __device__ __forceinline__ void operator()(const AccT& acc, const Unit& u, int wr, int wc, int fr, int fq) const {
        using pg8::u32x4; using pg8::f32x4;
        asm volatile("" : "+v"(fr), "+v"(fq));
        const int rl0 = wr * 64 + fr, col0 = u.pn * 256 + wc * 32 + 8 * fq;
        const float* b = bd + (size_t)u.e * 1024 + col0; const float* wp = ewt + (size_t)u.e * 32768 + u.rt * 256 + rl0;
        f32x4 bv[2][2]; float wts[2][4];
#pragma unroll
        for (int bj = 0; bj < 2; ++bj)
#pragma unroll
            for (int n = 0; n < 2; ++n) bv[bj][n] = *(const f32x4*)(b + bj * 128 + 4 * n);
#pragma unroll
        for (int ai = 0; ai < 2; ++ai)
#pragma unroll
            for (int m = 0; m < 4; ++m) wts[ai][m] = wp[ai * 128 + m * 16];
        asm volatile("" ::: "memory");
#pragma unroll
        for (int ai = 0; ai < 2; ++ai)
#pragma unroll
            for (int m = 0; m < 4; ++m) { const int rl = rl0 + ai * 128 + m * 16; const float wt = wts[ai][m] * 16.0f; unsigned char* rowp = Y + (size_t)(u.pm * 256 + rl) * 1024 + col0;
#pragma unroll
                for (int bj = 0; bj < 2; ++bj) { const f32x4 v0 = (acc[ai][bj][m][0] * (1.0f / 32.0f) + bv[bj][0]) * wt, v1 = (acc[ai][bj][m][1] * (1.0f / 32.0f) + bv[bj][1]) * wt;
                    int w0 = 0, w1 = 0; w0 = __builtin_amdgcn_cvt_pk_fp8_f32(v0[0], v0[1], w0, false); w0 = __builtin_amdgcn_cvt_pk_fp8_f32(v0[2], v0[3], w0, true);
                    w1 = __builtin_amdgcn_cvt_pk_fp8_f32(v1[0], v1[1], w1, false); w1 = __builtin_amdgcn_cvt_pk_fp8_f32(v1[2], v1[3], w1, true);
                    pg8::u32x2 w; w.x = (unsigned)w0; w.y = (unsigned)w1; *(pg8::u32x2*)(rowp + bj * 128) = w; } }
    }
};

typedef short bf16x8_t __attribute__((ext_vector_type(8)));
typedef short s16x4_t __attribute__((ext_vector_type(4)));
typedef short v4i16_t __attribute__((ext_vector_type(4)));
__device__ __forceinline__ int crow(int r, int hi) { return (r & 3) + 8 * (r >> 2) + 4 * hi; }
__device__ __forceinline__ s16x4_t vtr(const LAS unsigned char* p) { return __builtin_bit_cast(s16x4_t, __builtin_amdgcn_ds_read_tr16_b64_v4i16((LAS v4i16_t*)p)); }
constexpr int ATT_K = 0, ATT_V = 32768, ATT_Q = 65536, ATT_STG = 98304;
constexpr int UMETA_OFF = LDSCTL_OFF + 1024, WSC_OFF = LDSCTL_OFF + 2048;
constexpr int ALIST_BH = 256 * 2016;
__device__ __forceinline__ int alist_off(int j) { return 256 * (63 * j - (j * (j - 1)) / 2); }
__device__ __forceinline__ void glds16(const void* gsrc, unsigned lds_dst) { unsigned keep;
    asm volatile("s_mov_b32 %0, m0\n\ts_mov_b32 m0, %2\n\ts_nop 0\n\tglobal_load_lds_dwordx4 %1, off\n\ts_mov_b32 m0, %0" : "=&s"(keep) : "v"(gsrc), "s"(lds_dst) : "memory"); }
__device__ __forceinline__ void glds16_nt(const void* gsrc, unsigned lds_dst) { unsigned keep;
    asm volatile("s_mov_b32 %0, m0\n\ts_mov_b32 m0, %2\n\ts_nop 0\n\tglobal_load_lds_dwordx4 %1, off nt\n\ts_mov_b32 m0, %0" : "=&s"(keep) : "v"(gsrc), "s"(lds_dst) : "memory"); }
#define ATT_RFL(x) ((unsigned)__builtin_amdgcn_readfirstlane((int)(x)))
__device__ __forceinline__ void attn_dma_k(unsigned ldsb, const bf16* Kb, size_t rowbase, int h, int wave, int lane) {
#pragma unroll
    for (int i = 0; i < 4; ++i) glds16(Kb + (rowbase + (size_t)(i * 64 + lane)) * 64 + wave * 8, ATT_RFL(ldsb + ATT_K + wave * 4096 + i * 1024));
}
__device__ __forceinline__ void attn_dma_v(unsigned ldsb, const bf16* Vb, size_t rowbase, int h, int wave, int lane) {
#pragma unroll
    for (int i = 0; i < 4; ++i) { const int vi = wave * 4 + i, dh = vi >> 4, kg = vi & 15;
        glds16(Vb + (rowbase + (size_t)(kg * 16 + (lane >> 2))) * 64 + dh * 32 + (lane & 3) * 8, ATT_RFL(ldsb + ATT_V + dh * 16384 + kg * 1024)); }
}
__device__ __forceinline__ void attn_dma_q(unsigned ldsb, const bf16* qrowp, int wave, int lane) {
#pragma unroll
    for (int i = 0; i < 4; ++i) glds16(qrowp + (2 * i + (lane >> 5)) * 8, ATT_RFL(ldsb + ATT_Q + wave * 4096 + i * 1024));
}
__device__ __forceinline__ float max3f(float a, float b, float c) { float r; asm("v_max3_f32 %0, %1, %2, %3" : "=v"(r) : "v"(a), "v"(b), "v"(c)); return r; }
__device__ __forceinline__ float max2f(float a, float b) { float r; asm("v_max_f32_e32 %0, %1, %2" : "=v"(r) : "v"(a), "v"(b)); return r; }
__device__ __forceinline__ float fsub_s(float a, float b) { float r; asm("v_sub_f32_e32 %0, %1, %2" : "=v"(r) : "v"(a), "v"(b)); return r; }
__device__ __forceinline__ float rowmax32(const f32x16& p0, const f32x16& p1) {
    float a = max3f(p0[0], p0[1], p1[0]), b = max3f(p0[2], p0[3], p1[1]); a = max3f(a, p1[2], p1[3]);
#pragma unroll
    for (int r = 4; r < 16; r += 4) { a = max3f(a, p0[r], p0[r + 1]); b = max3f(b, p0[r + 2], p0[r + 3]); a = max3f(a, p1[r], p1[r + 1]); b = max3f(b, p1[r + 2], p1[r + 3]); }
    const float m = max2f(a, b);
    auto rr = __builtin_amdgcn_permlane32_swap(__float_as_uint(m), __float_as_uint(m), false, false);
    return max2f(__uint_as_float(rr[0]), __uint_as_float(rr[1]));
}
__device__ __forceinline__ void cmask(f32x16& p0, f32x16& p1, int jb, int qrel, int hi) {
    const int kb = 64 * jb + 4 * hi;
#pragma unroll
    for (int r = 0; r < 16; ++r) { const int kv = kb + (r & 3) + 8 * (r >> 2); p0[r] = (kv > qrel) ? -INFINITY : p0[r]; p1[r] = (kv + 32 > qrel) ? -INFINITY : p1[r]; }
}

constexpr int SIDE_GU = 32 * 64 * 32, SIDE_D = 32 * 64 * 16, SIDE_TASKS = SIDE_GU + SIDE_D;
__device__ __forceinline__ void side_issue(int task, const float* w_gu, const float* w_d, int lane, float (&sv)[16]) {
    const float* src; int N;
    if (task < SIDE_GU) { const int e = task >> 11, r = task & 2047, kb = r >> 5, nb = r & 31; N = 2048; src = w_gu + (size_t)e * 1024 * 2048 + (size_t)(kb * 16) * 2048 + nb * 64 + lane; }
    else { const int t2 = task - SIDE_GU, e = t2 >> 10, r = t2 & 1023, kb = r >> 4, nb = r & 15; N = 1024; src = w_d + (size_t)e * 1024 * 1024 + (size_t)(kb * 16) * 1024 + nb * 64 + lane; }
#pragma unroll
    for (int i = 0; i < 16; ++i) sv[i] = __builtin_nontemporal_load(src + (size_t)i * N);
}
__device__ __forceinline__ void side_finish(int task, unsigned char* Wgu8, unsigned char* Wd8, int lane, const float (&sv)[16]) {
    unsigned char* dst;
    if (task < SIDE_GU) { const int e = task >> 11, r = task & 2047, kb = r >> 5, nb = r & 31, n = nb * 64 + lane; dst = Wgu8 + ((size_t)e * 2048 + dst_row<3>(n)) * 1024 + kb * 16; }
    else { const int t2 = task - SIDE_GU, e = t2 >> 10, r = t2 & 1023, kb = r >> 4, nb = r & 15, n = nb * 64 + lane; dst = Wd8 + ((size_t)e * 1024 + n) * 1024 + kb * 16; }
    v4u o;
#define PK8(j) ({ int w_ = 0; w_ = __builtin_amdgcn_cvt_pk_fp8_f32(sv[4 * (j)] * 32.0f, sv[4 * (j) + 1] * 32.0f, w_, false); w_ = __builtin_amdgcn_cvt_pk_fp8_f32(sv[4 * (j) + 2] * 32.0f, sv[4 * (j) + 3] * 32.0f, w_, true); (unsigned)w_; })
    o.x = PK8(0); o.y = PK8(1); o.z = PK8(2); o.w = PK8(3);
#undef PK8
    *(GAS v4u*)dst = o;
}

__device__ __forceinline__ void side_dma(int task, const float* w_gu, const float* w_d, int lane, unsigned stg_lds) {
    const float* src; int N;
    if (task < SIDE_GU) { const int e = task >> 11, r = task & 2047, kb = r >> 5, nb = r & 31; N = 2048; src = w_gu + (size_t)e * 1024 * 2048 + (size_t)(kb * 16) * 2048 + nb * 64; }
    else { const int t2 = task - SIDE_GU, e = t2 >> 10, r = t2 & 1023, kb = r >> 4, nb = r & 15; N = 1024; src = w_d + (size_t)e * 1024 * 1024 + (size_t)(kb * 16) * 1024 + nb * 64; }
    const float* ls = src + (size_t)(lane >> 3) * N + (lane & 7) * 4;
#pragma unroll
    for (int p = 0; p < 4; ++p) glds16_nt(ls + (size_t)((p >> 1) * 8) * N + (p & 1) * 32, ATT_RFL(stg_lds + p * 1024));
}
__device__ __forceinline__ void side_consume(int task, bool real, unsigned char* dummy, unsigned char* Wgu8, unsigned char* Wd8, int lane, const LAS unsigned char* stg) {
    const LAS float* lp = (const LAS float*)(stg + (lane >> 5) * 1024 + (lane & 31) * 4);
    float sv[16];
#pragma unroll
    for (int k = 0; k < 16; ++k) sv[k] = lp[(k >> 3) * 512 + (k & 7) * 32];
    unsigned char* dst;
    if (task < SIDE_GU) { const int e = task >> 11, r = task & 2047, kb = r >> 5, nb = r & 31, n = nb * 64 + lane; dst = Wgu8 + ((size_t)e * 2048 + dst_row<3>(n)) * 1024 + kb * 16; }
    else { const int t2 = task - SIDE_GU, e = t2 >> 10, r = t2 & 1023, kb = r >> 4, nb = r & 15, n = nb * 64 + lane; dst = Wd8 + ((size_t)e * 1024 + n) * 1024 + kb * 16; }
    v4u o;
#define PK8(j) ({ int w_ = 0; w_ = __builtin_amdgcn_cvt_pk_fp8_f32(sv[4 * (j)] * 32.0f, sv[4 * (j) + 1] * 32.0f, w_, false); w_ = __builtin_amdgcn_cvt_pk_fp8_f32(sv[4 * (j) + 2] * 32.0f, sv[4 * (j) + 3] * 32.0f, w_, true); (unsigned)w_; })
    o.x = PK8(0); o.y = PK8(1); o.z = PK8(2); o.w = PK8(3);
#undef PK8
    if (!real) dst = dummy + lane * 16;
    *(GAS v4u*)dst = o;
}

#define ATT_WB(wait) asm volatile("s_waitcnt " wait "\n\ts_barrier" ::: "memory")
template <bool OWN>
__device__ __forceinline__ void attn_phase(Frame& F, const bf16* Qb, const bf16* Kb, const bf16* Vb, bf16* PO, float* PML, const unsigned short* alist, gu32* acnt, bf16* ATTO,
                                           const float* w_gu, const float* w_d, unsigned char* Wgu8, unsigned char* Wd8) {
    const int r32 = F.lane & 31, hi = F.lane >> 5, wave = F.wave;
    LAS int* um = (LAS int*)(F.lds + UMETA_OFF);
    LAS float* wsc = (LAS float*)(F.lds + WSC_OFF + wave * 1024);
    const unsigned ldsb = (unsigned)(unsigned long)F.lds;
    const LAS unsigned char* kp0 = F.lds + ATT_K + hi * 4096 + r32 * 16;
    const LAS unsigned char* vp0 = F.lds + ATT_V + ((F.lane >> 4) & 1) * 32 + (F.lane & 3) * 8 + (4 * hi + ((F.lane & 15) >> 2)) * 64;
    int nul = 0;
    int st_tail = __builtin_amdgcn_readfirstlane(F.vcu * 8 + wave);
    __syncthreads();
    if (!OWN) {
        LAS int* pfx = (LAS int*)(F.lds + ATT_STG);
        int c4[4]; int sum = 0;
#pragma unroll
        for (int i = 0; i < 4; ++i) { c4[i] = ((int)__hip_atomic_load(acnt + F.tid * 4 + i, RLX_AGENT) + 255) >> 8; sum += c4[i]; }
        int inc = sum;
#pragma unroll
        for (int o = 1; o < 64; o <<= 1) { const int v = __shfl_up(inc, o); if (F.lane >= o) inc += v; }
        LAS int* wt = pfx + 2064;
        if (F.lane == 63) wt[wave] = inc;
        __syncthreads();
        int base = 0;
        for (int w = 0; w < wave; ++w) base += wt[w];
        int ex = base + inc - sum;
#pragma unroll
        for (int i = 0; i < 4; ++i) { pfx[F.tid * 4 + i] = ex; ex += c4[i]; }
        if (F.tid == 511) pfx[2048] = ex;
        __syncthreads();
        const int NU = pfx[2048];
        const int u0 = (int)(((long)blockIdx.x * NU) / F.G), u1 = (int)(((long)(blockIdx.x + 1) * NU) / F.G);
        nul = u1 - u0; if (nul > 64) nul = 64;
        if (F.tid < nul) { const int u = u0 + F.tid; int lo_ = 0, hi_ = 2048;
            while (hi_ - lo_ > 1) { const int mid = (lo_ + hi_) >> 1; if (pfx[mid] <= u) lo_ = mid; else hi_ = mid; }
            const int chunk = u - pfx[lo_], cnt = (int)__hip_atomic_load(acnt + lo_, RLX_AGENT), rem = cnt - chunk * 256;
            um[F.tid * 4 + 0] = lo_; um[F.tid * 4 + 1] = chunk; um[F.tid * 4 + 2] = rem < 256 ? rem : 256; }
    } else {
        nul = ((int)blockIdx.x < 2048) ? (2047 - (int)blockIdx.x) / F.G + 1 : 0; if (nul > 64) nul = 64;
        if (F.tid < nul) { const int u = (int)blockIdx.x + F.tid * F.G; um[F.tid * 4 + 0] = u; um[F.tid * 4 + 1] = 0; um[F.tid * 4 + 2] = 256; }
    }
    __syncthreads();
    if (nul > 0) {
#define ATT_ENT(k) (OWN ? (unsigned)((((um[(k) * 4] & 63) * 256 + wave * 32 + r32) << 2) | 3) \
                        : (unsigned)alist[(size_t)(um[(k) * 4] >> 6) * ALIST_BH + alist_off(um[(k) * 4] & 63) + um[(k) * 4 + 1] * 256 + wave * 32 + r32])
#define ATT_ROWBASE(k) ((size_t)(um[(k) * 4] >> 6) * SEQ + (size_t)(um[(k) * 4] & 63) * 256)
#define ATT_H(k) ((um[(k) * 4] >> 6) & 15)
#define ATT_B(k) (um[(k) * 4] >> 10)
#define A2_SBAR() __builtin_amdgcn_sched_barrier(0)
#define A2_MFMA(a, b, c) __builtin_amdgcn_mfma_f32_32x32x16_bf16(a, b, c, 0, 0, 0)
#define A2_PKW(P, B) cvt_pk_bf16(P[B], P[(B) + 1])
#define A2_PAF(k) __builtin_bit_cast(bf16x8_t, pw##k)
#define A2_VFR(i) (bf16x8_t){vlo[i][0], vlo[i][1], vlo[i][2], vlo[i][3], vhi[i][0], vhi[i][1], vhi[i][2], vhi[i][3]}
#define A2_PIN(x) asm volatile("" : "+v"(x))
#define A2_MX3(a, b, c) __builtin_fmaxf(__builtin_fmaxf((a), (b)), (c))
#define A2_EX(v) __builtin_amdgcn_exp2f(v)
#define A2_GAPA(MF, A0, A1, A2, A3, W0, W1, PW) do { MF; sacc += A0; sacc += A1; sacc += A2; sacc += A3; A2_PIN(sacc); W0; W1; A2_PIN(PW); A2_SBAR(); } while (0)
#define A2_GAPB(MF, X, B) do { MF; X[B] = A2_EX(X[B]); X[(B) + 1] = A2_EX(X[(B) + 1]); X[(B) + 2] = A2_EX(X[(B) + 2]); X[(B) + 3] = A2_EX(X[(B) + 3]); A2_PIN(X); A2_SBAR(); } while (0)
#define A2_VRD(i) do { vlo[i] = vtr(vp_ + (((i) >> 2) * 16384 + ((i) & 3) * 1024)); vhi[i] = vtr(vp_ + (((i) >> 2) * 16384 + ((i) & 3) * 1024 + 512)); } while (0)
#define A2_KRD(G, j) do { if (G) { kf[2 * (j)] = *(const LAS bf16x8_t*)(kn_ + (j) * 8192); kf[2 * (j) + 1] = *(const LAS bf16x8_t*)(kn_ + (j) * 8192 + 512); A2_SBAR(); } } while (0)
#define A2_RESC() do { if (resc) { LDS_WAIT(); _Pragma("unroll") for (int d_ = 0; d_ < 2; ++d_) _Pragma("unroll") for (int r = 0; r < 16; ++r) o[d_][r] *= wsc[crow(r, hi)]; } } while (0)
#define A2_STEP(C0, C1, P0, P1, t, GL) do { A2_SBAR(); \
    const LAS unsigned char* vp_ = vp0 + ((t) - 1) * 4096; const LAS unsigned char* kn_ = kp0 + ((t) + 1) * 1024; (void)kn_; \
    A2_VRD(0); A2_SBAR(); float sacc = (P0[0] + P0[1]); \
    A2_GAPA(C0 = A2_MFMA(kf[0], qr[0], negm), P0[2], P0[3], P0[4], P0[5],     pw0[0] = A2_PKW(P0, 0), pw0[1] = A2_PKW(P0, 2), pw0); \
    A2_VRD(4); A2_SBAR(); A2_GAPA(C1 = A2_MFMA(kf[1], qr[0], negm), P0[6], P0[7], P0[8], P0[9],     pw0[2] = A2_PKW(P0, 4), pw0[3] = A2_PKW(P0, 6), pw0); \
    A2_VRD(1); A2_SBAR(); A2_GAPA(C0 = A2_MFMA(kf[2], qr[1], C0),   P0[10], P0[11], P0[12], P0[13], pw1[0] = A2_PKW(P0, 8), pw1[1] = A2_PKW(P0, 10), pw1); \
    A2_VRD(5); A2_SBAR(); A2_GAPA(C1 = A2_MFMA(kf[3], qr[1], C1),   P0[14], P0[15], P1[0], P1[1],   pw1[2] = A2_PKW(P0, 12), pw1[3] = A2_PKW(P0, 14), pw1); \
    A2_VRD(2); A2_SBAR(); A2_GAPA(C0 = A2_MFMA(kf[4], qr[2], C0),   P1[2], P1[3], P1[4], P1[5],     pw2[0] = A2_PKW(P1, 0), pw2[1] = A2_PKW(P1, 2), pw2); \
    A2_VRD(6); A2_SBAR(); A2_GAPA(C1 = A2_MFMA(kf[5], qr[2], C1),   P1[6], P1[7], P1[8], P1[9],     pw2[2] = A2_PKW(P1, 4), pw2[3] = A2_PKW(P1, 6), pw2); \
    A2_VRD(3); A2_SBAR(); A2_GAPA(C0 = A2_MFMA(kf[6], qr[3], C0),   P1[10], P1[11], P1[12], P1[13], pw3[0] = A2_PKW(P1, 8), pw3[1] = A2_PKW(P1, 10), pw3); \
    A2_VRD(7); A2_SBAR(); A2_GAPA(C1 = A2_MFMA(kf[7], qr[3], C1),   P1[14], P1[15], 0.f, 0.f,       pw3[2] = A2_PKW(P1, 12), pw3[3] = A2_PKW(P1, 14), pw3); \
    l_reg += sacc; \
    if (OWN) { int q_ = qrel; asm volatile("" : "+v"(q_)); cmask(C0, C1, t, q_, hi); } \
    { float a = A2_MX3(C0[0], C0[1], C1[0]), b = A2_MX3(C0[2], C0[3], C1[1]); a = A2_MX3(a, C1[2], C1[3]); \
      _Pragma("unroll") for (int r = 4; r < 16; r += 4) { a = A2_MX3(a, C0[r], C0[r + 1]); b = A2_MX3(b, C0[r + 2], C0[r + 3]); a = A2_MX3(a, C1[r], C1[r + 1]); b = A2_MX3(b, C1[r + 2], C1[r + 3]); } \
      float rm = __builtin_fmaxf(a, b); { auto rr = __builtin_amdgcn_permlane32_swap(__float_as_uint(rm), __float_as_uint(rm), false, false); rm = __builtin_fmaxf(__uint_as_float(rr[0]), __uint_as_float(rr[1])); } \
      resc = false; \
      if (__builtin_expect(__builtin_amdgcn_ballot_w64(rm > 8.0f) != 0, 0)) { const float dl = __builtin_fmaxf(rm, 0.f); mhat += dl; \
        _Pragma("unroll") for (int r = 0; r < 16; ++r) { C0[r] -= dl; C1[r] -= dl; } \
        _Pragma("unroll") for (int r = 0; r < 16; ++r) negm[r] = -mhat; asm volatile("" : "+v"(negm)); \
        const float f = __builtin_amdgcn_exp2f(-dl); l_reg *= f; if (hi == 0) { int r_ = r32; asm volatile("" : "+v"(r_)); wsc[r_] = f; } resc = true; } } \
    A2_SBAR(); \
    A2_GAPB(o[0] = A2_MFMA(A2_PAF(0), A2_VFR(0), o[0]), C0, 0); \
    A2_GAPB(o[1] = A2_MFMA(A2_PAF(0), A2_VFR(4), o[1]), C0, 4); \
    A2_KRD(GL, 0); A2_GAPB(o[0] = A2_MFMA(A2_PAF(1), A2_VFR(1), o[0]), C0, 8); \
    A2_KRD(GL, 1); A2_GAPB(o[1] = A2_MFMA(A2_PAF(1), A2_VFR(5), o[1]), C0, 12); \
    A2_KRD(GL, 2); A2_GAPB(o[0] = A2_MFMA(A2_PAF(2), A2_VFR(2), o[0]), C1, 0); \
    A2_KRD(GL, 3); A2_GAPB(o[1] = A2_MFMA(A2_PAF(2), A2_VFR(6), o[1]), C1, 4); \
    A2_GAPB(o[0] = A2_MFMA(A2_PAF(3), A2_VFR(3), o[0]), C1, 8); \
    A2_GAPB(o[1] = A2_MFMA(A2_PAF(3), A2_VFR(7), o[1]), C1, 12); \
    } while (0)
    unsigned ent0 = 0u, ent1 = ATT_ENT(0), ent2 = (nul > 1) ? ATT_ENT(1) : ent1;
    asm volatile("" : "+v"(ent1), "+v"(ent2));
    attn_dma_k(ldsb, Kb, ATT_ROWBASE(0), ATT_H(0), wave, F.lane);
    attn_dma_q(ldsb, Qb + ((size_t)(um[0] >> 6) * SEQ + (ent1 >> 2)) * 64, wave, F.lane);
    attn_dma_v(ldsb, Vb, ATT_ROWBASE(0), ATT_H(0), wave, F.lane);
    bool prev_active = false;
    int st_next = st_tail; const int st_step = F.G * 8; int st_cur = 0; bool st_real = false;
    const unsigned stg_lds = ldsb + ATT_STG + wave * 4096;
    unsigned char* dummy = Wd8 + (size_t)(WS_SIDE_DUMMY - WS_WD) + (size_t)(F.vcu * 8 + wave) * 1024;
    if (!OWN) { *(GAS v4u*)(dummy + F.lane * 16) = (v4u){0u, 0u, 0u, 0u}; }
    for (int k = 0; k < nul; ++k) {
        const int b = ATT_B(k), h = ATT_H(k), jb = um[k * 4] & 63, nh = um[k * 4 + 2];
        const int qrel = wave * 32 + r32; const bool valid = qrel < nh;
        const bool same_prev = !OWN && k > 0 && um[(k - 1) * 4] == um[k * 4], same_next = !OWN && k + 1 < nul && um[(k + 1) * 4] == um[k * 4];
        const bool more = k + 1 < nul;
        if (!same_prev) { if (OWN) { if (prev_active) { ATT_WB("vmcnt(8)"); } else { ATT_WB("vmcnt(4)"); } } else { if (prev_active) { ATT_WB("vmcnt(10)"); } else { ATT_WB("vmcnt(5)"); } } }
        else { if (prev_active) { asm volatile("s_waitcnt vmcnt(11)" ::: "memory"); } else { asm volatile("s_waitcnt vmcnt(6)" ::: "memory"); } }
        asm volatile("" : "+v"(ent2));
        ent0 = ent1; ent1 = ent2;
        const int t = (int)(ent0 >> 2), slot = (int)(ent0 & 3); const size_t qrow = (size_t)(b * 16 + h) * SEQ + t;
        bf16x8_t qr[4];
#pragma unroll
        for (int d0 = 0; d0 < 4; ++d0) qr[d0] = *(const LAS bf16x8_t*)(F.lds + ATT_Q + wave * 4096 + (2 * d0 + hi) * 512 + r32 * 16);
        { const int k2 = (k + 2 < nul) ? k + 2 : nul - 1;
          if (OWN) ent2 = ATT_ENT(k2);
          else { const unsigned short* lp = alist + (size_t)(um[k2 * 4] >> 6) * ALIST_BH + alist_off(um[k2 * 4] & 63) + um[k2 * 4 + 1] * 256 + wave * 32 + r32;
              asm volatile("global_load_ushort %0, %1, off" : "=v"(ent2) : "v"(lp) : "memory"); } }
        if (!OWN) { st_real = st_next < SIDE_TASKS; st_cur = st_real ? st_next : SIDE_TASKS - 1; if (st_real) st_next += st_step;
            int ln_ = F.lane; asm volatile("" : "+v"(ln_)); side_dma(st_cur, w_gu, w_d, ln_, stg_lds); }
        const int nv = OWN ? (jb < 3 ? jb : 3) : 0;
        const bool active = wave * 32 < nh;
        float mhat = 0.f, l_reg = 0.f; bool resc = false;
        f32x16 o[2]; o[0] = (f32x16){0.f,0.f,0.f,0.f,0.f,0.f,0.f,0.f,0.f,0.f,0.f,0.f,0.f,0.f,0.f,0.f}; o[1] = o[0];
        f32x16 negm = o[0]; asm volatile("" : "+v"(negm));
        f32x16 pA0, pA1, pB0, pB1; bf16x8_t kf[8]; s16x4_t vlo[8], vhi[8]; v4u pw0, pw1, pw2, pw3;
        if (active) {
#pragma unroll
            for (int j = 0; j < 4; ++j) { kf[2 * j] = *(const LAS bf16x8_t*)(kp0 + j * 8192); kf[2 * j + 1] = *(const LAS bf16x8_t*)(kp0 + j * 8192 + 512); }
            pA0 = A2_MFMA(kf[0], qr[0], negm); pA1 = A2_MFMA(kf[1], qr[0], negm);
#pragma unroll
            for (int d0 = 1; d0 < 4; ++d0) { pA0 = A2_MFMA(kf[2 * d0], qr[d0], pA0); pA1 = A2_MFMA(kf[2 * d0 + 1], qr[d0], pA1); }
            asm volatile("s_nop 15\n\ts_nop 7" : "+v"(pA0), "+v"(pA1));
        }
        LDS_WAIT();
        { int ln_ = F.lane; asm volatile("" : "+v"(ln_)); attn_dma_q(ldsb, Qb + ((size_t)(um[(more ? k + 1 : k) * 4] >> 6) * SEQ + (ent1 >> 2)) * 64, wave, ln_); }
        if (active) {
#pragma unroll
            for (int j = 0; j < 4; ++j) { kf[2 * j] = *(const LAS bf16x8_t*)(kp0 + 1024 + j * 8192); kf[2 * j + 1] = *(const LAS bf16x8_t*)(kp0 + 1024 + j * 8192 + 512); }
            if (OWN) { int q_ = qrel; asm volatile("" : "+v"(q_)); cmask(pA0, pA1, 0, q_, hi); }
            const float rm = rowmax32(pA0, pA1); mhat = rm;
#pragma unroll
            for (int r = 0; r < 16; ++r) { pA0[r] = fsub_s(pA0[r], rm); pA1[r] = fsub_s(pA1[r], rm); }
#pragma unroll
            for (int r = 0; r < 16; ++r) negm[r] = -mhat;
            asm volatile("" : "+v"(negm));
#pragma unroll
            for (int r = 0; r < 16; ++r) pA0[r] = __builtin_amdgcn_exp2f(pA0[r]);
#pragma unroll
            for (int r = 0; r < 16; ++r) pA1[r] = __builtin_amdgcn_exp2f(pA1[r]);
        }
        if (!same_prev) { if (OWN) { if (prev_active) { ATT_WB("vmcnt(8) lgkmcnt(0)"); } else { ATT_WB("vmcnt(4) lgkmcnt(0)"); } } else { if (prev_active) { ATT_WB("vmcnt(15) lgkmcnt(0)"); } else { ATT_WB("vmcnt(10) lgkmcnt(0)"); } } }
        const bool full = !OWN || wave >= 4;
        if (active) { A2_STEP(pB0, pB1, pA0, pA1, 1, true); A2_RESC(); }
        if (!OWN) { asm volatile("s_waitcnt vmcnt(4)" ::: "memory");
            { int ln_ = F.lane; asm volatile("" : "+v"(ln_)); side_consume(st_cur, st_real, dummy, Wgu8, Wd8, ln_, F.lds + ATT_STG + wave * 4096); }
            LDS_WAIT();
            st_real = st_next < SIDE_TASKS; st_cur = st_real ? st_next : SIDE_TASKS - 1; if (st_real) st_next += st_step;
            { int ln_ = F.lane; asm volatile("" : "+v"(ln_)); side_dma(st_cur, w_gu, w_d, ln_, stg_lds); } }
        if (active) { if (full) { A2_STEP(pA0, pA1, pB0, pB1, 2, true); A2_RESC(); } }
        if (!same_next) { ATT_WB("lgkmcnt(0)");
            if (more) { int ln_ = F.lane; asm volatile("" : "+v"(ln_)); attn_dma_k(ldsb, Kb, ATT_ROWBASE(k + 1), ATT_H(k + 1), wave, ln_); } }
        if (active) {
            if (full) { A2_STEP(pB0, pB1, pA0, pA1, 3, false); A2_RESC(); }
            float sacc = pB0[0] + pB0[1];
#pragma unroll
            for (int r = 2; r < 16; ++r) sacc += pB0[r];
#pragma unroll
            for (int r = 0; r < 16; ++r) sacc += pB1[r];
            l_reg += sacc;
            pw0 = (v4u){A2_PKW(pB0, 0), A2_PKW(pB0, 2), A2_PKW(pB0, 4), A2_PKW(pB0, 6)}; pw1 = (v4u){A2_PKW(pB0, 8), A2_PKW(pB0, 10), A2_PKW(pB0, 12), A2_PKW(pB0, 14)};
            pw2 = (v4u){A2_PKW(pB1, 0), A2_PKW(pB1, 2), A2_PKW(pB1, 4), A2_PKW(pB1, 6)}; pw3 = (v4u){A2_PKW(pB1, 8), A2_PKW(pB1, 10), A2_PKW(pB1, 12), A2_PKW(pB1, 14)};
            { const LAS unsigned char* vp_ = vp0 + (full ? 3 * 4096 : 4096);
#pragma unroll
              for (int i = 0; i < 8; ++i) A2_VRD(i);
              o[0] = A2_MFMA(A2_PAF(0), A2_VFR(0), o[0]); o[1] = A2_MFMA(A2_PAF(0), A2_VFR(4), o[1]);
              o[0] = A2_MFMA(A2_PAF(1), A2_VFR(1), o[0]); o[1] = A2_MFMA(A2_PAF(1), A2_VFR(5), o[1]);
              o[0] = A2_MFMA(A2_PAF(2), A2_VFR(2), o[0]); o[1] = A2_MFMA(A2_PAF(2), A2_VFR(6), o[1]);
              o[0] = A2_MFMA(A2_PAF(3), A2_VFR(3), o[0]); o[1] = A2_MFMA(A2_PAF(3), A2_VFR(7), o[1]); }
            { auto rr = __builtin_amdgcn_permlane32_swap(__float_as_uint(l_reg), __float_as_uint(l_reg), false, false); l_reg = __uint_as_float(rr[0]) + __uint_as_float(rr[1]); }
        }
        if (!same_next) { ATT_WB("lgkmcnt(0)");
            if (more) { int ln_ = F.lane; asm volatile("" : "+v"(ln_)); attn_dma_v(ldsb, Vb, ATT_ROWBASE(k + 1), ATT_H(k + 1), wave, ln_); } }
        else { LDS_WAIT(); }
        if (!OWN) { if (!same_next && more) { asm volatile("s_waitcnt vmcnt(8)" ::: "memory"); } else { asm volatile("s_waitcnt vmcnt(0)" ::: "memory"); }
            { int ln_ = F.lane; asm volatile("" : "+v"(ln_)); side_consume(st_cur, st_real, dummy, Wgu8, Wd8, ln_, F.lds + ATT_STG + wave * 4096); }
            LDS_WAIT(); }
        const float mx = mhat, l = l_reg;
        if (active) {
            int r32e = r32, hie = hi, lne = F.lane; asm volatile("" : "+v"(r32e), "+v"(hie), "+v"(lne));
            LAS bf16* stg = (LAS bf16*)(F.lds + ATT_STG + wave * 4096);
            if (!OWN) {
                if (hie == 0) { wsc[r32e] = 1.0f / l; ((LAS int*)wsc)[32 + r32e] = valid ? (int)(qrow * 3 + slot) : -1;
                    if (valid) { typedef float f32x2s __attribute__((ext_vector_type(2))); *(GAS f32x2s*)(PML + (qrow * 3 + slot) * 2) = (f32x2s){mx, l}; } }
                LDS_WAIT(); asm volatile("" ::: "memory");
#pragma unroll
                for (int r = 0; r < 16; ++r) { const int orow = crow(r, hie); const float rl = wsc[orow];
#pragma unroll
                    for (int dh = 0; dh < 2; ++dh) stg[orow * 64 + dh * 32 + r32e] = (bf16)(cvt_pk_bf16(o[dh][r] * rl, 0.f) & 0xffffu); }
                LDS_WAIT(); asm volatile("" ::: "memory");
#pragma unroll
                for (int i = 0; i < 4; ++i) { const int row = i * 8 + (lne >> 3), ch = lne & 7; const int pidx = ((LAS int*)wsc)[32 + row];
                    const v4u v = *(const LAS v4u*)(stg + row * 64 + ch * 8);
                    bf16* dst = (pidx >= 0) ? PO + (size_t)pidx * 64 + ch * 8 : (bf16*)(dummy + lne * 16);
                    *(GAS v4u*)dst = v; }
            } else {
                float pm_[3], pl_[3];
#pragma unroll
                for (int i = 0; i < 3; ++i) { pm_[i] = -INFINITY; pl_[i] = 0.f; if (i < nv) { const float* pm = PML + (qrow * 3 + i) * 2; pm_[i] = pm[0]; pl_[i] = pm[1]; } }
                const size_t grow0 = (size_t)b * SEQ + jb * 256 + wave * 32;
                const size_t hrow0 = (size_t)(b * 16 + h) * SEQ + jb * 256 + wave * 32;
                v4u pp[4][3];
#pragma unroll
                for (int i = 0; i < 4; ++i)
#pragma unroll
                    for (int sl = 0; sl < 3; ++sl) { pp[i][sl] = (v4u){0u, 0u, 0u, 0u};
                        if (sl < nv) pp[i][sl] = __builtin_nontemporal_load((const GAS v4u*)(PO + ((hrow0 + i * 8 + (lne >> 3)) * 3 + sl) * 64 + (lne & 7) * 8)); }
                float Mx = mx;
#pragma unroll
                for (int i = 0; i < 3; ++i) Mx = fmaxf(Mx, pm_[i]);
                const float aown = __builtin_amdgcn_exp2f(mx - Mx); float W = l * aown; float wi[3];
#pragma unroll
                for (int i = 0; i < 3; ++i) { wi[i] = pl_[i] * __builtin_amdgcn_exp2f(pm_[i] - Mx); W += wi[i]; }
                const float rW = 1.0f / W;
                if (hie == 0) { wsc[r32e * 4 + 0] = aown * rW; wsc[r32e * 4 + 1] = wi[0] * rW; wsc[r32e * 4 + 2] = wi[1] * rW; wsc[r32e * 4 + 3] = wi[2] * rW; }
                LDS_WAIT(); asm volatile("" ::: "memory");
#pragma unroll
                for (int r = 0; r < 16; ++r) { const int orow = crow(r, hie); const float c0 = wsc[orow * 4];
#pragma unroll
                    for (int dh = 0; dh < 2; ++dh) stg[orow * 64 + dh * 32 + r32e] = (bf16)(cvt_pk_bf16(o[dh][r] * c0, 0.f) & 0xffffu); }
                LDS_WAIT(); asm volatile("" ::: "memory");
#pragma unroll
                for (int i = 0; i < 4; ++i) { const int row = i * 8 + (lne >> 3), ch = lne & 7;
                    const v4u ov = *(const LAS v4u*)(stg + row * 64 + ch * 8);
                    float a8[8] = {bf_lo(ov.x), bf_hi(ov.x), bf_lo(ov.y), bf_hi(ov.y), bf_lo(ov.z), bf_hi(ov.z), bf_lo(ov.w), bf_hi(ov.w)};
#pragma unroll
                    for (int sl = 0; sl < 3; ++sl) { const float c = wsc[row * 4 + 1 + sl]; const v4u pv = pp[i][sl];
                        a8[0] += c * bf_lo(pv.x); a8[1] += c * bf_hi(pv.x); a8[2] += c * bf_lo(pv.y); a8[3] += c * bf_hi(pv.y);
                        a8[4] += c * bf_lo(pv.z); a8[5] += c * bf_hi(pv.z); a8[6] += c * bf_lo(pv.w); a8[7] += c * bf_hi(pv.w); }
                    int w0 = 0, w1 = 0; w0 = __builtin_amdgcn_cvt_pk_fp8_f32(a8[0] * 16.f, a8[1] * 16.f, w0, false); w0 = __builtin_amdgcn_cvt_pk_fp8_f32(a8[2] * 16.f, a8[3] * 16.f, w0, true);
                    w1 = __builtin_amdgcn_cvt_pk_fp8_f32(a8[4] * 16.f, a8[5] * 16.f, w1, false); w1 = __builtin_amdgcn_cvt_pk_fp8_f32(a8[6] * 16.f, a8[7] * 16.f, w1, true);
                    v2u w; w.x = (unsigned)w0; w.y = (unsigned)w1; *(GAS v2u*)((unsigned char*)ATTO + (grow0 + row) * 1024 + h * 64 + ch * 8) = w; }
            }
        }
        asm volatile("" ::: "memory");
        prev_active = active;
    }
    st_tail = st_next;
    }
    asm volatile("s_waitcnt vmcnt(0) lgkmcnt(0)" ::: "memory");
#ifndef SIDE_IN_P0
    if (!OWN)
#else
    if (false)
#endif
    { float sv[16], sv1[16]; const int st_step = F.G * 8;
        for (int st = st_tail; st < SIDE_TASKS; st += 2 * st_step) { side_issue(st, w_gu, w_d, F.lane, sv); const bool two = st + st_step < SIDE_TASKS; if (two) side_issue(st + st_step, w_gu, w_d, F.lane, sv1);
            side_finish(st, Wgu8, Wd8, F.lane, sv); if (two) side_finish(st + st_step, Wgu8, Wd8, F.lane, sv1); } }
    asm volatile("s_waitcnt vmcnt(0) lgkmcnt(0)" ::: "memory");
    __syncthreads();
#undef ATT_ENT
#undef ATT_ROWBASE
#undef ATT_H
#undef ATT_B
}

#define DECL_PTRS() int z_ = 0; asm volatile("" : "+s"(z_)); unsigned char* ws = args.ws + z_; const float* x = args.in[0 + z_]; const float* g_mix = args.in[1 + z_]; const float* w_in = args.in[2 + z_]; const float* conv_w = args.in[3 + z_]; const float* w_co = args.in[4 + z_]; const float* w_ao = args.in[5 + z_]; const float* w_out = args.in[6 + z_]; const float* g_ffn = args.in[7 + z_]; const float* router_w = args.in[8 + z_]; const float* router_b = args.in[9 + z_]; const float* w_gu = args.in[10 + z_]; const float* b_gu = args.in[11 + z_]; const float* w_d = args.in[12 + z_]; const float* b_d = args.in[13 + z_]; const float* g_fin = args.in[14 + z_]; float* out = args.out + z_; bf16* Win_t = (bf16*)(ws + WS_WIN); bf16* Wco_t = (bf16*)(ws + WS_WCO); bf16* Wao_t = (bf16*)(ws + WS_WAO); bf16* Wout_t = (bf16*)(ws + WS_WOUT); bf16* Wgu_t = (bf16*)(ws + WS_WGU); bf16* Wd_t = (bf16*)(ws + WS_WD); bf16* XN = (bf16*)(ws + WS_XN); bf16* CB = (bf16*)(ws + WS_CB); bf16* U = (bf16*)(ws + WS_U); bf16* Qb = (bf16*)(ws + WS_Q); bf16* Kb = (bf16*)(ws + WS_K); bf16* Vb = (bf16*)(ws + WS_V); bf16* GC = (bf16*)(ws + WS_GC); bf16* GA = (bf16*)(ws + WS_GA); bf16* T1 = U; bf16* MERGED = Qb; bf16* ATTO = XN; bf16* HN = XN; bf16* ACT = (bf16*)(ws + WS_ACT); bf16* Y = (bf16*)(ws + WS_Y); float* cosT = (float*)(ws + WS_COS); float* sinT = (float*)(ws + WS_SIN); float* ksum = (float*)(ws + WS_KSUM); float* rwg = (float*)(ws + WS_RWG); bf16* PO = (bf16*)(ws + WS_PO); float* PML = (float*)(ws + WS_PML); unsigned short* alist = (unsigned short*)(ws + WS_ALIST); gu32* acnt = F.ctl + CW_ACNT; int* etok = (int*)(ws + WS_ETOK); float* ewt = (float*)(ws + WS_EWT); float* erstd = (float*)(ws + WS_ERSTD); (void)erstd; unsigned char* Win8 = ws + WS_WIN8; unsigned char* Wao8 = ws + WS_WAO8; unsigned char* XN8 = ws + WS_XN8; (void)Win8; (void)Wao8; (void)XN8; int* tokslot = (int*)(ws + WS_TOKSLOT); (void)x; (void)out;
struct Args { const float* in[15]; float* out; unsigned char* ws; int ph_lo, ph_hi; };
constexpr int NPHASE = 11;

__global__ void __launch_bounds__(512, 2) fwd_kernel(Args args) {
    extern __shared__ __attribute__((aligned(16))) unsigned char lds_raw[];
    Frame F;
    F.lds = (LAS unsigned char*)lds_raw;
    F.tid = threadIdx.x; F.lane = F.tid & 63; F.wave = __builtin_amdgcn_readfirstlane(F.tid >> 6);
    F.G = gridDim.x; { const int bx = blockIdx.x; F.vcu = (F.G % 8 == 0) ? (bx % 8) * (F.G / 8) + bx / 8 : bx; }
    F.ws = args.ws; F.ctl = (gu32*)(args.ws + WS_CTL);

    for (int u = F.tid; u < (LDS_BYTES - LDSCTL_OFF) / 4; u += 512) ((LAS unsigned*)(F.lds + LDSCTL_OFF))[u] = 0u;
    __syncthreads();
    XcdBarrier bar = xcd_barrier_post((unsigned*)(F.ctl + CW_BAR), (volatile LAS unsigned*)(F.lds + MISC_OFF) + 8);
    const int lo = args.ph_lo, hi = args.ph_hi;
#define IN(k) (lo <= (k) && (k) < hi)
#define SEAM(k) do { if (IN(k) && IN((k) + 1)) xcd_barrier(bar); } while (0)
    const int gw = F.vcu * 8 + F.wave, NGW = F.G * 8;
    LAS int* tab = (LAS int*)(F.lds + TAB_OFF);

    if (IN(0)) {
        DECL_PTRS();
        constexpr int I_IN = 16 * 128, I_SQ = 16 * 16;
        constexpr int NITEMS = I_IN + 3 * I_SQ;
        for (int it = gw; it < NITEMS; it += NGW) {
            int r = it;
            if (r < I_IN) { const int nb = r % 128; if (nb < 48 || (nb >= 96 && nb < 112)) p0_transpose_task<1>(w_in, 8192, Win_t, g_mix, r, F.lane); else p0_transpose_task8<1>(w_in, 8192, Win8, g_mix, r, F.lane); continue; } r -= I_IN;
            if (r < I_SQ) { p0_transpose_task8<0>(w_ao, 1024, Wao8, nullptr, r, F.lane); continue; } r -= I_SQ;
            if (r < I_SQ) { p0_transpose_task<0>(w_co, 1024, Wco_t, nullptr, r, F.lane); continue; } r -= I_SQ;
            p0_transpose_task<0>(w_out, 1024, Wout_t, nullptr, r, F.lane);
        }
        for (int m = gw; m < M; m += NGW) {
            const GAS f32x4* xr = (const GAS f32x4*)(x + (size_t)m * D) + F.lane; f32x4 v[4]; float s = 0.f;
#pragma unroll
            for (int j = 0; j < 4; ++j) { v[j] = xr[64 * j]; s += (v[j].x * v[j].x + v[j].y * v[j].y) + (v[j].z * v[j].z + v[j].w * v[j].w); }
            const float rstd = 1.0f / sqrtf(wave_sum(s) * (1.f / D) + EPS);
            GAS v2u* o8 = (GAS v2u*)(XN + (size_t)m * D) + F.lane; GAS unsigned* o4 = (GAS unsigned*)(XN8 + (size_t)m * D) + F.lane;
#pragma unroll
            for (int j = 0; j < 4; ++j) { v2u w; w.x = cvt_pk_bf16(v[j].x * rstd, v[j].y * rstd); w.y = cvt_pk_bf16(v[j].z * rstd, v[j].w * rstd); o8[64 * j] = w;
                int q8 = 0; q8 = __builtin_amdgcn_cvt_pk_fp8_f32(v[j].x * rstd, v[j].y * rstd, q8, false); q8 = __builtin_amdgcn_cvt_pk_fp8_f32(v[j].z * rstd, v[j].w * rstd, q8, true); o4[64 * j] = (unsigned)q8; }
        }
        const int gt = F.vcu * 512 + F.tid, NT = F.G * 512;
        for (int i = gt; i < SEQ * 32; i += NT) { const int pos = i >> 5, k = i & 31; const float inv = powf(10000.0f, -(float)k / 32.0f); const float ang = (float)pos * inv; cosT[i] = cosf(ang); sinT[i] = sinf(ang); }
        for (int i = gt; i < BATCH * NBLK * 1024; i += NT) ksum[i] = 0.f;
        { unsigned short* rwgH = (unsigned short*)rwg; unsigned short* rwgL = rwgH + 64 * 64 * 8;
          for (int i = gt; i < 64 * 64 * 8; i += NT) { const int jj = i & 7, ln = (i >> 3) & 63, st = i >> 9, k = 16 * st + 8 * (ln >> 5) + jj, e = ln & 31;
              const float v = router_w[k * 32 + e] * g_ffn[k]; const unsigned hb = cvt_pk_bf16(v, 0.f) & 0xffffu; const float vh = __uint_as_float(hb << 16);
              rwgH[i] = (unsigned short)hb; rwgL[i] = (unsigned short)(cvt_pk_bf16(v - vh, 0.f) & 0xffffu); } }
#ifdef SIDE_IN_P0
        { float sv[16], sv1[16]; const int st_step = F.G * 8;
          for (int st = F.vcu * 8 + F.wave; st < SIDE_TASKS; st += 2 * st_step) { side_issue(st, w_gu, w_d, F.lane, sv); const bool two = st + st_step < SIDE_TASKS; if (two) side_issue(st + st_step, w_gu, w_d, F.lane, sv1);
              side_finish(st, (unsigned char*)Wgu_t, (unsigned char*)Wd_t, F.lane, sv); if (two) side_finish(st + st_step, (unsigned char*)Wgu_t, (unsigned char*)Wd_t, F.lane, sv1); } }
#endif
    }
    SEAM(0);
    if (IN(1)) {
        DECL_PTRS();
        { DensePol P{XN, Win_t, M / 256, 16, F.G, (int)blockIdx.x, 2, 12, 0, 12}; EpiInProj E{CB, U, Qb, Kb, Vb, GC, GA, cosT, sinT, ksum, 1.0f};
          pg8::gemm_phase<EpiInProj, DensePol, true>(F.lds, P, E); }
        { DensePol P{XN8, Win8, M / 256, 16, F.G, (int)blockIdx.x, 1, 12, 12, 16}; EpiInProj E{CB, U, Qb, Kb, Vb, GC, GA, cosT, sinT, ksum, 1.0f / 32.0f};
          pg8::gemm_phase<EpiInProj, DensePol, true, true>(F.lds, P, E); }
    }
    SEAM(1);
    if (IN(2)) {
        DECL_PTRS();
        bf16* CBW = CB;
        {
            const int cg = F.tid & 127, rs = F.tid >> 7;
            float w0[8], w1[8], w2[8];
#pragma unroll
            for (int e = 0; e < 8; ++e) { w0[e] = conv_w[cg * 8 + e]; w1[e] = conv_w[1024 + cg * 8 + e]; w2[e] = conv_w[2048 + cg * 8 + e]; }
            const int row0 = F.vcu * (M / F.G) + rs * 32, pos0 = row0 & (SEQ - 1);
            const size_t off0 = (size_t)row0 * 1024 + cg * 8;
            v4u u1 = (v4u){0u, 0u, 0u, 0u}, u2 = (v4u){0u, 0u, 0u, 0u};
            if (pos0 >= 1) u1 = *(const GAS v4u*)(U + off0 - 1024);
            if (pos0 >= 2) u2 = *(const GAS v4u*)(U + off0 - 2048);
#pragma unroll 1
            for (int r = 0; r < 32; r += 4) {
                v4u cb[4], uu[4];
#pragma unroll
                for (int q = 0; q < 4; ++q) { cb[q] = *(const GAS v4u*)(CB + off0 + (size_t)(r + q) * 1024); uu[q] = *(const GAS v4u*)(U + off0 + (size_t)(r + q) * 1024); }
#pragma unroll
                for (int q = 0; q < 4; ++q) {
                    const v4u u0 = uu[q]; float o[8];
#define CV(i, cw, a0, a1, a2, sel) o[i] = sel(cw) * (w0[i] * sel(a2) + w1[i] * sel(a1) + w2[i] * sel(a0))
                    CV(0, cb[q].x, u0.x, u1.x, u2.x, bf_lo); CV(1, cb[q].x, u0.x, u1.x, u2.x, bf_hi); CV(2, cb[q].y, u0.y, u1.y, u2.y, bf_lo); CV(3, cb[q].y, u0.y, u1.y, u2.y, bf_hi);
                    CV(4, cb[q].z, u0.z, u1.z, u2.z, bf_lo); CV(5, cb[q].z, u0.z, u1.z, u2.z, bf_hi); CV(6, cb[q].w, u0.w, u1.w, u2.w, bf_lo); CV(7, cb[q].w, u0.w, u1.w, u2.w, bf_hi);
#undef CV
                    v4u w; w.x = cvt_pk_bf16(o[0], o[1]); w.y = cvt_pk_bf16(o[2], o[3]); w.z = cvt_pk_bf16(o[4], o[5]); w.w = cvt_pk_bf16(o[6], o[7]);
                    *(GAS v4u*)(CBW + off0 + (size_t)(r + q) * 1024) = w;
                    u2 = u1; u1 = u0;
                }
            }
        }
        __syncthreads();
        {
            LAS unsigned char* kmH = F.lds; LAS unsigned char* kmL = F.lds + 8192;
            LAS int* lc = (LAS int*)(F.lds + 16384); LAS int* gb = lc + 64;
            const int r32 = F.lane & 31, hi = F.lane >> 5;
            for (int task = F.vcu; task < 32 * 32; task += F.G) {
                const int bh = task >> 5, chunk = task & 31, b = bh >> 4, h = bh & 15;
                { const int j = F.tid >> 3, c = F.tid & 7;
                  const f32x4 k0 = *(const f32x4*)(ksum + (size_t)(b * 64 + j) * 1024 + h * 64 + c * 8), k1 = *(const f32x4*)(ksum + (size_t)(b * 64 + j) * 1024 + h * 64 + c * 8 + 4);
                  v4u vh; vh.x = cvt_pk_bf16(k0.x, k0.y); vh.y = cvt_pk_bf16(k0.z, k0.w); vh.z = cvt_pk_bf16(k1.x, k1.y); vh.w = cvt_pk_bf16(k1.z, k1.w);
                  v4u vl; vl.x = cvt_pk_bf16(k0.x - bf_lo(vh.x), k0.y - bf_hi(vh.x)); vl.y = cvt_pk_bf16(k0.z - bf_lo(vh.y), k0.w - bf_hi(vh.y));
                  vl.z = cvt_pk_bf16(k1.x - bf_lo(vh.z), k1.y - bf_hi(vh.z)); vl.w = cvt_pk_bf16(k1.z - bf_lo(vh.w), k1.w - bf_hi(vh.w));
                  *(LAS v4u*)(kmH + c * 1024 + j * 16) = vh; *(LAS v4u*)(kmL + c * 1024 + j * 16) = vl; }
                if (F.tid < 64) lc[F.tid] = 0;
                __syncthreads();
                const int own = chunk * 2 + (F.wave >> 2), nv = own < 3 ? own : 3;
                int sel[2][3] = {{0, 0, 0}, {0, 0, 0}}, rk[2][3] = {{0, 0, 0}, {0, 0, 0}};
                if (own > 0) {
#pragma unroll
                    for (int ps = 0; ps < 2; ++ps) {
                        const int t = chunk * 512 + F.wave * 64 + ps * 32 + r32;
                        bf16x8_t qr[4];
#pragma unroll
                        for (int d0 = 0; d0 < 4; ++d0) qr[d0] = *(const bf16x8_t*)(Qb + ((size_t)(b * 16 + h) * SEQ + t) * 64 + d0 * 16 + hi * 8);
                        float v0 = -INFINITY, v1 = -INFINITY, v2 = -INFINITY; int i0 = 0, i1 = 0, i2 = 0;
#pragma unroll
                        for (int tl = 0; tl < 2; ++tl) {
                            if (tl * 32 < own) {
                                f32x16 g = {0.f, 0.f, 0.f, 0.f, 0.f, 0.f, 0.f, 0.f, 0.f, 0.f, 0.f, 0.f, 0.f, 0.f, 0.f, 0.f};
#pragma unroll
                                for (int d0 = 0; d0 < 4; ++d0) { const bf16x8_t ah = *(const LAS bf16x8_t*)(kmH + (2 * d0 + hi) * 1024 + (tl * 32 + r32) * 16), al = *(const LAS bf16x8_t*)(kmL + (2 * d0 + hi) * 1024 + (tl * 32 + r32) * 16);
                                    g = __builtin_amdgcn_mfma_f32_32x32x16_bf16(ah, qr[d0], g, 0, 0, 0); g = __builtin_amdgcn_mfma_f32_32x32x16_bf16(al, qr[d0], g, 0, 0, 0); }
#pragma unroll
                                for (int r = 0; r < 16; ++r) { const int j = tl * 32 + crow(r, hi); const float gv = (j < own) ? g[r] : -INFINITY;
                                    if (gv > v0) { v2 = v1; i2 = i1; v1 = v0; i1 = i0; v0 = gv; i0 = j; }
                                    else if (gv > v1) { v2 = v1; i2 = i1; v1 = gv; i1 = j; }
                                    else if (gv > v2) { v2 = gv; i2 = j; } }
                            }
                        }
                        float pv[3] = {__shfl_xor(v0, 32), __shfl_xor(v1, 32), __shfl_xor(v2, 32)}; int pi[3] = {__shfl_xor(i0, 32), __shfl_xor(i1, 32), __shfl_xor(i2, 32)};
#pragma unroll
                        for (int e = 0; e < 3; ++e) { const float gv = pv[e]; const int j = pi[e];
                            if (gv > v0 || (gv == v0 && j < i0)) { v2 = v1; i2 = i1; v1 = v0; i1 = i0; v0 = gv; i0 = j; }
                            else if (gv > v1 || (gv == v1 && j < i1)) { v2 = v1; i2 = i1; v1 = gv; i1 = j; }
                            else if (gv > v2 || (gv == v2 && j < i2)) { v2 = gv; i2 = j; } }
                        sel[ps][0] = i0; sel[ps][1] = i1; sel[ps][2] = i2;
                        if (hi == 0) {
                            rk[ps][0] = __hip_atomic_fetch_add(&lc[i0], 1, __ATOMIC_RELAXED, __HIP_MEMORY_SCOPE_WORKGROUP);
                            if (nv > 1) rk[ps][1] = __hip_atomic_fetch_add(&lc[i1], 1, __ATOMIC_RELAXED, __HIP_MEMORY_SCOPE_WORKGROUP);
                            if (nv > 2) rk[ps][2] = __hip_atomic_fetch_add(&lc[i2], 1, __ATOMIC_RELAXED, __HIP_MEMORY_SCOPE_WORKGROUP);
                        }
                    }
                }
                __syncthreads();
                if (F.tid < 64) { const int c = lc[F.tid]; gb[F.tid] = c ? (int)__hip_atomic_fetch_add((unsigned*)(acnt + bh * 64 + F.tid), (unsigned)c, RLX_AGENT) : 0; }
                __syncthreads();
                if (own > 0 && hi == 0) {
                    unsigned short* lb = alist + (size_t)bh * ALIST_BH;
#pragma unroll
                    for (int ps = 0; ps < 2; ++ps) { const int t = chunk * 512 + F.wave * 64 + ps * 32 + r32;
                        lb[alist_off(sel[ps][0]) + gb[sel[ps][0]] + rk[ps][0]] = (unsigned short)((t << 2) | 0);
                        if (nv > 1) lb[alist_off(sel[ps][1]) + gb[sel[ps][1]] + rk[ps][1]] = (unsigned short)((t << 2) | 1);
                        if (nv > 2) lb[alist_off(sel[ps][2]) + gb[sel[ps][2]] + rk[ps][2]] = (unsigned short)((t << 2) | 2); }
                }
                __syncthreads();
            }
        }
    }
    SEAM(2);
    if (IN(3)) {
        DECL_PTRS();
        attn_phase<false>(F, Qb, Kb, Vb, PO, PML, alist, acnt, ATTO, w_gu, w_d, (unsigned char*)Wgu_t, (unsigned char*)Wd_t);
    }
    SEAM(3);
    if (IN(4)) {
        DECL_PTRS();
        attn_phase<true>(F, Qb, Kb, Vb, PO, PML, alist, acnt, ATTO, w_gu, w_d, (unsigned char*)Wgu_t, (unsigned char*)Wd_t);
    }
    SEAM(4);
    if (IN(5)) {
        DECL_PTRS();
        { DensePol P{CB, Wco_t, M / 256, 4, F.G, (int)blockIdx.x, 2, 4, 0, 0}; EpiGate<0> E{GC, nullptr, T1, 1.0f}; pg8::gemm_phase<EpiGate<0>, DensePol, true>(F.lds, P, E); }
        VM_WAIT(); __syncthreads();
        { DensePol P{ATTO, Wao8, M / 256, 4, F.G, (int)blockIdx.x, 1, 4, 0, 0}; EpiGate<1> E{GA, T1, MERGED, 1.0f / 512.0f}; pg8::gemm_phase<EpiGate<1>, DensePol, true, true>(F.lds, P, E); }
    }
    SEAM(5);
    if (IN(6)) {
        DECL_PTRS();
        DensePol P{MERGED, Wout_t, M / 256, 4, F.G, (int)blockIdx.x, 2, 4, 0, 0}; EpiResid E{x, out};
        pg8::gemm_phase<EpiResid, DensePol, true>(F.lds, P, E);
    }
    SEAM(6);
    if (IN(7)) {
        DECL_PTRS();
        LAS int* lcnt = (LAS int*)(F.lds + 98304); LAS int* gbase = lcnt + 32; LAS float* rbl = (LAS float*)(lcnt + 64);
        if (F.tid < 32) { lcnt[F.tid] = 0; rbl[F.tid] = router_b[F.tid]; }
        __syncthreads();
        const int rows_per_wg = M / F.G;
        int myrank[4] = {0, 0, 0, 0}, mye[4] = {0, 0, 0, 0}; float myw[4] = {0.f, 0.f, 0.f, 0.f}; int mytok = -1; float myrstd = 0.f;
        {
            const int r32 = F.lane & 31, hh = F.lane >> 5, rt = F.wave & 3, kh = F.wave >> 2, row = F.vcu * rows_per_wg + rt * 32 + r32;
            const float* hrow = out + (size_t)row * 1024 + kh * 512 + 8 * hh;
            unsigned char* hn = (unsigned char*)HN + (size_t)row * 1024 + kh * 512 + 8 * hh;
            const float* gfr = g_ffn + kh * 512 + 8 * hh;
            const unsigned short* rwgH = (const unsigned short*)rwg + ((size_t)(kh * 32) * 64 + F.lane) * 8; const unsigned short* rwgL = rwgH + 64 * 64 * 8;
            f32x16 acc = {0.f, 0.f, 0.f, 0.f, 0.f, 0.f, 0.f, 0.f, 0.f, 0.f, 0.f, 0.f, 0.f, 0.f, 0.f, 0.f}; float ss = 0.f;
#pragma unroll 4
            for (int st = 0; st < 32; ++st) {
                const f32x4 a0 = *(const f32x4*)(hrow + 16 * st), a1 = *(const f32x4*)(hrow + 16 * st + 4);
                const v4u bh = *(const v4u*)(rwgH + (size_t)st * 512), bl = *(const v4u*)(rwgL + (size_t)st * 512);
                ss += (a0.x * a0.x + a0.y * a0.y) + (a0.z * a0.z + a0.w * a0.w) + (a1.x * a1.x + a1.y * a1.y) + (a1.z * a1.z + a1.w * a1.w);
                v4u ah; ah.x = cvt_pk_bf16(a0.x, a0.y); ah.y = cvt_pk_bf16(a0.z, a0.w); ah.z = cvt_pk_bf16(a1.x, a1.y); ah.w = cvt_pk_bf16(a1.z, a1.w);
                v4u al; al.x = cvt_pk_bf16(a0.x - bf_lo(ah.x), a0.y - bf_hi(ah.x)); al.y = cvt_pk_bf16(a0.z - bf_lo(ah.y), a0.w - bf_hi(ah.y));
                al.z = cvt_pk_bf16(a1.x - bf_lo(ah.z), a1.y - bf_hi(ah.z)); al.w = cvt_pk_bf16(a1.z - bf_lo(ah.w), a1.w - bf_hi(ah.w));
                { const f32x4 g0 = *(const f32x4*)(gfr + 16 * st), g1 = *(const f32x4*)(gfr + 16 * st + 4); int w0 = 0, w1 = 0;
                  w0 = __builtin_amdgcn_cvt_pk_fp8_f32(a0.x * g0.x, a0.y * g0.y, w0, false); w0 = __builtin_amdgcn_cvt_pk_fp8_f32(a0.z * g0.z, a0.w * g0.w, w0, true);
                  w1 = __builtin_amdgcn_cvt_pk_fp8_f32(a1.x * g1.x, a1.y * g1.y, w1, false); w1 = __builtin_amdgcn_cvt_pk_fp8_f32(a1.z * g1.z, a1.w * g1.w, w1, true);
                  v2u w; w.x = (unsigned)w0; w.y = (unsigned)w1; *(GAS v2u*)(hn + 16 * st) = w; }
                const bf16x8_t fah = __builtin_bit_cast(bf16x8_t, ah), fal = __builtin_bit_cast(bf16x8_t, al), fbh = __builtin_bit_cast(bf16x8_t, bh), fbl = __builtin_bit_cast(bf16x8_t, bl);
                acc = __builtin_amdgcn_mfma_f32_32x32x16_bf16(fah, fbh, acc, 0, 0, 0);
                acc = __builtin_amdgcn_mfma_f32_32x32x16_bf16(fah, fbl, acc, 0, 0, 0);
                acc = __builtin_amdgcn_mfma_f32_32x32x16_bf16(fal, fbh, acc, 0, 0, 0);
            }
            LAS float* xch = (LAS float*)(F.lds + 32768 + rt * 8192);
            if (kh == 1) {
#pragma unroll
                for (int r = 0; r < 16; ++r) xch[r * 64 + F.lane] = acc[r];
                xch[16 * 64 + F.lane] = ss; }
            LDS_WAIT(); __syncthreads();
            if (kh == 0) {
#pragma unroll
                for (int r = 0; r < 16; ++r) acc[r] += xch[r * 64 + F.lane];
                ss += xch[16 * 64 + F.lane];
                ss += __shfl_xor(ss, 32);
                const float rstd = 1.0f / sqrtf(ss * (1.f / D) + EPS);
                LAS float* scr = (LAS float*)(F.lds + rt * 8192);
#pragma unroll
                for (int r = 0; r < 16; ++r) scr[crow(r, hh) * 33 + r32] = acc[r];
                LDS_WAIT(); asm volatile("" ::: "memory");
                if (hh == 0) {
                    float v0 = -INFINITY, v1 = -INFINITY, v2 = -INFINITY, v3 = -INFINITY; int i0 = 0, i1 = 0, i2 = 0, i3 = 0;
#pragma unroll 4
                    for (int e = 0; e < 32; ++e) { const float g = scr[r32 * 33 + e] * rstd + rbl[e];
                        if (g > v0) { v3 = v2; i3 = i2; v2 = v1; i2 = i1; v1 = v0; i1 = i0; v0 = g; i0 = e; }
                        else if (g > v1) { v3 = v2; i3 = i2; v2 = v1; i2 = i1; v1 = g; i1 = e; }
                        else if (g > v2) { v3 = v2; i3 = i2; v2 = g; i2 = e; }
                        else if (g > v3) { v3 = g; i3 = e; } }
                    const float e1 = __expf(v1 - v0), e2 = __expf(v2 - v0), e3 = __expf(v3 - v0), inv = 1.0f / (1.0f + e1 + e2 + e3);
                    mye[0] = i0; mye[1] = i1; mye[2] = i2; mye[3] = i3; myw[0] = inv; myw[1] = e1 * inv; myw[2] = e2 * inv; myw[3] = e3 * inv; mytok = row; myrstd = rstd;
#pragma unroll
                    for (int k = 0; k < 4; ++k) myrank[k] = __hip_atomic_fetch_add(&lcnt[mye[k]], 1, __ATOMIC_RELAXED, __HIP_MEMORY_SCOPE_WORKGROUP);
                }
            }
        }
        __syncthreads();
        if (F.tid < 32) gbase[F.tid] = (int)__hip_atomic_fetch_add((unsigned*)(F.ctl + CW_ECNT + 64 * F.tid), (unsigned)lcnt[F.tid], RLX_AGENT);
        __syncthreads();
        if (mytok >= 0) {
#pragma unroll
            for (int k = 0; k < 4; ++k) { const int e = mye[k], pos = gbase[e] + myrank[k]; etok[e * 32768 + pos] = mytok; ewt[e * 32768 + pos] = myw[k]; erstd[e * 32768 + pos] = myrstd; tokslot[mytok * 4 + k] = e * 32768 + pos; }
        }
    }
    SEAM(7);
    if (IN(8) || IN(9) || IN(10)) {
        __syncthreads();
        if (F.tid < 64) {
            const int e = F.tid & 31; const int c = (int)__hip_atomic_load(F.ctl + CW_ECNT + 64 * e, RLX_AGENT); const int t = (c + 255) >> 8;
            int inc = t;
#pragma unroll
            for (int o = 1; o < 32; o <<= 1) { const int v = __shfl_up(inc, o, 32); if (e >= o) inc += v; }
            if (F.tid < 32) { tab[e] = c; tab[32 + e] = inc - t; if (e == 31) { tab[64] = inc; tab[65] = inc; } }
        }
        __syncthreads();
    }
    if (IN(8)) {
        DECL_PTRS();
        LAS int* ul = (LAS int*)(F.lds + UMETA_OFF); __syncthreads(); const int nul = moe_unit_list(ul, tab, 8, F.G, (int)blockIdx.x, F.tid); __syncthreads();
        MoePol1 P{HN, Wgu_t, etok, tab, ul, nul}; EpiSwiglu E{b_gu, erstd, (unsigned char*)ACT};
        pg8::gemm_phase<EpiSwiglu, MoePol1, true, true>(F.lds, P, E);
    }
    SEAM(8);
    if (IN(9)) {
        DECL_PTRS();
        LAS int* ul = (LAS int*)(F.lds + UMETA_OFF); __syncthreads(); const int nul = moe_unit_list(ul, tab, 4, F.G, (int)blockIdx.x, F.tid); __syncthreads();
        MoePol2 P{ACT, Wd_t, ul, nul}; EpiDown E{b_d, ewt, (unsigned char*)Y};
        pg8::gemm_phase<EpiDown, MoePol2, true, true>(F.lds, P, E);
    }
    SEAM(9);
    if (IN(10)) {
        DECL_PTRS();
        const unsigned tmo = __hip_atomic_load(F.ctl + CW_BAR + XB_TMO, RLX_AGENT);
        f32x4 gfv[4];
#pragma unroll
        for (int j = 0; j < 4; ++j) gfv[j] = ((const GAS f32x4*)g_fin + F.lane)[64 * j];
        for (int m = gw; m < M; m += NGW) {
            GAS f32x4* hr = (GAS f32x4*)(out + (size_t)m * D) + F.lane; f32x4 v[4];
#pragma unroll
            for (int j = 0; j < 4; ++j) v[j] = hr[64 * j];
#pragma unroll
            for (int k = 0; k < 4; ++k) { const int ts = tokslot[m * 4 + k], e = ts >> 15, pos = ts & 32767; const size_t srow = (size_t)tab[32 + e] * 256 + pos;
                const GAS unsigned* yr = (const GAS unsigned*)((const unsigned char*)Y + srow * 1024) + F.lane;
#pragma unroll
                for (int j = 0; j < 4; ++j) { const unsigned w = yr[64 * j]; const pg8::f32x2 lo2 = __builtin_amdgcn_cvt_pk_f32_fp8((int)w, false), hi2 = __builtin_amdgcn_cvt_pk_f32_fp8((int)w, true);
                    v[j].x += lo2[0] * (1.0f / 16.0f); v[j].y += lo2[1] * (1.0f / 16.0f); v[j].z += hi2[0] * (1.0f / 16.0f); v[j].w += hi2[1] * (1.0f / 16.0f); } }
            float s = 0.f;
#pragma unroll
            for (int j = 0; j < 4; ++j) s += (v[j].x * v[j].x + v[j].y * v[j].y) + (v[j].z * v[j].z + v[j].w * v[j].w);
            float rstd = 1.0f / sqrtf(wave_sum(s) * (1.f / D) + EPS);
            if (tmo) rstd = __builtin_nanf("");
#pragma unroll
            for (int j = 0; j < 4; ++j) hr[64 * j] = v[j] * rstd * gfv[j];
        }
    }
#undef IN
#undef SEAM
}

extern "C" void kernel_launch(void* const* d_in, const int* in_sizes, int n_in, void* d_out, int out_size, void* d_ws, size_t ws_size, hipStream_t stream) {
    static int grid = 0;
    if (grid == 0) {
        if (n_in != 15 || out_size != M * D || ws_size < WS_END) { fprintf(stderr, "kernel_launch: unexpected shapes (n_in %d out %d ws %zu); nothing launched\n", n_in, out_size, ws_size); grid = -1; return; }
        int dev = 0, cus = 0, per_cu = 0;
        if (hipGetDevice(&dev) != hipSuccess || hipDeviceGetAttribute(&cus, hipDeviceAttributeMultiprocessorCount, dev) != hipSuccess) { grid = -1; return; }
        if (hipFuncSetAttribute((const void*)fwd_kernel, hipFuncAttributeMaxDynamicSharedMemorySize, LDS_BYTES) != hipSuccess) { fprintf(stderr, "kernel_launch: hipFuncSetAttribute failed\n"); grid = -1; return; }
        if (hipOccupancyMaxActiveBlocksPerMultiprocessor(&per_cu, (const void*)fwd_kernel, 512, LDS_BYTES) != hipSuccess || per_cu < 1) { fprintf(stderr, "kernel_launch: occupancy query reports %d blocks per CU; nothing launched\n", per_cu); (void)hipGetLastError(); grid = -1; return; }
        (void)hipGetLastError();
        grid = cus;
    }
    if (grid < 0) return;
    (void)hipMemsetAsync((char*)d_ws + WS_CTL, 0, CTL_ZERO_BYTES, stream);
    Args a{};
    for (int i = 0; i < 15; ++i) a.in[i] = (const float*)d_in[i];
    a.out = (float*)d_out; a.ws = (unsigned char*)d_ws;
    a.ph_lo = 0; a.ph_hi = NPHASE;
#ifndef LAUNCH_PLAN
    hipLaunchKernelGGL(fwd_kernel, dim3(grid), dim3(512), LDS_BYTES, stream, a);
#else
    { static const int plan[] = {LAUNCH_PLAN}; for (unsigned i = 0; i < sizeof(plan) / sizeof(plan[0]); ++i) { a.ph_lo = plan[i]; a.ph_hi = plan[i] + 1; hipLaunchKernelGGL(fwd_kernel, dim3(grid), dim3(512), LDS_BYTES, stream, a); } }
#endif
}
```

```cpp
#include <hip/hip_runtime.h>
#include <cstdio>
#include <cstdint>
#include <cmath>


constexpr int BATCH = 2, SEQ = 16384, D = 1024, M = BATCH * SEQ, NH = 16, HD = 64, NBLK = SEQ / 256, NE = 32, NIN = 8192;
constexpr float EPS = 1e-5f;
constexpr float C2 = 0.125f * 1.4426950408889634f;

namespace pg8 {
#define PG8_LAS __attribute__((address_space(3)))
typedef unsigned short bf16_t;
typedef short bf16x8 __attribute__((ext_vector_type(8)));
typedef float f32x4 __attribute__((ext_vector_type(4)));
typedef float f32x2 __attribute__((ext_vector_type(2)));
typedef unsigned u32x4 __attribute__((ext_vector_type(4)));
typedef unsigned u32x2 __attribute__((ext_vector_type(2)));
constexpr int BM = 256, BK = 64, HALF = 128, HTB = HALF * BK * 2, STAGE_BYTES = 8 * HTB, NXCD = 8, WGM = 5, KD = 1024;

__host__ __device__ __forceinline__ int lds_byte(int r, int c) { const int st = (r >> 4) * 2 + (c >> 5), rr = r & 15, cc = c & 31, ob = rr * 64 + cc * 2; return st * 1024 + (ob ^ (((ob >> 9) & 1) << 5)); }
__host__ __device__ __forceinline__ void stage_rc(int b, int& R, int& C) { const int st = b / 1024, sb = b % 1024, swz = sb ^ (((sb >> 9) & 1) << 5); R = (st >> 1) * 16 + swz / 64; C = (st & 1) * 32 + (swz % 64) / 2; }
__host__ __device__ __forceinline__ int perm32(int rho) { const int n = rho >> 4, i = rho & 15; return 8 * (i >> 2) + 4 * n + (i & 3); }

struct Unit { int pm, pn, e, rt; };

typedef float f32x2_cv __attribute__((ext_vector_type(2))); typedef __bf16 bf16x2_cv __attribute__((ext_vector_type(2)));
__device__ __forceinline__ unsigned cvt_pk_bf16(float lo, float hi) { const f32x2_cv v = {lo, hi}; const bf16x2_cv b = __builtin_convertvector(v, bf16x2_cv); return __builtin_bit_cast(unsigned, b); }
__device__ __forceinline__ float bf_lo(unsigned w) { return __uint_as_float(w << 16); }
__device__ __forceinline__ float bf_hi(unsigned w) { return __uint_as_float(w & 0xffff0000u); }

__device__ __forceinline__ bool tile_order(int i, int G, int c, int nM, int nN, int& pm, int& pn) {
    const int nwg = nM * nN; const long L = (long)i * G + c; if (L >= nwg) return false;
    int wgid = (int)L;
    { const int q = nwg / NXCD, r = nwg % NXCD, xcd = wgid % NXCD, off = wgid / NXCD; wgid = (xcd < r ? xcd * (q + 1) : r * (q + 1) + (xcd - r) * q) + off; }
    const int nig = WGM * nN, gid = wgid / nig, fm = gid * WGM, gsz = (nM - fm) < WGM ? (nM - fm) : WGM;
    pm = fm + ((wgid % nig) % gsz); pn = (wgid % nig) / gsz; return true;
}

typedef int v8i __attribute__((ext_vector_type(8)));
typedef int v4i __attribute__((ext_vector_type(4)));
template <class Epi, class Pol, bool ALIGN_EPI, bool FP8 = false>
__device__ __forceinline__ void gemm_phase(PG8_LAS unsigned char* lds, const Pol& S, const Epi& E) {
    constexpr int K = KD, KB = FP8 ? KD : 2 * KD  , nt = KB / 128;
    const int tid = threadIdx.x, wid = __builtin_amdgcn_readfirstlane(tid >> 6), lane = tid & 63, wr = wid >> 2, wc = wid & 3, fr = lane & 15, fq = lane >> 4;
    int RA[2], CA[2]; unsigned voffB[2];
#pragma unroll
    for (int i = 0; i < 2; ++i) { int R, C; stage_rc(tid * 16 + i * 8192, R, C); const int Rb = Epi::PERM ? ((R & ~31) + perm32(R & 31)) : R;
        RA[i] = R; CA[i] = C; voffB[i] = (unsigned)(Rb * KB + C * 2); }
    constexpr unsigned kstep = BK * 2, hstep = (unsigned)HALF * KB;
    const unsigned ldsw = (unsigned)wid * 1024u;
    const int aoff = lds_byte(wr * 64 + fr, fq * 8), boff = lds_byte(wc * 32 + fr, fq * 8);
#define PG8_SA(b, h) (((b) * 2 + (h)) * HTB)
#define PG8_SB(b, h) ((4 + (b) * 2 + (h)) * HTB)
#define PG8_GLDS(bufoff, ptr, o0, o1) do { \
        __builtin_amdgcn_global_load_lds((const unsigned*)((const char*)(ptr) + (o0)), (PG8_LAS unsigned*)(lds + (bufoff) + ldsw), 16, 0, 0); \
        __builtin_amdgcn_global_load_lds((const unsigned*)((const char*)(ptr) + (o1)), (PG8_LAS unsigned*)(lds + (bufoff) + ldsw + 8192), 16, 0, 0); } while (0)
#define PG8_STAGE_B(bufoff, ptr) PG8_GLDS(bufoff, ptr, voffB[0], voffB[1])
#define PG8_LDA(dst, b, h) do { if constexpr (FP8) { _Pragma("unroll") for (int m = 0; m < 4; ++m) { const v4i l_ = *(const PG8_LAS v4i*)(lds + PG8_SA(b, h) + aoff + m * 2048), h_ = *(const PG8_LAS v4i*)(lds + PG8_SA(b, h) + aoff + m * 2048 + 1024); \
            dst##8[m] = (v8i){l_[0], l_[1], l_[2], l_[3], h_[0], h_[1], h_[2], h_[3]}; } } \
        else { _Pragma("unroll") for (int m = 0; m < 4; ++m) _Pragma("unroll") for (int k = 0; k < 2; ++k) dst[m][k] = *(const PG8_LAS bf16x8*)(lds + PG8_SA(b, h) + aoff + m * 2048 + k * 1024); } } while (0)
#define PG8_LDB(dst, b, h) do { if constexpr (FP8) { _Pragma("unroll") for (int n = 0; n < 2; ++n) { const v4i l_ = *(const PG8_LAS v4i*)(lds + PG8_SB(b, h) + boff + n * 2048), h_ = *(const PG8_LAS v4i*)(lds + PG8_SB(b, h) + boff + n * 2048 + 1024); \
            dst##8[n] = (v8i){l_[0], l_[1], l_[2], l_[3], h_[0], h_[1], h_[2], h_[3]}; } } \
        else { _Pragma("unroll") for (int n = 0; n < 2; ++n) _Pragma("unroll") for (int k = 0; k < 2; ++k) dst[n][k] = *(const PG8_LAS bf16x8*)(lds + PG8_SB(b, h) + boff + n * 2048 + k * 1024); } } while (0)
#define PG8_MMA(ai, bj, At, Bt) do { __builtin_amdgcn_s_setprio(1); if constexpr (FP8) { _Pragma("unroll") for (int m = 0; m < 4; ++m) _Pragma("unroll") for (int n = 0; n < 2; ++n) \
        asm volatile("s_nop 1\n\tv_mfma_scale_f32_16x16x128_f8f6f4 %0, %1, %2, %0, %3, %3 op_sel_hi:[0,0,0]" : "+v"(acc[ai][bj][m][n]) : "v"(Bt##8[n]), "v"(At##8[m]), "v"(one_scale)); } \
        else { _Pragma("unroll") for (int m = 0; m < 4; ++m) _Pragma("unroll") for (int n = 0; n < 2; ++n) _Pragma("unroll") for (int k = 0; k < 2; ++k) \
        acc[ai][bj][m][n] = __builtin_amdgcn_mfma_f32_16x16x32_bf16(Bt[n][k], At[m][k], acc[ai][bj][m][n], 0, 0, 0); } __builtin_amdgcn_s_setprio(0); } while (0)
#define PG8_WAIT_V(n) asm volatile("s_waitcnt vmcnt(" #n ")" ::: "memory")
#define PG8_WAIT_L(n) asm volatile("s_waitcnt lgkmcnt(" #n ")" ::: "memory")
#define PG8_BAR __builtin_amdgcn_s_barrier()
#define PG8_SCHED __builtin_amdgcn_sched_barrier(0)
#define PG8_AOFF(vo, u) do { _Pragma("unroll") for (int h_ = 0; h_ < 2; ++h_) _Pragma("unroll") for (int i_ = 0; i_ < 2; ++i_) { \
        if constexpr (Pol::GATHER) vo[h_][i_] = (unsigned)(S.gather(u, h_ * HALF + RA[i_]) * KB + CA[i_] * 2); \
        else vo[h_][i_] = (unsigned)((h_ * HALF + RA[i_]) * KB + CA[i_] * 2); } } while (0)
    Unit cur, nxt; int ui = 0;
    if (!S.next(0, cur)) return;
    f32x4 acc[2][2][4][2];
#pragma unroll
    for (int a = 0; a < 2; ++a)
#pragma unroll
        for (int b = 0; b < 2; ++b)
#pragma unroll
            for (int m = 0; m < 4; ++m)
#pragma unroll
                for (int n = 0; n < 2; ++n) acc[a][b][m][n] = (f32x4){0.f, 0.f, 0.f, 0.f};
    bf16x8 At[4][2], B0[2][2], B1[2][2]; v8i At8[4], B08[2], B18[2];
    int one_scale = 0x7f7f7f7f; asm volatile("" : "+v"(one_scale));
    unsigned voC[2][2], voN[2][2];
    PG8_AOFF(voC, cur);
#pragma unroll
    for (int h_ = 0; h_ < 2; ++h_)
#pragma unroll
        for (int i_ = 0; i_ < 2; ++i_) voN[h_][i_] = voC[h_][i_];
    const char* cA = S.a_base(cur); const char* cB = S.b_base(cur);
    PG8_STAGE_B(PG8_SB(0, 0), cB); PG8_STAGE_B(PG8_SB(0, 1), cB + hstep); PG8_GLDS(PG8_SA(0, 0), cA, voC[0][0], voC[0][1]); PG8_GLDS(PG8_SA(0, 1), cA, voC[1][0], voC[1][1]);
    if (wr == 1) PG8_BAR;
    PG8_WAIT_V(2); PG8_BAR;
    PG8_STAGE_B(PG8_SB(1, 0), cB + kstep); PG8_GLDS(PG8_SA(1, 0), cA + kstep, voC[0][0], voC[0][1]); PG8_STAGE_B(PG8_SB(1, 1), cB + hstep + kstep);
    PG8_WAIT_V(6); PG8_BAR;
    for (;;) {
        const bool has_next = S.next(ui + 1, nxt);
        const char* nA = cA; const char* nB = cB;
        if (has_next) { nA = S.a_base(nxt); nB = S.b_base(nxt); if constexpr (Pol::GATHER) { PG8_AOFF(voN, nxt); } }
        else { if constexpr (Pol::GATHER) {
#pragma unroll
            for (int h_ = 0; h_ < 2; ++h_)
#pragma unroll
                for (int i_ = 0; i_ < 2; ++i_) voN[h_][i_] = voC[h_][i_]; } }
#pragma unroll 1
        for (int t = 0; t < nt; t += 2) {
            const bool last = (t == nt - 2);
            const char* a1 = cA + (size_t)(t + 1) * kstep;
            const char* a2 = last ? nA : cA + (size_t)(t + 2) * kstep; const char* b2 = last ? nB : cB + (size_t)(t + 2) * kstep;
            const char* a3 = a2 + kstep; const char* b3 = b2 + kstep;
            unsigned o00, o01, o10, o11;
            if constexpr (Pol::GATHER) { o00 = last ? voN[0][0] : voC[0][0]; o01 = last ? voN[0][1] : voC[0][1]; o10 = last ? voN[1][0] : voC[1][0]; o11 = last ? voN[1][1] : voC[1][1]; }
            else { o00 = voC[0][0]; o01 = voC[0][1]; o10 = voC[1][0]; o11 = voC[1][1]; }
            PG8_LDB(B0, 0, 0); PG8_LDB(B1, 0, 1); PG8_SCHED; PG8_LDA(At, 0, 0); PG8_GLDS(PG8_SA(1, 1), a1, voC[1][0], voC[1][1]);
            PG8_WAIT_V(8); PG8_WAIT_L(0); PG8_BAR; PG8_MMA(0, 0, At, B0); PG8_MMA(0, 1, At, B1); PG8_BAR; PG8_SCHED;
            PG8_LDA(At, 0, 1); PG8_STAGE_B(PG8_SB(0, 0), b2); PG8_STAGE_B(PG8_SB(0, 1), b2 + hstep); PG8_GLDS(PG8_SA(0, 0), a2, o00, o01);
            PG8_WAIT_V(8); PG8_WAIT_L(0); PG8_BAR; PG8_MMA(1, 0, At, B0); PG8_MMA(1, 1, At, B1); PG8_BAR; PG8_SCHED;
            PG8_LDB(B0, 1, 0); PG8_LDB(B1, 1, 1); PG8_SCHED; PG8_LDA(At, 1, 0); PG8_GLDS(PG8_SA(0, 1), a2, o10, o11);
            PG8_WAIT_V(8); PG8_WAIT_L(0); PG8_BAR; PG8_MMA(0, 0, At, B0); PG8_MMA(0, 1, At, B1); PG8_BAR; PG8_SCHED;
            PG8_LDA(At, 1, 1); PG8_STAGE_B(PG8_SB(1, 0), b3); PG8_STAGE_B(PG8_SB(1, 1), b3 + hstep); PG8_GLDS(PG8_SA(1, 0), a3, o00, o01);
            PG8_WAIT_V(8); PG8_WAIT_L(0); PG8_BAR; PG8_MMA(1, 0, At, B0); PG8_MMA(1, 1, At, B1); PG8_BAR; PG8_SCHED;
        }
        if constexpr (FP8) asm volatile("s_nop 15\n\ts_nop 15" ::: "memory");
        if constexpr (ALIGN_EPI) { if (wr == 0) PG8_BAR; }
        E(acc, cur, wr, wc, fr, fq);
        if (!has_next) break;
#pragma unroll
        for (int a = 0; a < 2; ++a)
#pragma unroll
            for (int b = 0; b < 2; ++b)
#pragma unroll
                for (int m = 0; m < 4; ++m)
#pragma unroll
                    for (int n = 0; n < 2; ++n) acc[a][b][m][n] = (f32x4){0.f, 0.f, 0.f, 0.f};
        cur = nxt; cA = nA; cB = nB; ++ui;
#pragma unroll
        for (int h_ = 0; h_ < 2; ++h_)
#pragma unroll
            for (int i_ = 0; i_ < 2; ++i_) voC[h_][i_] = voN[h_][i_];
        if constexpr (ALIGN_EPI) { if (wr == 1) PG8_BAR; }
    }
    PG8_WAIT_V(0);
    if constexpr (!ALIGN_EPI) { if (wr == 0) PG8_BAR; }
    PG8_BAR;
#undef PG8_SA
#undef PG8_SB
#undef PG8_GLDS
#undef PG8_STAGE_B
#undef PG8_LDA
#undef PG8_LDB
#undef PG8_MMA
#undef PG8_WAIT_V
#undef PG8_WAIT_L
#undef PG8_BAR
#undef PG8_SCHED
#undef PG8_AOFF
}
}

constexpr size_t MiB = 1u << 20;
constexpr size_t WS_CTL = 0, CTL_ZERO_BYTES = 1 * MiB;
constexpr size_t WS_RWG = 1 * MiB;
constexpr size_t WS_KSUM = 1 * MiB + 512 * 1024;
constexpr size_t WS_ETOK = 2 * MiB;
constexpr size_t WS_EWT = 6 * MiB;
constexpr size_t WS_TOKSLOT = 10 * MiB;
constexpr size_t WS_XRMS = 13 * MiB;
constexpr size_t WS_COS = 11 * MiB;
constexpr size_t WS_WCO = 16 * MiB, WS_WAO = 18 * MiB, WS_WOUT = 20 * MiB;
constexpr size_t WS_WIN = 24 * MiB;
constexpr size_t WS_WGU = 40 * MiB;
constexpr size_t WS_WD = 168 * MiB;
constexpr size_t WS_XN = 232 * MiB;
constexpr size_t WS_CB = 296 * MiB;
constexpr size_t WS_U = 360 * MiB;
constexpr size_t WS_Q = 424 * MiB;
constexpr size_t WS_K = 488 * MiB;
constexpr size_t WS_V = 552 * MiB;
constexpr size_t WS_GC = 616 * MiB;
constexpr size_t WS_GA = 680 * MiB;
constexpr size_t WS_PO = 744 * MiB;
constexpr size_t WS_PML = 936 * MiB;
constexpr size_t WS_ALIST = 952 * MiB;
constexpr size_t WS_ACT = 296 * MiB;
constexpr size_t WS_Y = 616 * MiB;
constexpr size_t WS_WIN8 = 104 * MiB;
constexpr size_t WS_WAO8 = 112 * MiB;
constexpr size_t WS_XN8 = 744 * MiB;
constexpr size_t WS_ERSTD = 986 * MiB;
constexpr size_t WS_SIDE_DUMMY = 990 * MiB;
constexpr size_t WS_END = 992 * MiB;
constexpr int CW_BAR = 4096;
constexpr int CW_ECNT = 8192;
constexpr int CW_ACNT = 16384;
constexpr int CW_DBG = 20000;

constexpr int RING_BYTES = 131072, LDSCTL_OFF = RING_BYTES, MISC_OFF = LDSCTL_OFF + 320, TAB_OFF = LDSCTL_OFF + 512, LDS_BYTES = 147456;

#define GAS __attribute__((address_space(1)))
#define LAS __attribute__((address_space(3)))
typedef unsigned short bf16;
typedef unsigned v4u __attribute__((ext_vector_type(4)));
typedef unsigned v2u __attribute__((ext_vector_type(2)));
typedef float f32x4 __attribute__((ext_vector_type(4)));
typedef float f32x16 __attribute__((ext_vector_type(16)));
typedef GAS unsigned gu32;
#define RLX_AGENT __ATOMIC_RELAXED, __HIP_MEMORY_SCOPE_AGENT
#define LDS_WAIT() asm volatile("s_waitcnt lgkmcnt(0)" ::: "memory")
#define VM_WAIT() asm volatile("s_waitcnt vmcnt(0)" ::: "memory")
using pg8::cvt_pk_bf16; using pg8::bf_lo; using pg8::bf_hi;

#define XB_TMO      128
#define XB_XCNT(j)  (256  + 64 * (j))
#define XB_XSUB(j)  (1280 + 64 * (j))
#define XB_XGEN(j)  (2304 + 64 * (j))
#define XB_TOP      3328
#define XB_TOPGEN   3392
#define XCD_BAR_WORDS 3456
#define XB_SPIN_CAP (1u << 18)
__device__ __forceinline__ unsigned xb_ld(unsigned* p)              { return __hip_atomic_load(p, __ATOMIC_RELAXED, __HIP_MEMORY_SCOPE_AGENT); }
__device__ __forceinline__ unsigned xb_add(unsigned* p, unsigned v) { return __hip_atomic_fetch_add(p, v, __ATOMIC_RELAXED, __HIP_MEMORY_SCOPE_AGENT); }
__device__ __forceinline__ unsigned xb_xcc_id() { return (unsigned)__builtin_amdgcn_s_getreg((3 << 11) | 20) & 0xFu; }
#define XB_SPIN(cond, bar) do { unsigned _sp = 0; while (cond) { __builtin_amdgcn_s_sleep(1); \
    if ((++_sp & 255u) == 0u) { if (xb_ld(&(bar)[XB_TMO])) break; if (_sp > XB_SPIN_CAP) { atomicAdd(&(bar)[XB_TMO], 1u); break; } } } } while (0)
struct XcdBarrier { unsigned* bar; unsigned x; volatile LAS unsigned* st; };
__device__ __forceinline__ XcdBarrier xcd_barrier_post(unsigned* bar, volatile LAS unsigned* st) {
    XcdBarrier b; b.bar = bar; b.x = xb_xcc_id(); b.st = st;
    if (threadIdx.x == 0) (void)xb_add(&bar[XB_XCNT(b.x)], 1u);
    return b;
}
__device__ __forceinline__ void xcd_barrier_complete(unsigned* bar, unsigned x, unsigned& nloc, unsigned& nx) {
    const unsigned G = gridDim.x * gridDim.y * gridDim.z;
    unsigned sum, cnt, mine, sp = 0u;
    for (;;) {
        sum = 0u; cnt = 0u; mine = 0u;
#pragma unroll
        for (unsigned j = 0; j < 16; ++j) { const unsigned c = xb_ld(&bar[XB_XCNT(j)]); sum += c; cnt += (c > 0u) ? 1u : 0u; mine = (j == x) ? c : mine; }
        if (sum == G) break;
        __builtin_amdgcn_s_sleep(1);
        if ((++sp & 255u) == 0u) { if (xb_ld(&bar[XB_TMO])) break; if (sp > XB_SPIN_CAP) { atomicAdd(&bar[XB_TMO], 1u); break; } }
    }
    nloc = mine > 0u ? mine : 1u; nx = cnt > 0u ? cnt : 1u;
}
__device__ __forceinline__ void xcd_barrier(const XcdBarrier& b) {
    asm volatile("s_waitcnt vmcnt(0)" ::: "memory");
    __syncthreads();
    if (threadIdx.x == 0) {
        unsigned* bar = b.bar;
        __builtin_amdgcn_s_waitcnt(0);
        unsigned nloc = b.st[0], nx = b.st[1];
        if (nloc == 0u) { xcd_barrier_complete(bar, b.x, nloc, nx); b.st[0] = nloc; b.st[1] = nx; }
        const unsigned old = xb_add(&bar[XB_XSUB(b.x)], 1u);
        const unsigned gen = old / nloc;
        if (old + 1u == (gen + 1u) * nloc) {
            __builtin_amdgcn_fence(__ATOMIC_RELEASE, "agent");
            asm volatile("s_waitcnt vmcnt(0)" ::: "memory");
            const unsigned og = xb_add(&bar[XB_TOP], 1u);
            const unsigned tg = og / nx;
            if (og + 1u == (tg + 1u) * nx) xb_add(&bar[XB_TOPGEN], 1u);
            else XB_SPIN(xb_ld(&bar[XB_TOPGEN]) == tg, bar);
            __builtin_amdgcn_fence(__ATOMIC_ACQUIRE, "agent");
            xb_add(&bar[XB_XGEN(b.x)], 1u);
            asm volatile("s_waitcnt vmcnt(0)" ::: "memory");
        } else {
            XB_SPIN(xb_ld(&bar[XB_XGEN(b.x)]) == gen, bar);
            __builtin_amdgcn_fence(__ATOMIC_ACQUIRE, "agent");
            asm volatile("s_waitcnt vmcnt(0)" ::: "memory");
        }
    }
    __syncthreads();
}

struct Frame {
    LAS unsigned char* lds;
    gu32* ctl;
    int tid, lane, wave, vcu, G;
    unsigned char* ws;
};
__device__ __forceinline__ float wave_sum(float v) {
#pragma unroll
    for (int o = 1; o < 64; o <<= 1) v += __shfl_xor(v, o);
    return v;
}

template <int MODE> __device__ __forceinline__ int dst_row(int n) {
    if (MODE == 1) {
        if (n < 1024) return n;
        if (n < 3072) { const int ch = (n - 1024) & 1023; return 1024 + (ch >> 7) * 256 + (n < 2048 ? 0 : 128) + (ch & 127); }
        if (n < 5120) { const int base = n < 4096 ? 3072 : 4096, r = n - base, h = r >> 6, d = r & 63; return base + 64 * h + 2 * (d & 31) + (d >> 5); }
        return n;
    }
    if (MODE == 2) return n < 1024 ? 2 * n : 2 * (n - 1024) + 1;
    if (MODE == 3) { const int ch = n & 1023; return (ch >> 7) * 256 + (n < 1024 ? 0 : 128) + (ch & 127); }
    return n;
}
template <int MODE> __device__ __forceinline__ void p0_transpose_item(const float* W, int K, int N, bf16* WT, const float* g, LAS float* scr, int item, int lane) {
    const int nblk = N / 32, kb = item / nblk, nb = item % nblk, k0 = 64 * kb, n0 = 32 * nb;
#pragma unroll 8
    for (int i = 0; i < 32; ++i) { const int kk = 2 * i + (lane >> 5); float v = W[(size_t)(k0 + kk) * N + n0 + (lane & 31)]; if (g) v *= g[k0 + kk]; scr[kk * 33 + (lane & 31)] = v; }
    LDS_WAIT(); asm volatile("" ::: "memory");
    const int c = lane & 7;
#pragma unroll
    for (int j = 0; j < 4; ++j) { const int n = (lane >> 3) + 8 * j; const LAS float* s = scr + (8 * c) * 33 + n;
        v4u o; o.x = cvt_pk_bf16(s[0 * 33], s[1 * 33]); o.y = cvt_pk_bf16(s[2 * 33], s[3 * 33]); o.z = cvt_pk_bf16(s[4 * 33], s[5 * 33]); o.w = cvt_pk_bf16(s[6 * 33], s[7 * 33]);
        *(GAS v4u*)(WT + (size_t)dst_row<MODE>(n0 + n) * K + k0 + 8 * c) = o; }
    LDS_WAIT(); asm volatile("" ::: "memory");
}

template <int MODE> __device__ __forceinline__ void p0_transpose_task(const float* W, int N, bf16* WT, const float* g, int task, int lane) {
    const int nblk = N / 64, kb = task / nblk, nb = task % nblk, kq = lane >> 4, n4 = lane & 15, k0 = 64 * kb + 16 * kq, n = 64 * nb + 4 * n4;
    const float* src = W + (size_t)k0 * N + n;
    f32x4 v[16];
#pragma unroll
    for (int i = 0; i < 16; ++i) v[i] = __builtin_nontemporal_load((const f32x4*)(src + (size_t)i * N));
    if (g) {
#pragma unroll
        for (int i = 0; i < 16; i += 4) { const f32x4 g4 = *(const f32x4*)(g + k0 + i); v[i] *= g4.x; v[i + 1] *= g4.y; v[i + 2] *= g4.z; v[i + 3] *= g4.w; }
    }
#pragma unroll
    for (int e = 0; e < 4; ++e) { bf16* dst = WT + (size_t)dst_row<MODE>(n + e) * 1024 + k0;
#pragma unroll
        for (int c = 0; c < 2; ++c) { v4u o; o.x = cvt_pk_bf16(v[8 * c][e], v[8 * c + 1][e]); o.y = cvt_pk_bf16(v[8 * c + 2][e], v[8 * c + 3][e]); o.z = cvt_pk_bf16(v[8 * c + 4][e], v[8 * c + 5][e]); o.w = cvt_pk_bf16(v[8 * c + 6][e], v[8 * c + 7][e]);
            *(GAS v4u*)(dst + 8 * c) = o; } }
}
template <int MODE> __device__ __forceinline__ void p0_transpose_task8(const float* W, int N, unsigned char* WT, const float* g, int task, int lane) {
    const int nblk = N / 64, kb = task / nblk, nb = task % nblk, kq = lane >> 4, n4 = lane & 15, k0 = 64 * kb + 16 * kq, n = 64 * nb + 4 * n4;
    const float* src = W + (size_t)k0 * N + n;
    f32x4 v[16];
#pragma unroll
    for (int i = 0; i < 16; ++i) v[i] = __builtin_nontemporal_load((const f32x4*)(src + (size_t)i * N));
#pragma unroll
    for (int i = 0; i < 16; i += 4) { f32x4 g4 = (f32x4){32.0f, 32.0f, 32.0f, 32.0f}; if (g) g4 = *(const f32x4*)(g + k0 + i) * 32.0f; v[i] *= g4.x; v[i + 1] *= g4.y; v[i + 2] *= g4.z; v[i + 3] *= g4.w; }
#pragma unroll
    for (int e = 0; e < 4; ++e) { unsigned char* dst = WT + (size_t)dst_row<MODE>(n + e) * 1024 + k0; v4u o;
#define PK8(j) ({ int w_ = 0; w_ = __builtin_amdgcn_cvt_pk_fp8_f32(v[4 * (j)][e], v[4 * (j) + 1][e], w_, false); w_ = __builtin_amdgcn_cvt_pk_fp8_f32(v[4 * (j) + 2][e], v[4 * (j) + 3][e], w_, true); (unsigned)w_; })
        o.x = PK8(0); o.y = PK8(1); o.z = PK8(2); o.w = PK8(3);
#undef PK8
        *(GAS v4u*)dst = o; }
}

using pg8::Unit; using pg8::bf16_t;
struct DensePol {
    static constexpr bool GATHER = false;
    const void* A; const void* Bt; int nM, nN, G, c; int esz  , split, off0, off1;
    __device__ __forceinline__ bool next(int i, Unit& u) const { u.e = 0; u.rt = 0; int j; if (!pg8::tile_order(i, G, c, nM, nN, u.pm, j)) return false; u.pn = j < split ? j + off0 : j + off1; return true; }
    __device__ __forceinline__ const char* a_base(const Unit& u) const { return (const char*)A + (size_t)u.pm * 256 * 1024 * esz; }
    __device__ __forceinline__ const char* b_base(const Unit& u) const { return (const char*)Bt + (size_t)u.pn * 256 * 1024 * esz; }
    __device__ __forceinline__ int gather(const Unit&, int) const { return 0; }
};
struct MoePol1 {
    static constexpr bool GATHER = true;
    const void* A; const void* Bt; const int* etok; const LAS int* tab; const LAS int* ul; int nul;
    __device__ __forceinline__ bool next(int i, Unit& u) const { if (i >= nul) return false; const LAS int* p = ul + 4 * i; u.pm = p[0]; u.pn = p[1]; u.e = p[2]; u.rt = p[3]; return true; }
    __device__ __forceinline__ const char* a_base(const Unit&) const { return (const char*)A; }
    __device__ __forceinline__ const char* b_base(const Unit& u) const { return (const char*)Bt + ((size_t)u.e * 2048 + (size_t)u.pn * 256) * 1024; }
    __device__ __forceinline__ int gather(const Unit& u, int r) const { const int pos = u.rt * 256 + r, last = tab[u.e] - 1; return etok[u.e * 32768 + (pos < last ? pos : last)]; }
};
struct MoePol2 {
    static constexpr bool GATHER = false;
    const void* A; const void* Bt; const LAS int* ul; int nul;
    __device__ __forceinline__ bool next(int i, Unit& u) const { const int k = i; if (k >= nul) return false; const LAS int* p = ul + 4 * k; u.pm = p[0]; u.pn = p[1]; u.e = p[2]; u.rt = p[3]; return true; }
    __device__ __forceinline__ const char* a_base(const Unit& u) const { return (const char*)A + (size_t)u.pm * 256 * 1024; }
    __device__ __forceinline__ const char* b_base(const Unit& u) const { return (const char*)Bt + ((size_t)u.e * 1024 + (size_t)u.pn * 256) * 1024; }
    __device__ __forceinline__ int gather(const Unit&, int) const { return 0; }
};

__device__ __forceinline__ int moe_unit_list(LAS int* ul, const LAS int* tab, int ncol, int G, int c, int tid) {
    const int T = tab[65], nun = T * ncol; const int nul = (c < nun) ? (nun - 1 - c) / G + 1 : 0;
    if (tid < nul && tid < 64) { int g, pn; pg8::tile_order(tid, G, c, T, ncol, g, pn); int e = 0;
        for (int k = 1; k < 32; ++k) e += (tab[32 + k] <= g) ? 1 : 0;
        ul[4 * tid + 0] = g; ul[4 * tid + 1] = pn; ul[4 * tid + 2] = e; ul[4 * tid + 3] = g - tab[32 + e]; }
    return nul < 64 ? nul : 64;
}

typedef pg8::f32x4 (AccT)[2][2][4][2];
__device__ __forceinline__ float sigmoidf_(float x) { return __builtin_amdgcn_rcpf(1.0f + __builtin_amdgcn_exp2f(x * -1.4426950408889634f)); }

__device__ __forceinline__ float row16_sum(float s) {
#define R16_DPP(ctrl) __builtin_bit_cast(float, __builtin_amdgcn_update_dpp(0, __builtin_bit_cast(int, s), ctrl, 0xF, 0xF, true))
    s += R16_DPP(0xB1); s += R16_DPP(0x4E); s += R16_DPP(0x141); s += R16_DPP(0x140);
#undef R16_DPP
    return s;
}
__device__ __forceinline__ size_t hm_idx(int row, int col) { return ((size_t)((row >> 14) * 16 + (col >> 6)) * SEQ + (size_t)(row & (SEQ - 1))) * 64 + (col & 63); }
struct EpiInProj {
    static constexpr bool PERM = true;
    bf16_t *CB, *U, *Q, *Kb, *V, *GC, *GA; const unsigned* ropeT; float* ksum; float asc;
    __device__ __forceinline__ void operator()(const AccT& acc, const Unit& u, int wr, int wc, int fr, int fq) const {
        using pg8::u32x4; using pg8::u32x2; using pg8::f32x4;
        const int pn = u.pn, row0_ = u.pm * 256 + wr * 64 + fr, cl = wc * 32 + 8 * fq;
        int row0 = row0_;
        if (pn < 4 || (pn >= 20 && pn < 24)) {
            asm volatile("" : "+v"(row0));
            bf16_t* base = (pn < 4) ? CB : V; const int col0 = (pn & 3) * 256 + cl;
#pragma unroll
            for (int ai = 0; ai < 2; ++ai)
#pragma unroll
                for (int m = 0; m < 4; ++m) { const int row = row0 + ai * 128 + m * 16;
#pragma unroll
                    for (int bj = 0; bj < 2; ++bj) { const f32x4 v0 = acc[ai][bj][m][0] * asc, v1 = acc[ai][bj][m][1] * asc; u32x4 w;
                        w.x = cvt_pk_bf16(v0[0], v0[1]); w.y = cvt_pk_bf16(v0[2], v0[3]); w.z = cvt_pk_bf16(v1[0], v1[1]); w.w = cvt_pk_bf16(v1[2], v1[3]);
                        bf16_t* dst = (pn < 4) ? base + (size_t)row * 1024 + col0 + bj * 128 : base + hm_idx(row, col0 + bj * 128);
                        *(u32x4*)dst = w; } }
        } else if (pn >= 24) {
            asm volatile("" : "+v"(row0));
            bf16_t* base = (pn < 28) ? GC : GA; const int col0 = (pn & 3) * 256 + cl;
#pragma unroll
            for (int ai = 0; ai < 2; ++ai)
#pragma unroll
                for (int m = 0; m < 4; ++m) { unsigned char* rowp = (unsigned char*)base + (size_t)(row0 + ai * 128 + m * 16) * 1024 + col0;
#pragma unroll
                    for (int bj = 0; bj < 2; ++bj) { const f32x4 v0 = acc[ai][bj][m][0] * asc, v1 = acc[ai][bj][m][1] * asc; unsigned w0 = 0u, w1 = 0u;
#define G8(x) __builtin_rintf(sigmoidf_(x) * 255.0f)
                        w0 = __builtin_amdgcn_cvt_pk_u8_f32(G8(v0[0]), 0, w0); w0 = __builtin_amdgcn_cvt_pk_u8_f32(G8(v0[1]), 1, w0); w0 = __builtin_amdgcn_cvt_pk_u8_f32(G8(v0[2]), 2, w0); w0 = __builtin_amdgcn_cvt_pk_u8_f32(G8(v0[3]), 3, w0);
                        w1 = __builtin_amdgcn_cvt_pk_u8_f32(G8(v1[0]), 0, w1); w1 = __builtin_amdgcn_cvt_pk_u8_f32(G8(v1[1]), 1, w1); w1 = __builtin_amdgcn_cvt_pk_u8_f32(G8(v1[2]), 2, w1); w1 = __builtin_amdgcn_cvt_pk_u8_f32(G8(v1[3]), 3, w1);
#undef G8
                        pg8::u32x2 w; w.x = w0; w.y = w1; *(pg8::u32x2*)(rowp + bj * 128) = w; } }
        } else if (pn < 12) {
            asm volatile("" : "+v"(row0));
            const int ch0 = (pn - 4) * 128 + cl;
#pragma unroll
            for (int ai = 0; ai < 2; ++ai)
#pragma unroll
                for (int m = 0; m < 4; ++m) { bf16_t* rowp = U + (size_t)(row0 + ai * 128 + m * 16) * 1024 + ch0;
                    const f32x4 a0 = acc[ai][0][m][0], a1 = acc[ai][0][m][1], b0 = acc[ai][1][m][0], b1 = acc[ai][1][m][1]; u32x4 w;
                    w.x = cvt_pk_bf16(a0[0] * b0[0], a0[1] * b0[1]); w.y = cvt_pk_bf16(a0[2] * b0[2], a0[3] * b0[3]); w.z = cvt_pk_bf16(a1[0] * b1[0], a1[1] * b1[1]); w.w = cvt_pk_bf16(a1[2] * b1[2], a1[3] * b1[3]);
                    *(u32x4*)rowp = w; }
        } else {
            asm volatile("" : "+v"(row0));
            const bool isq = pn < 16; bf16_t* base = isq ? Q : Kb; const int col0 = (pn & 3) * 256 + cl; const float sc = (isq ? C2 : 1.0f) * asc;
            const int i0 = 16 * (wc & 1) + 4 * fq;
            float ks[2][8];
#pragma unroll
            for (int bj = 0; bj < 2; ++bj)
#pragma unroll
                for (int e = 0; e < 8; ++e) ks[bj][e] = 0.f;
            u32x4 tw[2][4];
#pragma unroll
            for (int ai = 0; ai < 2; ++ai)
#pragma unroll
                for (int m = 0; m < 4; ++m) { const int pos = (row0 + ai * 128 + m * 16) & (SEQ - 1); tw[ai][m] = *(const u32x4*)(ropeT + pos * 32 + i0); }
            asm volatile("" ::: "memory");
#pragma unroll
            for (int ai = 0; ai < 2; ++ai) {
#pragma unroll
                for (int m = 0; m < 4; ++m) {
                    typedef _Float16 h2_t __attribute__((ext_vector_type(2)));
                    float cs[4], sn[4];
#pragma unroll
                    for (int j = 0; j < 4; ++j) { const u32x4 t4 = tw[ai][m]; const unsigned ej = (j == 0) ? t4.x : (j == 1) ? t4.y : (j == 2) ? t4.z : t4.w;
                        const h2_t hh = __builtin_bit_cast(h2_t, ej); cs[j] = (float)hh.x * sc; sn[j] = (float)hh.y * sc; }
#pragma unroll
                    for (int bj = 0; bj < 2; ++bj) { const int row = row0 + ai * 128 + m * 16;
                        bf16_t* rowp = base + hm_idx(row, col0 + bj * 128);
                        const f32x4 v0 = acc[ai][bj][m][0], v1 = acc[ai][bj][m][1]; float o[8];
                        o[0] = v0[0] * cs[0] - v0[1] * sn[0]; o[1] = v0[1] * cs[0] + v0[0] * sn[0];
                        o[2] = v0[2] * cs[1] - v0[3] * sn[1]; o[3] = v0[3] * cs[1] + v0[2] * sn[1];
                        o[4] = v1[0] * cs[2] - v1[1] * sn[2]; o[5] = v1[1] * cs[2] + v1[0] * sn[2];
                        o[6] = v1[2] * cs[3] - v1[3] * sn[3]; o[7] = v1[3] * cs[3] + v1[2] * sn[3];
#pragma unroll
                        for (int e = 0; e < 8; ++e) { ks[bj][e] += o[e]; asm volatile("" : "+v"(ks[bj][e])); }
                        u32x4 w; w.x = cvt_pk_bf16(o[0], o[1]); w.y = cvt_pk_bf16(o[2], o[3]); w.z = cvt_pk_bf16(o[4], o[5]); w.w = cvt_pk_bf16(o[6], o[7]);
                        *(u32x4*)(rowp) = w; } }
                asm volatile("" ::: "memory");
            }
            if (!isq) {
#pragma unroll
                for (int bj = 0; bj < 2; ++bj)
#pragma unroll
                    for (int e = 0; e < 8; ++e) { float s = row16_sum(ks[bj][e]);
                        if (fr == 0) atomicAdd(ksum + (size_t)u.pm * 1024 + col0 + bj * 128 + e, s); }
            }
        }
    }
};
template <int MODE> struct EpiGate {
    static constexpr bool PERM = true;
    const bf16_t* G; const bf16_t* T1in; bf16_t* O; float asc;
    __device__ __forceinline__ void operator()(const AccT& acc, const Unit& u, int wr, int wc, int fr, int fq) const {
        using pg8::u32x4; using pg8::f32x4;
        asm volatile("" : "+v"(fr), "+v"(fq));
        const int row0 = u.pm * 256 + wr * 64 + fr, col0 = u.pn * 256 + wc * 32 + 8 * fq;
#pragma unroll
        for (int ai = 0; ai < 2; ++ai) {
            pg8::u32x2 gg[4][2]; u32x4 tt[4][2];
#pragma unroll
            for (int m = 0; m < 4; ++m)
#pragma unroll
                for (int bj = 0; bj < 2; ++bj) { const size_t off = (size_t)(row0 + ai * 128 + m * 16) * 1024 + col0 + bj * 128;
                    gg[m][bj] = *(const pg8::u32x2*)((const unsigned char*)G + off); if (MODE == 1) tt[m][bj] = *(const u32x4*)(T1in + off); }
            asm volatile("" ::: "memory");
#pragma unroll
            for (int m = 0; m < 4; ++m)
#pragma unroll
                for (int bj = 0; bj < 2; ++bj) { const size_t off = (size_t)(row0 + ai * 128 + m * 16) * 1024 + col0 + bj * 128;
                    const float gsc = asc * (1.0f / 255.0f); const f32x4 v0 = acc[ai][bj][m][0] * gsc, v1 = acc[ai][bj][m][1] * gsc; const pg8::u32x2 g = gg[m][bj]; float o[8];
                    o[0] = (float)(g.x & 0xffu) * v0[0]; o[1] = (float)((g.x >> 8) & 0xffu) * v0[1]; o[2] = (float)((g.x >> 16) & 0xffu) * v0[2]; o[3] = (float)(g.x >> 24) * v0[3];
                    o[4] = (float)(g.y & 0xffu) * v1[0]; o[5] = (float)((g.y >> 8) & 0xffu) * v1[1]; o[6] = (float)((g.y >> 16) & 0xffu) * v1[2]; o[7] = (float)(g.y >> 24) * v1[3];
                    if (MODE == 1) { const u32x4 t = tt[m][bj];
                        o[0] += bf_lo(t.x); o[1] += bf_hi(t.x); o[2] += bf_lo(t.y); o[3] += bf_hi(t.y); o[4] += bf_lo(t.z); o[5] += bf_hi(t.z); o[6] += bf_lo(t.w); o[7] += bf_hi(t.w); }
                    u32x4 w; w.x = cvt_pk_bf16(o[0], o[1]); w.y = cvt_pk_bf16(o[2], o[3]); w.z = cvt_pk_bf16(o[4], o[5]); w.w = cvt_pk_bf16(o[6], o[7]);
                    *(u32x4*)(O + off) = w; }
            asm volatile("" ::: "memory");
        }
    }
};
struct EpiResid {
    static constexpr bool PERM = false;
    const bf16_t* XNb; const float* xrms; bf16_t* H;
    __device__ __forceinline__ void operator()(const AccT& acc, const Unit& u, int wr, int wc, int fr, int fq) const {
        using pg8::f32x4; using pg8::u32x2;
        asm volatile("" : "+v"(fr), "+v"(fq));
        const int row0 = u.pm * 256 + wr * 64 + fr, col0 = u.pn * 256 + wc * 32 + 4 * fq;
#pragma unroll
        for (int ai = 0; ai < 2; ++ai) {
            u32x2 xv[4][2][2]; float rs[4];
#pragma unroll
            for (int m = 0; m < 4; ++m) { rs[m] = xrms[row0 + ai * 128 + m * 16];
#pragma unroll
                for (int bj = 0; bj < 2; ++bj)
#pragma unroll
                    for (int n = 0; n < 2; ++n) xv[m][bj][n] = *(const u32x2*)(XNb + (size_t)(row0 + ai * 128 + m * 16) * 1024 + col0 + bj * 128 + n * 16); }
            asm volatile("" ::: "memory");
#pragma unroll
            for (int m = 0; m < 4; ++m)
#pragma unroll
                for (int bj = 0; bj < 2; ++bj)
#pragma unroll
                    for (int n = 0; n < 2; ++n) { const u32x2 xw = xv[m][bj][n]; const f32x4 a = acc[ai][bj][m][n]; const float r = rs[m];
                        u32x2 w; w.x = cvt_pk_bf16(bf_lo(xw.x) * r + a[0], bf_hi(xw.x) * r + a[1]); w.y = cvt_pk_bf16(bf_lo(xw.y) * r + a[2], bf_hi(xw.y) * r + a[3]);
                        *(u32x2*)(H + (size_t)(row0 + ai * 128 + m * 16) * 1024 + col0 + bj * 128 + n * 16) = w; }
            asm volatile("" ::: "memory");
        }
    }
};
struct EpiSwiglu {
    static constexpr bool PERM = true;
    const float* bgu; const float* erstd; unsigned char* ACT;
    __device__ __forceinline__ float act1(float g, float up) const { g = fminf(g, 7.0f); up = fminf(fmaxf(up, -7.0f), 7.0f); return (up + 1.0f) * (g * sigmoidf_(1.702f * g)); }
    __device__ __forceinline__ void operator()(const AccT& acc, const Unit& u, int wr, int wc, int fr, int fq) const {
        using pg8::u32x2; using pg8::f32x4;
        asm volatile("" : "+v"(fr), "+v"(fq));
        const int row0 = u.pm * 256 + wr * 64 + fr, ch0 = u.pn * 128 + wc * 32 + 8 * fq;
        const float* bg = bgu + (size_t)u.e * 2048; const float* rsp = erstd + (size_t)u.e * 32768 + u.rt * 256 + wr * 64 + fr;
        f32x4 bgv[2], buv[2];
#pragma unroll
        for (int n = 0; n < 2; ++n) { bgv[n] = *(const f32x4*)(bg + ch0 + 4 * n); buv[n] = *(const f32x4*)(bg + 1024 + ch0 + 4 * n); }
        float rss[2][4];
#pragma unroll
        for (int ai = 0; ai < 2; ++ai)
#pragma unroll
            for (int m = 0; m < 4; ++m) rss[ai][m] = rsp[ai * 128 + m * 16];
        asm volatile("" ::: "memory");
#pragma unroll
        for (int ai = 0; ai < 2; ++ai)
#pragma unroll
            for (int m = 0; m < 4; ++m) { unsigned char* rowp = ACT + (size_t)(row0 + ai * 128 + m * 16) * 1024 + ch0; const float rs = rss[ai][m] * (1.0f / 32.0f);
                float a8[8];
#pragma unroll
                for (int n = 0; n < 2; ++n) { const f32x4 g4 = acc[ai][0][m][n] * rs + bgv[n], u4 = acc[ai][1][m][n] * rs + buv[n];
                    a8[4 * n + 0] = act1(g4[0], u4[0]); a8[4 * n + 1] = act1(g4[1], u4[1]); a8[4 * n + 2] = act1(g4[2], u4[2]); a8[4 * n + 3] = act1(g4[3], u4[3]); }
                int w0 = 0, w1 = 0;
                w0 = __builtin_amdgcn_cvt_pk_fp8_f32(a8[0], a8[1], w0, false); w0 = __builtin_amdgcn_cvt_pk_fp8_f32(a8[2], a8[3], w0, true);
                w1 = __builtin_amdgcn_cvt_pk_fp8_f32(a8[4], a8[5], w1, false); w1 = __builtin_amdgcn_cvt_pk_fp8_f32(a8[6], a8[7], w1, true);
                u32x2 w; w.x = (unsigned)w0; w.y = (unsigned)w1; *(u32x2*)rowp = w; }
    }
};
struct EpiDown {
    static constexpr bool PERM = true;
    const float* bd; const float* ewt; unsigned char* Y;
    __device__ __forceinline__ void operator()(const AccT& acc, const Unit& u, int wr, int wc, int fr, int fq) const {
        using pg8::u32x4; using pg8::f32x4;
        asm volatile("" : "+v"(fr), "+v"(fq));
        const int rl0 = wr * 64 + fr, col0 = u.pn * 256 + wc * 32 + 8 * fq;
        const float* b = bd + (size_t)u.e * 1024 + col0; const float* wp = ewt + (size_t)u.e * 32768 + u.rt * 256 + rl0;
        f32x4 bv[2][2]; float wts[2][4];
#pragma unroll
        for (int bj = 0; bj < 2; ++bj)
#pragma unroll
            for (int n = 0; n < 2; ++n) bv[bj][n] = *(const f32x4*)(b + bj * 128 + 4 * n);
#pragma unroll
        for (int ai = 0; ai < 2; ++ai)
#pragma unroll
            for (int m = 0; m < 4; ++m) wts[ai][m] = wp[ai * 128 + m * 16];
        asm volatile("" ::: "memory");
#pragma unroll
        for (int ai = 0; ai < 2; ++ai)
#pragma unroll
            for (int mp = 0; mp < 2; ++mp) {
                const int msel = 2 * mp + (fq & 1);
                unsigned char* rowp = Y + (size_t)(u.pm * 256 + rl0 + ai * 128 + msel * 16) * 1024 + (col0 - 8 * fq) + (fq >> 1) * 16;
#pragma unroll
                for (int bj = 0; bj < 2; ++bj) { pg8::u32x2 w2[2];
#pragma unroll
                    for (int q = 0; q < 2; ++q) { const int m = 2 * mp + q; const float wt = wts[ai][m] * 16.0f;
                        const f32x4 v0 = (acc[ai][bj][m][0] * (1.0f / 32.0f) + bv[bj][0]) * wt, v1 = (acc[ai][bj][m][1] * (1.0f / 32.0f) + bv[bj][1]) * wt;
                        int w0 = 0, w1 = 0; w0 = __builtin_amdgcn_cvt_pk_fp8_f32(v0[0], v0[1], w0, false); w0 = __builtin_amdgcn_cvt_pk_fp8_f32(v0[2], v0[3], w0, true);
                        w1 = __builtin_amdgcn_cvt_pk_fp8_f32(v1[0], v1[1], w1, false); w1 = __builtin_amdgcn_cvt_pk_fp8_f32(v1[2], v1[3], w1, true);
                        w2[q].x = (unsigned)w0; w2[q].y = (unsigned)w1; }
                    const auto rx = __builtin_amdgcn_permlane16_swap(w2[0].x, w2[1].x, false, false), ry = __builtin_amdgcn_permlane16_swap(w2[0].y, w2[1].y, false, false);
                    u32x4 o; o.x = rx[0]; o.y = ry[0]; o.z = rx[1]; o.w = ry[1];
                    *(u32x4*)(rowp + bj * 128) = o; } }
    }
};

typedef short bf16x8_t __attribute__((ext_vector_type(8)));
typedef short s16x4_t __attribute__((ext_vector_type(4)));
typedef short v4i16_t __attribute__((ext_vector_type(4)));
__device__ __forceinline__ int crow(int r, int hi) { return (r & 3) + 8 * (r >> 2) + 4 * hi; }
__device__ __forceinline__ s16x4_t vtr(const LAS unsigned char* p) { return __builtin_bit_cast(s16x4_t, __builtin_amdgcn_ds_read_tr16_b64_v4i16((LAS v4i16_t*)p)); }
constexpr int ATT_K = 0, ATT_V = 32768, ATT_Q = 65536, ATT_STG = 98304;
constexpr int UMETA_OFF = LDSCTL_OFF + 1024, WSC_OFF = LDSCTL_OFF + 2048;
constexpr int ALIST_BH = 256 * 2016;
__device__ __forceinline__ int alist_off(int j) { return 256 * (63 * j - (j * (j - 1)) / 2); }
__device__ __forceinline__ void glds16(const void* gsrc, unsigned lds_dst) { unsigned keep;
    asm volatile("s_mov_b32 %0, m0\n\ts_mov_b32 m0, %2\n\ts_nop 0\n\tglobal_load_lds_dwordx4 %1, off\n\ts_mov_b32 m0, %0" : "=&s"(keep) : "v"(gsrc), "s"(lds_dst) : "memory"); }
__device__ __forceinline__ void glds16_nt(const void* gsrc, unsigned lds_dst) { unsigned keep;
    asm volatile("s_mov_b32 %0, m0\n\ts_mov_b32 m0, %2\n\ts_nop 0\n\tglobal_load_lds_dwordx4 %1, off nt\n\ts_mov_b32 m0, %0" : "=&s"(keep) : "v"(gsrc), "s"(lds_dst) : "memory"); }
#define ATT_RFL(x) ((unsigned)__builtin_amdgcn_readfirstlane((int)(x)))
__device__ __forceinline__ void attn_dma_k(unsigned ldsb, const bf16* Kb, size_t rowbase, int h, int wave, int lane) {
#pragma unroll
    for (int i = 0; i < 4; ++i) glds16(Kb + (rowbase + (size_t)(i * 64 + lane)) * 64 + wave * 8, ATT_RFL(ldsb + ATT_K + wave * 4096 + i * 1024));
}
__device__ __forceinline__ void attn_dma_v(unsigned ldsb, const bf16* Vb, size_t rowbase, int h, int wave, int lane) {
#pragma unroll
    for (int i = 0; i < 4; ++i) { const int vi = wave * 4 + i, dh = vi >> 4, kg = vi & 15;
        glds16(Vb + (rowbase + (size_t)(kg * 16 + (lane >> 2))) * 64 + dh * 32 + (lane & 3) * 8, ATT_RFL(ldsb + ATT_V + dh * 16384 + kg * 1024)); }
}
__device__ __forceinline__ void attn_dma_q(unsigned ldsb, const bf16* qrowp, int wave, int lane) {
#pragma unroll
    for (int i = 0; i < 4; ++i) glds16(qrowp + (2 * i + (lane >> 5)) * 8, ATT_RFL(ldsb + ATT_Q + wave * 4096 + i * 1024));
}
__device__ __forceinline__ float max3f(float a, float b, float c) { float r; asm("v_max3_f32 %0, %1, %2, %3" : "=v"(r) : "v"(a), "v"(b), "v"(c)); return r; }
__device__ __forceinline__ float max2f(float a, float b) { float r; asm("v_max_f32_e32 %0, %1, %2" : "=v"(r) : "v"(a), "v"(b)); return r; }
__device__ __forceinline__ float fsub_s(float a, float b) { float r; asm("v_sub_f32_e32 %0, %1, %2" : "=v"(r) : "v"(a), "v"(b)); return r; }
__device__ __forceinline__ float rowmax32(const f32x16& p0, const f32x16& p1) {
    float a = max3f(p0[0], p0[1], p1[0]), b = max3f(p0[2], p0[3], p1[1]); a = max3f(a, p1[2], p1[3]);
#pragma unroll
    for (int r = 4; r < 16; r += 4) { a = max3f(a, p0[r], p0[r + 1]); b = max3f(b, p0[r + 2], p0[r + 3]); a = max3f(a, p1[r], p1[r + 1]); b = max3f(b, p1[r + 2], p1[r + 3]); }
    const float m = max2f(a, b);
    auto rr = __builtin_amdgcn_permlane32_swap(__float_as_uint(m), __float_as_uint(m), false, false);
    return max2f(__uint_as_float(rr[0]), __uint_as_float(rr[1]));
}
__device__ __forceinline__ void cmask(f32x16& p0, f32x16& p1, int jb, int qrel, int hi) {
    const int kb = 64 * jb + 4 * hi;
#pragma unroll
    for (int r = 0; r < 16; ++r) { const int kv = kb + (r & 3) + 8 * (r >> 2); p0[r] = (kv > qrel) ? -INFINITY : p0[r]; p1[r] = (kv + 32 > qrel) ? -INFINITY : p1[r]; }
}

constexpr int SIDE_GU = 32 * 32 * 64, SIDE_D = 32 * 32 * 32, SIDE_TASKS = SIDE_GU + SIDE_D;
struct SideTask { const float* src; unsigned char* dst; int N; };
__device__ __forceinline__ SideTask side_decode(int task, const float* w_gu, const float* w_d, unsigned char* Wgu8, unsigned char* Wd8, int lane) {
    SideTask t;
    if (task < SIDE_GU) { const int e = task >> 11, r = task & 2047, kb = r >> 6, nb = r & 63, n = nb * 32 + (lane & 31); t.N = 2048;
        t.src = w_gu + (size_t)e * 1024 * 2048 + (size_t)(kb * 32) * 2048 + nb * 32; t.dst = Wgu8 + ((size_t)e * 2048 + dst_row<3>(n)) * 1024 + kb * 32 + (lane >> 5) * 16; }
    else { const int t2 = task - SIDE_GU, e = t2 >> 10, r = t2 & 1023, kb = r >> 5, nb = r & 31, n = nb * 32 + (lane & 31); t.N = 1024;
        t.src = w_d + (size_t)e * 1024 * 1024 + (size_t)(kb * 32) * 1024 + nb * 32; t.dst = Wd8 + ((size_t)e * 1024 + n) * 1024 + kb * 32 + (lane >> 5) * 16; }
    return t;
}
#define SIDE_PK8(j) ({ int w_ = 0; w_ = __builtin_amdgcn_cvt_pk_fp8_f32(sv[4 * (j)] * 32.0f, sv[4 * (j) + 1] * 32.0f, w_, false); w_ = __builtin_amdgcn_cvt_pk_fp8_f32(sv[4 * (j) + 2] * 32.0f, sv[4 * (j) + 3] * 32.0f, w_, true); (unsigned)w_; })
__device__ __forceinline__ void side_issue(int task, const float* w_gu, const float* w_d, int lane, float (&sv)[16]) {
    const SideTask t = side_decode(task, w_gu, w_d, nullptr, nullptr, lane);
    const float* src = t.src + (size_t)((lane >> 5) * 16) * t.N + (lane & 31);
#pragma unroll
    for (int i = 0; i < 16; ++i) sv[i] = __builtin_nontemporal_load(src + (size_t)i * t.N);
}
__device__ __forceinline__ void side_finish(int task, unsigned char* Wgu8, unsigned char* Wd8, int lane, const float (&sv)[16]) {
    const SideTask t = side_decode(task, nullptr, nullptr, Wgu8, Wd8, lane);
    v4u o; o.x = SIDE_PK8(0); o.y = SIDE_PK8(1); o.z = SIDE_PK8(2); o.w = SIDE_PK8(3);
    *(GAS v4u*)t.dst = o;
}

__device__ __forceinline__ void side_dma(int task, const float* w_gu, const float* w_d, int lane, unsigned stg_lds) {
    const SideTask t = side_decode(task, w_gu, w_d, nullptr, nullptr, lane);
    const float* ls = t.src + (size_t)(lane >> 3) * t.N + (lane & 7) * 4;
#pragma unroll
    for (int p = 0; p < 4; ++p) glds16_nt(ls + (size_t)(p * 8) * t.N, ATT_RFL(stg_lds + p * 1024));
}
__device__ __forceinline__ void side_consume(int task, bool real, unsigned char* dummy, unsigned char* Wgu8, unsigned char* Wd8, int lane, const LAS unsigned char* stg) {
    const LAS float* lp = (const LAS float*)stg + (lane >> 5) * 512 + (lane & 31);
    float sv[16];
#pragma unroll
    for (int k = 0; k < 16; ++k) sv[k] = lp[(k >> 3) * 256 + (k & 7) * 32];
    const SideTask t = side_decode(task, nullptr, nullptr, Wgu8, Wd8, lane);
    v4u o; o.x = SIDE_PK8(0); o.y = SIDE_PK8(1); o.z = SIDE_PK8(2); o.w = SIDE_PK8(3);
    unsigned char* dst = real ? t.dst : dummy + lane * 16;
    *(GAS v4u*)dst = o;
}

#define ATT_WB(wait) asm volatile("s_waitcnt " wait "\n\ts_barrier" ::: "memory")
template <bool OWN>
__device__ __forceinline__ void attn_phase(Frame& F, const bf16* Qb, const bf16* Kb, const bf16* Vb, bf16* PO, float* PML, const unsigned short* alist, gu32* acnt, bf16* ATTO,
                                           const float* w_gu, const float* w_d, unsigned char* Wgu8, unsigned char* Wd8) {
    const int r32 = F.lane & 31, hi = F.lane >> 5, wave = F.wave;
    LAS int* um = (LAS int*)(F.lds + UMETA_OFF);
    LAS float* wsc = (LAS float*)(F.lds + WSC_OFF + wave * 1024);
    const unsigned ldsb = (unsigned)(unsigned long)F.lds;
    const LAS unsigned char* kp0 = F.lds + ATT_K + hi * 4096 + r32 * 16;
    const LAS unsigned char* vp0 = F.lds + ATT_V + ((F.lane >> 4) & 1) * 32 + (F.lane & 3) * 8 + (4 * hi + ((F.lane & 15) >> 2)) * 64;
    int nul = 0;
    int st_tail = __builtin_amdgcn_readfirstlane(F.vcu * 8 + wave);
    __syncthreads();
    if (!OWN) {
        LAS int* pfx = (LAS int*)(F.lds + ATT_STG);
        int c4[4]; int sum = 0;
#pragma unroll
        for (int i = 0; i < 4; ++i) { c4[i] = ((int)__hip_atomic_load(acnt + F.tid * 4 + i, RLX_AGENT) + 255) >> 8; sum += c4[i]; }
        int inc = sum;
#pragma unroll
        for (int o = 1; o < 64; o <<= 1) { const int v = __shfl_up(inc, o); if (F.lane >= o) inc += v; }
        LAS int* wt = pfx + 2064;
        if (F.lane == 63) wt[wave] = inc;
        __syncthreads();
        int base = 0;
        for (int w = 0; w < wave; ++w) base += wt[w];
        int ex = base + inc - sum;
#pragma unroll
        for (int i = 0; i < 4; ++i) { pfx[F.tid * 4 + i] = ex; ex += c4[i]; }
        if (F.tid == 511) pfx[2048] = ex;
        __syncthreads();
        const int NU = pfx[2048];
        const int u0 = (int)(((long)blockIdx.x * NU) / F.G), u1 = (int)(((long)(blockIdx.x + 1) * NU) / F.G);
        nul = u1 - u0; if (nul > 64) nul = 64;
        if (F.tid < nul) { const int u = u0 + F.tid; int lo_ = 0, hi_ = 2048;
            while (hi_ - lo_ > 1) { const int mid = (lo_ + hi_) >> 1; if (pfx[mid] <= u) lo_ = mid; else hi_ = mid; }
            const int chunk = u - pfx[lo_], cnt = (int)__hip_atomic_load(acnt + lo_, RLX_AGENT), rem = cnt - chunk * 256;
            um[F.tid * 4 + 0] = lo_; um[F.tid * 4 + 1] = chunk; um[F.tid * 4 + 2] = rem < 256 ? rem : 256; }
    } else {
        nul = ((int)blockIdx.x < 2048) ? (2047 - (int)blockIdx.x) / F.G + 1 : 0; if (nul > 64) nul = 64;
        if (F.tid < nul) { const int u = (int)blockIdx.x + F.tid * F.G; um[F.tid * 4 + 0] = u; um[F.tid * 4 + 1] = 0; um[F.tid * 4 + 2] = 256; }
    }
    __syncthreads();
    if (nul > 0) {
#define ATT_ENT(k) (OWN ? (unsigned)((((um[(k) * 4] & 63) * 256 + wave * 32 + r32) << 2) | 3) \
                        : (unsigned)alist[(size_t)(um[(k) * 4] >> 6) * ALIST_BH + alist_off(um[(k) * 4] & 63) + um[(k) * 4 + 1] * 256 + wave * 32 + r32])
#define ATT_ROWBASE(k) ((size_t)(um[(k) * 4] >> 6) * SEQ + (size_t)(um[(k) * 4] & 63) * 256)
#define ATT_H(k) ((um[(k) * 4] >> 6) & 15)
#define ATT_B(k) (um[(k) * 4] >> 10)
#define A2_SBAR() __builtin_amdgcn_sched_barrier(0)
#define A2_MFMA(a, b, c) __builtin_amdgcn_mfma_f32_32x32x16_bf16(a, b, c, 0, 0, 0)
#define A2_PKW(P, B) cvt_pk_bf16(P[B], P[(B) + 1])
#define A2_PAF(k) __builtin_bit_cast(bf16x8_t, pw##k)
#define A2_VFR(i) (bf16x8_t){vlo[i][0], vlo[i][1], vlo[i][2], vlo[i][3], vhi[i][0], vhi[i][1], vhi[i][2], vhi[i][3]}
#define A2_PIN(x) asm volatile("" : "+v"(x))
#define A2_MX3(a, b, c) __builtin_fmaxf(__builtin_fmaxf((a), (b)), (c))
#define A2_EX(v) __builtin_amdgcn_exp2f(v)
#define A2_GAPA(MF, A0, A1, A2, A3, W0, W1, PW) do { MF; sacc += A0; sacc += A1; sacc += A2; sacc += A3; A2_PIN(sacc); W0; W1; A2_PIN(PW); A2_SBAR(); } while (0)
#define A2_GAPB(MF, X, B) do { MF; X[B] = A2_EX(X[B]); X[(B) + 1] = A2_EX(X[(B) + 1]); X[(B) + 2] = A2_EX(X[(B) + 2]); X[(B) + 3] = A2_EX(X[(B) + 3]); A2_PIN(X); A2_SBAR(); } while (0)
#define A2_VRD(i) do { vlo[i] = vtr(vp_ + (((i) >> 2) * 16384 + ((i) & 3) * 1024)); vhi[i] = vtr(vp_ + (((i) >> 2) * 16384 + ((i) & 3) * 1024 + 512)); } while (0)
#define A2_KRD(G, j) do { if (G) { kf[2 * (j)] = *(const LAS bf16x8_t*)(kn_ + (j) * 8192); kf[2 * (j) + 1] = *(const LAS bf16x8_t*)(kn_ + (j) * 8192 + 512); A2_SBAR(); } } while (0)
#define A2_RESC() do { if (resc) { LDS_WAIT(); _Pragma("unroll") for (int d_ = 0; d_ < 2; ++d_) _Pragma("unroll") for (int r = 0; r < 16; ++r) o[d_][r] *= wsc[crow(r, hi)]; } } while (0)
#define A2_STEP(C0, C1, P0, P1, t, GL) do { A2_SBAR(); \
    const LAS unsigned char* vp_ = vp0 + ((t) - 1) * 4096; const LAS unsigned char* kn_ = kp0 + ((t) + 1) * 1024; (void)kn_; \
    A2_VRD(0); A2_SBAR(); float sacc = (P0[0] + P0[1]); \
    A2_GAPA(C0 = A2_MFMA(kf[0], qr[0], negm), P0[2], P0[3], P0[4], P0[5],     pw0[0] = A2_PKW(P0, 0), pw0[1] = A2_PKW(P0, 2), pw0); \
    A2_VRD(4); A2_SBAR(); A2_GAPA(C1 = A2_MFMA(kf[1], qr[0], negm), P0[6], P0[7], P0[8], P0[9],     pw0[2] = A2_PKW(P0, 4), pw0[3] = A2_PKW(P0, 6), pw0); \
    A2_VRD(1); A2_SBAR(); A2_GAPA(C0 = A2_MFMA(kf[2], qr[1], C0),   P0[10], P0[11], P0[12], P0[13], pw1[0] = A2_PKW(P0, 8), pw1[1] = A2_PKW(P0, 10), pw1); \
    A2_VRD(5); A2_SBAR(); A2_GAPA(C1 = A2_MFMA(kf[3], qr[1], C1),   P0[14], P0[15], P1[0], P1[1],   pw1[2] = A2_PKW(P0, 12), pw1[3] = A2_PKW(P0, 14), pw1); \
    A2_VRD(2); A2_SBAR(); A2_GAPA(C0 = A2_MFMA(kf[4], qr[2], C0),   P1[2], P1[3], P1[4], P1[5],     pw2[0] = A2_PKW(P1, 0), pw2[1] = A2_PKW(P1, 2), pw2); \
    A2_VRD(6); A2_SBAR(); A2_GAPA(C1 = A2_MFMA(kf[5], qr[2], C1),   P1[6], P1[7], P1[8], P1[9],     pw2[2] = A2_PKW(P1, 4), pw2[3] = A2_PKW(P1, 6), pw2); \
    A2_VRD(3); A2_SBAR(); A2_GAPA(C0 = A2_MFMA(kf[6], qr[3], C0),   P1[10], P1[11], P1[12], P1[13], pw3[0] = A2_PKW(P1, 8), pw3[1] = A2_PKW(P1, 10), pw3); \
    A2_VRD(7); A2_SBAR(); A2_GAPA(C1 = A2_MFMA(kf[7], qr[3], C1),   P1[14], P1[15], 0.f, 0.f,       pw3[2] = A2_PKW(P1, 12), pw3[3] = A2_PKW(P1, 14), pw3); \
    l_reg += sacc; \
    if (OWN) { int q_ = qrel; asm volatile("" : "+v"(q_)); cmask(C0, C1, t, q_, hi); } \
    { float a = A2_MX3(C0[0], C0[1], C1[0]), b = A2_MX3(C0[2], C0[3], C1[1]); a = A2_MX3(a, C1[2], C1[3]); \
      _Pragma("unroll") for (int r = 4; r < 16; r += 4) { a = A2_MX3(a, C0[r], C0[r + 1]); b = A2_MX3(b, C0[r + 2], C0[r + 3]); a = A2_MX3(a, C1[r], C1[r + 1]); b = A2_MX3(b, C1[r + 2], C1[r + 3]); } \
      float rm = __builtin_fmaxf(a, b); { auto rr = __builtin_amdgcn_permlane32_swap(__float_as_uint(rm), __float_as_uint(rm), false, false); rm = __builtin_fmaxf(__uint_as_float(rr[0]), __uint_as_float(rr[1])); } \
      resc = false; \
      if (__builtin_expect(__builtin_amdgcn_ballot_w64(rm > 8.0f) != 0, 0)) { const float dl = __builtin_fmaxf(rm, 0.f); mhat += dl; \
        _Pragma("unroll") for (int r = 0; r < 16; ++r) { C0[r] -= dl; C1[r] -= dl; } \
        _Pragma("unroll") for (int r = 0; r < 16; ++r) negm[r] = -mhat; asm volatile("" : "+v"(negm)); \
        const float f = __builtin_amdgcn_exp2f(-dl); l_reg *= f; if (hi == 0) { int r_ = r32; asm volatile("" : "+v"(r_)); wsc[r_] = f; } resc = true; } } \
    A2_SBAR(); \
    A2_GAPB(o[0] = A2_MFMA(A2_PAF(0), A2_VFR(0), o[0]), C0, 0); \
    A2_GAPB(o[1] = A2_MFMA(A2_PAF(0), A2_VFR(4), o[1]), C0, 4); \
    A2_KRD(GL, 0); A2_GAPB(o[0] = A2_MFMA(A2_PAF(1), A2_VFR(1), o[0]), C0, 8); \
    A2_KRD(GL, 1); A2_GAPB(o[1] = A2_MFMA(A2_PAF(1), A2_VFR(5), o[1]), C0, 12); \
    A2_KRD(GL, 2); A2_GAPB(o[0] = A2_MFMA(A2_PAF(2), A2_VFR(2), o[0]), C1, 0); \
    A2_KRD(GL, 3); A2_GAPB(o[1] = A2_MFMA(A2_PAF(2), A2_VFR(6), o[1]), C1, 4); \
    A2_GAPB(o[0] = A2_MFMA(A2_PAF(3), A2_VFR(3), o[0]), C1, 8); \
    A2_GAPB(o[1] = A2_MFMA(A2_PAF(3), A2_VFR(7), o[1]), C1, 12); \
    } while (0)
    unsigned ent0 = 0u, ent1 = ATT_ENT(0), ent2 = (nul > 1) ? ATT_ENT(1) : ent1;
    asm volatile("" : "+v"(ent1), "+v"(ent2));
    attn_dma_k(ldsb, Kb, ATT_ROWBASE(0), ATT_H(0), wave, F.lane);
    attn_dma_q(ldsb, Qb + ((size_t)(um[0] >> 6) * SEQ + (ent1 >> 2)) * 64, wave, F.lane);
    attn_dma_v(ldsb, Vb, ATT_ROWBASE(0), ATT_H(0), wave, F.lane);
    bool prev_active = false;
    int st_next = st_tail; const int st_step = F.G * 8; int st_cur = 0; bool st_real = false;
    const unsigned stg_lds = ldsb + ATT_STG + wave * 4096;
    unsigned char* dummy = Wd8 + (size_t)(WS_SIDE_DUMMY - WS_WD) + (size_t)(F.vcu * 8 + wave) * 1024;
    if (!OWN) { *(GAS v4u*)(dummy + F.lane * 16) = (v4u){0u, 0u, 0u, 0u}; }
    for (int k = 0; k < nul; ++k) {
        const int b = ATT_B(k), h = ATT_H(k), jb = um[k * 4] & 63, nh = um[k * 4 + 2];
        const int qrel = wave * 32 + r32; const bool valid = qrel < nh;
        const bool same_prev = !OWN && k > 0 && um[(k - 1) * 4] == um[k * 4], same_next = !OWN && k + 1 < nul && um[(k + 1) * 4] == um[k * 4];
        const bool more = k + 1 < nul;
        if (!same_prev) { if (OWN) { if (prev_active) { ATT_WB("vmcnt(8)"); } else { ATT_WB("vmcnt(4)"); } } else { if (prev_active) { ATT_WB("vmcnt(10)"); } else { ATT_WB("vmcnt(5)"); } } }
        else { if (prev_active) { asm volatile("s_waitcnt vmcnt(11)" ::: "memory"); } else { asm volatile("s_waitcnt vmcnt(6)" ::: "memory"); } }
        asm volatile("" : "+v"(ent2));
        ent0 = ent1; ent1 = ent2;
        const int t = (int)(ent0 >> 2), slot = (int)(ent0 & 3); const size_t qrow = (size_t)(b * 16 + h) * SEQ + t;
        bf16x8_t qr[4];
#pragma unroll
        for (int d0 = 0; d0 < 4; ++d0) qr[d0] = *(const LAS bf16x8_t*)(F.lds + ATT_Q + wave * 4096 + (2 * d0 + hi) * 512 + r32 * 16);
        { const int k2 = (k + 2 < nul) ? k + 2 : nul - 1;
          if (OWN) ent2 = ATT_ENT(k2);
          else { const unsigned short* lp = alist + (size_t)(um[k2 * 4] >> 6) * ALIST_BH + alist_off(um[k2 * 4] & 63) + um[k2 * 4 + 1] * 256 + wave * 32 + r32;
              asm volatile("global_load_ushort %0, %1, off" : "=v"(ent2) : "v"(lp) : "memory"); } }
        if (!OWN) { st_real = st_next < SIDE_TASKS; st_cur = st_real ? st_next : SIDE_TASKS - 1; if (st_real) st_next += st_step;
            int ln_ = F.lane; asm volatile("" : "+v"(ln_)); side_dma(st_cur, w_gu, w_d, ln_, stg_lds); }
        const int nv = OWN ? (jb < 3 ? jb : 3) : 0;
        const bool active = wave * 32 < nh;
        float mhat = 0.f, l_reg = 0.f; bool resc = false;
        f32x16 o[2]; o[0] = (f32x16){0.f,0.f,0.f,0.f,0.f,0.f,0.f,0.f,0.f,0.f,0.f,0.f,0.f,0.f,0.f,0.f}; o[1] = o[0];
        f32x16 negm = o[0]; asm volatile("" : "+v"(negm));
        f32x16 pA0, pA1, pB0, pB1; bf16x8_t kf[8]; s16x4_t vlo[8], vhi[8]; v4u pw0, pw1, pw2, pw3;
        if (active) {
#pragma unroll
            for (int j = 0; j < 4; ++j) { kf[2 * j] = *(const LAS bf16x8_t*)(kp0 + j * 8192); kf[2 * j + 1] = *(const LAS bf16x8_t*)(kp0 + j * 8192 + 512); }
            pA0 = A2_MFMA(kf[0], qr[0], negm); pA1 = A2_MFMA(kf[1], qr[0], negm);
#pragma unroll
            for (int d0 = 1; d0 < 4; ++d0) { pA0 = A2_MFMA(kf[2 * d0], qr[d0], pA0); pA1 = A2_MFMA(kf[2 * d0 + 1], qr[d0], pA1); }
            asm volatile("s_nop 15\n\ts_nop 7" : "+v"(pA0), "+v"(pA1));
        }
        LDS_WAIT();
        { int ln_ = F.lane; asm volatile("" : "+v"(ln_)); attn_dma_q(ldsb, Qb + ((size_t)(um[(more ? k + 1 : k) * 4] >> 6) * SEQ + (ent1 >> 2)) * 64, wave, ln_); }
        if (active) {
#pragma unroll
            for (int j = 0; j < 4; ++j) { kf[2 * j] = *(const LAS bf16x8_t*)(kp0 + 1024 + j * 8192); kf[2 * j + 1] = *(const LAS bf16x8_t*)(kp0 + 1024 + j * 8192 + 512); }
            if (OWN) { int q_ = qrel; asm volatile("" : "+v"(q_)); cmask(pA0, pA1, 0, q_, hi); }
            const float rm = rowmax32(pA0, pA1); mhat = rm;
#pragma unroll
            for (int r = 0; r < 16; ++r) { pA0[r] = fsub_s(pA0[r], rm); pA1[r] = fsub_s(pA1[r], rm); }
#pragma unroll
            for (int r = 0; r < 16; ++r) negm[r] = -mhat;
            asm volatile("" : "+v"(negm));
#pragma unroll
            for (int r = 0; r < 16; ++r) pA0[r] = __builtin_amdgcn_exp2f(pA0[r]);
#pragma unroll
            for (int r = 0; r < 16; ++r) pA1[r] = __builtin_amdgcn_exp2f(pA1[r]);
        }
        if (!same_prev) { if (OWN) { if (prev_active) { ATT_WB("vmcnt(8) lgkmcnt(0)"); } else { ATT_WB("vmcnt(4) lgkmcnt(0)"); } } else { if (prev_active) { ATT_WB("vmcnt(15) lgkmcnt(0)"); } else { ATT_WB("vmcnt(10) lgkmcnt(0)"); } } }
        const bool full = !OWN || wave >= 4;
        if (active) { A2_STEP(pB0, pB1, pA0, pA1, 1, true); A2_RESC(); }
        if (!OWN) { asm volatile("s_waitcnt vmcnt(4)" ::: "memory");
            { int ln_ = F.lane; asm volatile("" : "+v"(ln_)); side_consume(st_cur, st_real, dummy, Wgu8, Wd8, ln_, F.lds + ATT_STG + wave * 4096); }
            LDS_WAIT();
            st_real = st_next < SIDE_TASKS; st_cur = st_real ? st_next : SIDE_TASKS - 1; if (st_real) st_next += st_step;
            { int ln_ = F.lane; asm volatile("" : "+v"(ln_)); side_dma(st_cur, w_gu, w_d, ln_, stg_lds); } }
        if (active) { if (full) { A2_STEP(pA0, pA1, pB0, pB1, 2, true); A2_RESC(); } }
        if (!same_next) { ATT_WB("lgkmcnt(0)");
            if (more) { int ln_ = F.lane; asm volatile("" : "+v"(ln_)); attn_dma_k(ldsb, Kb, ATT_ROWBASE(k + 1), ATT_H(k + 1), wave, ln_); } }
        if (active) {
            if (full) { A2_STEP(pB0, pB1, pA0, pA1, 3, false); A2_RESC(); }
            float sacc = pB0[0] + pB0[1];
#pragma unroll
            for (int r = 2; r < 16; ++r) sacc += pB0[r];
#pragma unroll
            for (int r = 0; r < 16; ++r) sacc += pB1[r];
            l_reg += sacc;
            pw0 = (v4u){A2_PKW(pB0, 0), A2_PKW(pB0, 2), A2_PKW(pB0, 4), A2_PKW(pB0, 6)}; pw1 = (v4u){A2_PKW(pB0, 8), A2_PKW(pB0, 10), A2_PKW(pB0, 12), A2_PKW(pB0, 14)};
            pw2 = (v4u){A2_PKW(pB1, 0), A2_PKW(pB1, 2), A2_PKW(pB1, 4), A2_PKW(pB1, 6)}; pw3 = (v4u){A2_PKW(pB1, 8), A2_PKW(pB1, 10), A2_PKW(pB1, 12), A2_PKW(pB1, 14)};
            { const LAS unsigned char* vp_ = vp0 + (full ? 3 * 4096 : 4096);
#pragma unroll
              for (int i = 0; i < 8; ++i) A2_VRD(i);
              o[0] = A2_MFMA(A2_PAF(0), A2_VFR(0), o[0]); o[1] = A2_MFMA(A2_PAF(0), A2_VFR(4), o[1]);
              o[0] = A2_MFMA(A2_PAF(1), A2_VFR(1), o[0]); o[1] = A2_MFMA(A2_PAF(1), A2_VFR(5), o[1]);
              o[0] = A2_MFMA(A2_PAF(2), A2_VFR(2), o[0]); o[1] = A2_MFMA(A2_PAF(2), A2_VFR(6), o[1]);
              o[0] = A2_MFMA(A2_PAF(3), A2_VFR(3), o[0]); o[1] = A2_MFMA(A2_PAF(3), A2_VFR(7), o[1]); }
            { auto rr = __builtin_amdgcn_permlane32_swap(__float_as_uint(l_reg), __float_as_uint(l_reg), false, false); l_reg = __uint_as_float(rr[0]) + __uint_as_float(rr[1]); }
        }
        if (!same_next) { ATT_WB("lgkmcnt(0)");
            if (more) { int ln_ = F.lane; asm volatile("" : "+v"(ln_)); attn_dma_v(ldsb, Vb, ATT_ROWBASE(k + 1), ATT_H(k + 1), wave, ln_); } }
        else { LDS_WAIT(); }
        if (!OWN) { if (!same_next && more) { asm volatile("s_waitcnt vmcnt(8)" ::: "memory"); } else { asm volatile("s_waitcnt vmcnt(0)" ::: "memory"); }
            { int ln_ = F.lane; asm volatile("" : "+v"(ln_)); side_consume(st_cur, st_real, dummy, Wgu8, Wd8, ln_, F.lds + ATT_STG + wave * 4096); }
            LDS_WAIT(); }
        const float mx = mhat, l = l_reg;
        if (active) {
            int r32e = r32, hie = hi, lne = F.lane; asm volatile("" : "+v"(r32e), "+v"(hie), "+v"(lne));
            LAS bf16* stg = (LAS bf16*)(F.lds + ATT_STG + wave * 4096);
            if (!OWN) {
                if (hie == 0) { wsc[r32e] = 1.0f / l; ((LAS int*)wsc)[32 + r32e] = valid ? (int)(qrow * 3 + slot) : -1;
                    if (valid) { typedef float f32x2s __attribute__((ext_vector_type(2))); *(GAS f32x2s*)(PML + (qrow * 3 + slot) * 2) = (f32x2s){mx, l}; } }
                LDS_WAIT(); asm volatile("" ::: "memory");
#pragma unroll
                for (int r = 0; r < 16; ++r) { const int orow = crow(r, hie); const float rl = wsc[orow];
#pragma unroll
                    for (int dh = 0; dh < 2; ++dh) stg[orow * 64 + dh * 32 + r32e] = (bf16)(cvt_pk_bf16(o[dh][r] * rl, 0.f) & 0xffffu); }
                LDS_WAIT(); asm volatile("" ::: "memory");
#pragma unroll
                for (int i = 0; i < 4; ++i) { const int row = i * 8 + (lne >> 3), ch = lne & 7; const int pidx = ((LAS int*)wsc)[32 + row];
                    const v4u v = *(const LAS v4u*)(stg + row * 64 + ch * 8);
                    int w0 = 0, w1 = 0; w0 = __builtin_amdgcn_cvt_pk_fp8_f32(bf_lo(v.x) * 16.f, bf_hi(v.x) * 16.f, w0, false); w0 = __builtin_amdgcn_cvt_pk_fp8_f32(bf_lo(v.y) * 16.f, bf_hi(v.y) * 16.f, w0, true);
                    w1 = __builtin_amdgcn_cvt_pk_fp8_f32(bf_lo(v.z) * 16.f, bf_hi(v.z) * 16.f, w1, false); w1 = __builtin_amdgcn_cvt_pk_fp8_f32(bf_lo(v.w) * 16.f, bf_hi(v.w) * 16.f, w1, true);
                    unsigned char* dst = (pidx >= 0) ? (unsigned char*)PO + (size_t)pidx * 64 + ch * 8 : dummy + lne * 16;
                    v2u w; w.x = (unsigned)w0; w.y = (unsigned)w1; *(GAS v2u*)dst = w; }
            } else {
                float pm_[3], pl_[3];
#pragma unroll
                for (int i = 0; i < 3; ++i) { pm_[i] = -INFINITY; pl_[i] = 0.f; if (i < nv) { const float* pm = PML + (qrow * 3 + i) * 2; pm_[i] = pm[0]; pl_[i] = pm[1]; } }
                const size_t grow0 = (size_t)b * SEQ + jb * 256 + wave * 32;
                const size_t hrow0 = (size_t)(b * 16 + h) * SEQ + jb * 256 + wave * 32;
                v2u pp[4][3];
#pragma unroll
                for (int i = 0; i < 4; ++i)
#pragma unroll
                    for (int sl = 0; sl < 3; ++sl) { pp[i][sl] = (v2u){0u, 0u};
                        if (sl < nv) pp[i][sl] = __builtin_nontemporal_load((const GAS v2u*)((const unsigned char*)PO + ((hrow0 + i * 8 + (lne >> 3)) * 3 + sl) * 64 + (lne & 7) * 8)); }
                float Mx = mx;
#pragma unroll
                for (int i = 0; i < 3; ++i) Mx = fmaxf(Mx, pm_[i]);
                const float aown = __builtin_amdgcn_exp2f(mx - Mx); float W = l * aown; float wi[3];
#pragma unroll
                for (int i = 0; i < 3; ++i) { wi[i] = pl_[i] * __builtin_amdgcn_exp2f(pm_[i] - Mx); W += wi[i]; }
                const float rW = 1.0f / W;
                if (hie == 0) { wsc[r32e * 4 + 0] = aown * rW; wsc[r32e * 4 + 1] = wi[0] * rW; wsc[r32e * 4 + 2] = wi[1] * rW; wsc[r32e * 4 + 3] = wi[2] * rW; }
                LDS_WAIT(); asm volatile("" ::: "memory");
#pragma unroll
                for (int r = 0; r < 16; ++r) { const int orow = crow(r, hie); const float c0 = wsc[orow * 4];
#pragma unroll
                    for (int dh = 0; dh < 2; ++dh) stg[orow * 64 + dh * 32 + r32e] = (bf16)(cvt_pk_bf16(o[dh][r] * c0, 0.f) & 0xffffu); }
                LDS_WAIT(); asm volatile("" ::: "memory");
#pragma unroll
                for (int i = 0; i < 4; ++i) { const int row = i * 8 + (lne >> 3), ch = lne & 7;
                    const v4u ov = *(const LAS v4u*)(stg + row * 64 + ch * 8);
                    float a8[8] = {bf_lo(ov.x), bf_hi(ov.x), bf_lo(ov.y), bf_hi(ov.y), bf_lo(ov.z), bf_hi(ov.z), bf_lo(ov.w), bf_hi(ov.w)};
#pragma unroll
                    for (int sl = 0; sl < 3; ++sl) { const float c = wsc[row * 4 + 1 + sl] * (1.0f / 16.0f); const v2u pv = pp[i][sl];
                        typedef float f32x2p __attribute__((ext_vector_type(2)));
                        const f32x2p p0 = __builtin_amdgcn_cvt_pk_f32_fp8((int)pv.x, false), p1 = __builtin_amdgcn_cvt_pk_f32_fp8((int)pv.x, true), p2 = __builtin_amdgcn_cvt_pk_f32_fp8((int)pv.y, false), p3 = __builtin_amdgcn_cvt_pk_f32_fp8((int)pv.y, true);
                        a8[0] += c * p0.x; a8[1] += c * p0.y; a8[2] += c * p1.x; a8[3] += c * p1.y; a8[4] += c * p2.x; a8[5] += c * p2.y; a8[6] += c * p3.x; a8[7] += c * p3.y; }
                    int w0 = 0, w1 = 0; w0 = __builtin_amdgcn_cvt_pk_fp8_f32(a8[0] * 16.f, a8[1] * 16.f, w0, false); w0 = __builtin_amdgcn_cvt_pk_fp8_f32(a8[2] * 16.f, a8[3] * 16.f, w0, true);
                    w1 = __builtin_amdgcn_cvt_pk_fp8_f32(a8[4] * 16.f, a8[5] * 16.f, w1, false); w1 = __builtin_amdgcn_cvt_pk_fp8_f32(a8[6] * 16.f, a8[7] * 16.f, w1, true);
                    v2u w; w.x = (unsigned)w0; w.y = (unsigned)w1; *(GAS v2u*)((unsigned char*)ATTO + (grow0 + row) * 1024 + h * 64 + ch * 8) = w; }
            }
        }
        asm volatile("" ::: "memory");
        prev_active = active;
    }
    st_tail = st_next;
    }
    asm volatile("s_waitcnt vmcnt(0) lgkmcnt(0)" ::: "memory");
    if (!OWN)
    { float sv[16], sv1[16]; const int st_step = F.G * 8;
        for (int st = st_tail; st < SIDE_TASKS; st += 2 * st_step) { side_issue(st, w_gu, w_d, F.lane, sv); const bool two = st + st_step < SIDE_TASKS; if (two) side_issue(st + st_step, w_gu, w_d, F.lane, sv1);
            side_finish(st, Wgu8, Wd8, F.lane, sv); if (two) side_finish(st + st_step, Wgu8, Wd8, F.lane, sv1); } }
    asm volatile("s_waitcnt vmcnt(0) lgkmcnt(0)" ::: "memory");
    __syncthreads();
#undef ATT_ENT
#undef ATT_ROWBASE
#undef ATT_H
#undef ATT_B
}

#define DECL_PTRS() int z_ = 0; asm volatile("" : "+s"(z_)); unsigned char* ws = args.ws + z_; const float* x = args.in[0 + z_]; const float* g_mix = args.in[1 + z_]; const float* w_in = args.in[2 + z_]; const float* conv_w = args.in[3 + z_]; const float* w_co = args.in[4 + z_]; const float* w_ao = args.in[5 + z_]; const float* w_out = args.in[6 + z_]; const float* g_ffn = args.in[7 + z_]; const float* router_w = args.in[8 + z_]; const float* router_b = args.in[9 + z_]; const float* w_gu = args.in[10 + z_]; const float* b_gu = args.in[11 + z_]; const float* w_d = args.in[12 + z_]; const float* b_d = args.in[13 + z_]; const float* g_fin = args.in[14 + z_]; float* out = args.out + z_; bf16* HB = (bf16*)(ws + WS_K); (void)HB; bf16* Win_t = (bf16*)(ws + WS_WIN); bf16* Wco_t = (bf16*)(ws + WS_WCO); bf16* Wao_t = (bf16*)(ws + WS_WAO); bf16* Wout_t = (bf16*)(ws + WS_WOUT); bf16* Wgu_t = (bf16*)(ws + WS_WGU); bf16* Wd_t = (bf16*)(ws + WS_WD); bf16* XN = (bf16*)(ws + WS_XN); bf16* CB = (bf16*)(ws + WS_CB); bf16* U = (bf16*)(ws + WS_U); bf16* Qb = (bf16*)(ws + WS_Q); bf16* Kb = (bf16*)(ws + WS_K); bf16* Vb = (bf16*)(ws + WS_V); bf16* GC = (bf16*)(ws + WS_GC); bf16* GA = (bf16*)(ws + WS_GA); bf16* T1 = U; bf16* MERGED = Qb; bf16* ATTO = (bf16*)(ws + WS_PO + 128 * MiB); float* xrms = (float*)(ws + WS_XRMS); (void)xrms; bf16* HN = XN; bf16* ACT = (bf16*)(ws + WS_ACT); bf16* Y = (bf16*)(ws + WS_Y); unsigned* ropeT = (unsigned*)(ws + WS_COS); float* ksum = (float*)(ws + WS_KSUM); float* rwg = (float*)(ws + WS_RWG); bf16* PO = (bf16*)(ws + WS_PO); float* PML = (float*)(ws + WS_PML); unsigned short* alist = (unsigned short*)(ws + WS_ALIST); gu32* acnt = F.ctl + CW_ACNT; int* etok = (int*)(ws + WS_ETOK); float* ewt = (float*)(ws + WS_EWT); float* erstd = (float*)(ws + WS_ERSTD); (void)erstd; unsigned char* Win8 = ws + WS_WIN8; unsigned char* Wao8 = ws + WS_WAO8; unsigned char* XN8 = ws + WS_XN8; (void)Win8; (void)Wao8; (void)XN8; int* tokslot = (int*)(ws + WS_TOKSLOT); (void)x; (void)out;
struct Args { const float* in[15]; float* out; unsigned char* ws; int ph_lo, ph_hi; };
constexpr int NPHASE = 11;

__global__ void __launch_bounds__(512, 2) fwd_kernel(Args args) {
    extern __shared__ __attribute__((aligned(16))) unsigned char lds_raw[];
    Frame F;
    F.lds = (LAS unsigned char*)lds_raw;
    F.tid = threadIdx.x; F.lane = F.tid & 63; F.wave = __builtin_amdgcn_readfirstlane(F.tid >> 6);
    F.G = gridDim.x; { const int bx = blockIdx.x; F.vcu = (F.G % 8 == 0) ? (bx % 8) * (F.G / 8) + bx / 8 : bx; }
    F.ws = args.ws; F.ctl = (gu32*)(args.ws + WS_CTL);

    for (int u = F.tid; u < (LDS_BYTES - LDSCTL_OFF) / 4; u += 512) ((LAS unsigned*)(F.lds + LDSCTL_OFF))[u] = 0u;
    __syncthreads();
    XcdBarrier bar = xcd_barrier_post((unsigned*)(F.ctl + CW_BAR), (volatile LAS unsigned*)(F.lds + MISC_OFF) + 8);
    const int lo = args.ph_lo, hi = args.ph_hi;
#define IN(k) (lo <= (k) && (k) < hi)
#define SEAM(k) do { if (IN(k) && IN((k) + 1)) xcd_barrier(bar); } while (0)
    const int gw = F.vcu * 8 + F.wave, NGW = F.G * 8;
    LAS int* tab = (LAS int*)(F.lds + TAB_OFF);

    if (IN(0)) {
        DECL_PTRS();
        constexpr int I_IN = 16 * 128, I_SQ = 16 * 16;
        constexpr int NITEMS = I_IN + 3 * I_SQ;
        for (int it = gw; it < NITEMS; it += NGW) {
            int r = it;
            if (r < I_IN) { const int nb = r % 128; if (nb < 48 || (nb >= 96 && nb < 112)) p0_transpose_task<1>(w_in, 8192, Win_t, g_mix, r, F.lane); else p0_transpose_task8<1>(w_in, 8192, Win8, g_mix, r, F.lane); continue; } r -= I_IN;
            if (r < I_SQ) { p0_transpose_task8<0>(w_ao, 1024, Wao8, nullptr, r, F.lane); continue; } r -= I_SQ;
            if (r < I_SQ) { p0_transpose_task<0>(w_co, 1024, Wco_t, nullptr, r, F.lane); continue; } r -= I_SQ;
            p0_transpose_task<0>(w_out, 1024, Wout_t, nullptr, r, F.lane);
        }
        for (int m = gw; m < M; m += NGW) {
            const GAS f32x4* xr = (const GAS f32x4*)(x + (size_t)m * D) + F.lane; f32x4 v[4]; float s = 0.f;
#pragma unroll
            for (int j = 0; j < 4; ++j) { v[j] = xr[64 * j]; s += (v[j].x * v[j].x + v[j].y * v[j].y) + (v[j].z * v[j].z + v[j].w * v[j].w); }
            const float rms = sqrtf(wave_sum(s) * (1.f / D) + EPS), rstd = 1.0f / rms;
            if (F.lane == 0) xrms[m] = rms;
            GAS v2u* o8 = (GAS v2u*)(XN + (size_t)m * D) + F.lane; GAS unsigned* o4 = (GAS unsigned*)(XN8 + (size_t)m * D) + F.lane;
#pragma unroll
            for (int j = 0; j < 4; ++j) { v2u w; w.x = cvt_pk_bf16(v[j].x * rstd, v[j].y * rstd); w.y = cvt_pk_bf16(v[j].z * rstd, v[j].w * rstd); o8[64 * j] = w;
                int q8 = 0; q8 = __builtin_amdgcn_cvt_pk_fp8_f32(v[j].x * rstd, v[j].y * rstd, q8, false); q8 = __builtin_amdgcn_cvt_pk_fp8_f32(v[j].z * rstd, v[j].w * rstd, q8, true); o4[64 * j] = (unsigned)q8; }
        }
        const int gt = F.vcu * 512 + F.tid, NT = F.G * 512;
        for (int i = gt; i < SEQ * 32; i += NT) { const int pos = i >> 5, k = i & 31; const float inv = powf(10000.0f, -(float)k / 32.0f); const float ang = (float)pos * inv; typedef _Float16 h2_t __attribute__((ext_vector_type(2))); const h2_t hh = {(_Float16)cosf(ang), (_Float16)sinf(ang)}; ropeT[i] = __builtin_bit_cast(unsigned, hh); }
        for (int i = gt; i < BATCH * NBLK * 1024; i += NT) ksum[i] = 0.f;
        { unsigned short* rwgH = (unsigned short*)rwg; unsigned short* rwgL = rwgH + 64 * 64 * 8;
          for (int i = gt; i < 64 * 64 * 8; i += NT) { const int jj = i & 7, ln = (i >> 3) & 63, st = i >> 9, k = 16 * st + 8 * (ln >> 5) + jj, e = ln & 31;
              const float v = router_w[k * 32 + e] * g_ffn[k]; const unsigned hb = cvt_pk_bf16(v, 0.f) & 0xffffu; const float vh = __uint_as_float(hb << 16);
              rwgH[i] = (unsigned short)hb; rwgL[i] = (unsigned short)(cvt_pk_bf16(v - vh, 0.f) & 0xffffu); } }
    }
    SEAM(0);
    if (IN(1)) {
        DECL_PTRS();
        { DensePol P{XN, Win_t, M / 256, 16, F.G, (int)blockIdx.x, 2, 12, 0, 12}; EpiInProj E{CB, U, Qb, Kb, Vb, GC, GA, ropeT, ksum, 1.0f};
          pg8::gemm_phase<EpiInProj, DensePol, true>(F.lds, P, E); }
        { DensePol P{XN8, Win8, M / 256, 16, F.G, (int)blockIdx.x, 1, 12, 12, 16}; EpiInProj E{CB, U, Qb, Kb, Vb, GC, GA, ropeT, ksum, 1.0f / 32.0f};
          pg8::gemm_phase<EpiInProj, DensePol, true, true>(F.lds, P, E); }
    }
    SEAM(1);
    if (IN(2)) {
        DECL_PTRS();
        bf16* CBW = CB;
        {
            const int cg = F.tid & 127, rs = F.tid >> 7;
            float w0[8], w1[8], w2[8];
#pragma unroll
            for (int e = 0; e < 8; ++e) { w0[e] = conv_w[cg * 8 + e]; w1[e] = conv_w[1024 + cg * 8 + e]; w2[e] = conv_w[2048 + cg * 8 + e]; }
            const int row0 = F.vcu * (M / F.G) + rs * 32, pos0 = row0 & (SEQ - 1);
            const size_t off0 = (size_t)row0 * 1024 + cg * 8;
            v4u u1 = (v4u){0u, 0u, 0u, 0u}, u2 = (v4u){0u, 0u, 0u, 0u};
            if (pos0 >= 1) u1 = *(const GAS v4u*)(U + off0 - 1024);
            if (pos0 >= 2) u2 = *(const GAS v4u*)(U + off0 - 2048);
#pragma unroll 1
            for (int r = 0; r < 32; r += 4) {
                v4u cb[4], uu[4];
#pragma unroll
                for (int q = 0; q < 4; ++q) { cb[q] = *(const GAS v4u*)(CB + off0 + (size_t)(r + q) * 1024); uu[q] = *(const GAS v4u*)(U + off0 + (size_t)(r + q) * 1024); }
#pragma unroll
                for (int q = 0; q < 4; ++q) {
                    const v4u u0 = uu[q]; float o[8];
#define CV(i, cw, a0, a1, a2, sel) o[i] = sel(cw) * (w0[i] * sel(a2) + w1[i] * sel(a1) + w2[i] * sel(a0))
                    CV(0, cb[q].x, u0.x, u1.x, u2.x, bf_lo); CV(1, cb[q].x, u0.x, u1.x, u2.x, bf_hi); CV(2, cb[q].y, u0.y, u1.y, u2.y, bf_lo); CV(3, cb[q].y, u0.y, u1.y, u2.y, bf_hi);
                    CV(4, cb[q].z, u0.z, u1.z, u2.z, bf_lo); CV(5, cb[q].z, u0.z, u1.z, u2.z, bf_hi); CV(6, cb[q].w, u0.w, u1.w, u2.w, bf_lo); CV(7, cb[q].w, u0.w, u1.w, u2.w, bf_hi);
#undef CV
                    v4u w; w.x = cvt_pk_bf16(o[0], o[1]); w.y = cvt_pk_bf16(o[2], o[3]); w.z = cvt_pk_bf16(o[4], o[5]); w.w = cvt_pk_bf16(o[6], o[7]);
                    *(GAS v4u*)(CBW + off0 + (size_t)(r + q) * 1024) = w;
                    u2 = u1; u1 = u0;
                }
            }
        }
        __syncthreads();
        {
            LAS unsigned char* kmH = F.lds; LAS unsigned char* kmL = F.lds + 8192;
            LAS int* lc = (LAS int*)(F.lds + 16384); LAS int* gb = lc + 64;
            const int r32 = F.lane & 31, hi = F.lane >> 5;
            for (int task = F.vcu; task < 32 * 32; task += F.G) {
                const int bh = task >> 5, chunk = task & 31, b = bh >> 4, h = bh & 15;
                { const int j = F.tid >> 3, c = F.tid & 7;
                  const f32x4 k0 = *(const f32x4*)(ksum + (size_t)(b * 64 + j) * 1024 + h * 64 + c * 8), k1 = *(const f32x4*)(ksum + (size_t)(b * 64 + j) * 1024 + h * 64 + c * 8 + 4);
                  v4u vh; vh.x = cvt_pk_bf16(k0.x, k0.y); vh.y = cvt_pk_bf16(k0.z, k0.w); vh.z = cvt_pk_bf16(k1.x, k1.y); vh.w = cvt_pk_bf16(k1.z, k1.w);
                  v4u vl; vl.x = cvt_pk_bf16(k0.x - bf_lo(vh.x), k0.y - bf_hi(vh.x)); vl.y = cvt_pk_bf16(k0.z - bf_lo(vh.y), k0.w - bf_hi(vh.y));
                  vl.z = cvt_pk_bf16(k1.x - bf_lo(vh.z), k1.y - bf_hi(vh.z)); vl.w = cvt_pk_bf16(k1.z - bf_lo(vh.w), k1.w - bf_hi(vh.w));
                  *(LAS v4u*)(kmH + c * 1024 + j * 16) = vh; *(LAS v4u*)(kmL + c * 1024 + j * 16) = vl; }
                if (F.tid < 64) lc[F.tid] = 0;
                __syncthreads();
                const int own = chunk * 2 + (F.wave >> 2), nv = own < 3 ? own : 3;
                int sel[2][3] = {{0, 0, 0}, {0, 0, 0}}, rk[2][3] = {{0, 0, 0}, {0, 0, 0}};
                if (own > 0) {
#pragma unroll
                    for (int ps = 0; ps < 2; ++ps) {
                        const int t = chunk * 512 + F.wave * 64 + ps * 32 + r32;
                        bf16x8_t qr[4];
#pragma unroll
                        for (int d0 = 0; d0 < 4; ++d0) qr[d0] = *(const bf16x8_t*)(Qb + ((size_t)(b * 16 + h) * SEQ + t) * 64 + d0 * 16 + hi * 8);
                        float v0 = -INFINITY, v1 = -INFINITY, v2 = -INFINITY; int i0 = 0, i1 = 0, i2 = 0;
#pragma unroll
                        for (int tl = 0; tl < 2; ++tl) {
                            if (tl * 32 < own) {
                                f32x16 g = {0.f, 0.f, 0.f, 0.f, 0.f, 0.f, 0.f, 0.f, 0.f, 0.f, 0.f, 0.f, 0.f, 0.f, 0.f, 0.f};
#pragma unroll
                                for (int d0 = 0; d0 < 4; ++d0) { const bf16x8_t ah = *(const LAS bf16x8_t*)(kmH + (2 * d0 + hi) * 1024 + (tl * 32 + r32) * 16), al = *(const LAS bf16x8_t*)(kmL + (2 * d0 + hi) * 1024 + (tl * 32 + r32) * 16);
                                    g = __builtin_amdgcn_mfma_f32_32x32x16_bf16(ah, qr[d0], g, 0, 0, 0); g = __builtin_amdgcn_mfma_f32_32x32x16_bf16(al, qr[d0], g, 0, 0, 0); }
#pragma unroll
                                for (int r = 0; r < 16; ++r) { const int j = tl * 32 + crow(r, hi); const float gv = (j < own) ? g[r] : -INFINITY;
                                    if (gv > v0) { v2 = v1; i2 = i1; v1 = v0; i1 = i0; v0 = gv; i0 = j; }
                                    else if (gv > v1) { v2 = v1; i2 = i1; v1 = gv; i1 = j; }
                                    else if (gv > v2) { v2 = gv; i2 = j; } }
                            }
                        }
                        float pv[3] = {__shfl_xor(v0, 32), __shfl_xor(v1, 32), __shfl_xor(v2, 32)}; int pi[3] = {__shfl_xor(i0, 32), __shfl_xor(i1, 32), __shfl_xor(i2, 32)};
#pragma unroll
                        for (int e = 0; e < 3; ++e) { const float gv = pv[e]; const int j = pi[e];
                            if (gv > v0 || (gv == v0 && j < i0)) { v2 = v1; i2 = i1; v1 = v0; i1 = i0; v0 = gv; i0 = j; }
                            else if (gv > v1 || (gv == v1 && j < i1)) { v2 = v1; i2 = i1; v1 = gv; i1 = j; }
                            else if (gv > v2 || (gv == v2 && j < i2)) { v2 = gv; i2 = j; } }
                        sel[ps][0] = i0; sel[ps][1] = i1; sel[ps][2] = i2;
                        if (hi == 0) {
                            rk[ps][0] = __hip_atomic_fetch_add(&lc[i0], 1, __ATOMIC_RELAXED, __HIP_MEMORY_SCOPE_WORKGROUP);
                            if (nv > 1) rk[ps][1] = __hip_atomic_fetch_add(&lc[i1], 1, __ATOMIC_RELAXED, __HIP_MEMORY_SCOPE_WORKGROUP);
                            if (nv > 2) rk[ps][2] = __hip_atomic_fetch_add(&lc[i2], 1, __ATOMIC_RELAXED, __HIP_MEMORY_SCOPE_WORKGROUP);
                        }
                    }
                }
                __syncthreads();
                if (F.tid < 64) { const int c = lc[F.tid]; gb[F.tid] = c ? (int)__hip_atomic_fetch_add((unsigned*)(acnt + bh * 64 + F.tid), (unsigned)c, RLX_AGENT) : 0; }
                __syncthreads();
                if (own > 0 && hi == 0) {
                    unsigned short* lb = alist + (size_t)bh * ALIST_BH;
#pragma unroll
                    for (int ps = 0; ps < 2; ++ps) { const int t = chunk * 512 + F.wave * 64 + ps * 32 + r32;
                        lb[alist_off(sel[ps][0]) + gb[sel[ps][0]] + rk[ps][0]] = (unsigned short)((t << 2) | 0);
                        if (nv > 1) lb[alist_off(sel[ps][1]) + gb[sel[ps][1]] + rk[ps][1]] = (unsigned short)((t << 2) | 1);
                        if (nv > 2) lb[alist_off(sel[ps][2]) + gb[sel[ps][2]] + rk[ps][2]] = (unsigned short)((t << 2) | 2); }
                }
                __syncthreads();
            }
        }
    }
    SEAM(2);
    if (IN(3)) {
        DECL_PTRS();
        attn_phase<false>(F, Qb, Kb, Vb, PO, PML, alist, acnt, ATTO, w_gu, w_d, (unsigned char*)Wgu_t, (unsigned char*)Wd_t);
    }
    SEAM(3);
    if (IN(4)) {
        DECL_PTRS();
        attn_phase<true>(F, Qb, Kb, Vb, PO, PML, alist, acnt, ATTO, w_gu, w_d, (unsigned char*)Wgu_t, (unsigned char*)Wd_t);
    }
    SEAM(4);
    if (IN(5)) {
        DECL_PTRS();
        { DensePol P{CB, Wco_t, M / 256, 4, F.G, (int)blockIdx.x, 2, 4, 0, 0}; EpiGate<0> E{GC, nullptr, T1, 1.0f}; pg8::gemm_phase<EpiGate<0>, DensePol, true>(F.lds, P, E); }
        VM_WAIT(); __syncthreads();
        { DensePol P{ATTO, Wao8, M / 256, 4, F.G, (int)blockIdx.x, 1, 4, 0, 0}; EpiGate<1> E{GA, T1, MERGED, 1.0f / 512.0f}; pg8::gemm_phase<EpiGate<1>, DensePol, true, true>(F.lds, P, E); }
    }
    SEAM(5);
    if (IN(6)) {
        DECL_PTRS();
        DensePol P{MERGED, Wout_t, M / 256, 4, F.G, (int)blockIdx.x, 2, 4, 0, 0}; EpiResid E{XN, xrms, HB};
        pg8::gemm_phase<EpiResid, DensePol, true>(F.lds, P, E);
    }
    SEAM(6);
    if (IN(7)) {
        DECL_PTRS();
        LAS int* lcnt = (LAS int*)(F.lds + 98304); LAS int* gbase = lcnt + 32; LAS float* rbl = (LAS float*)(lcnt + 64);
        if (F.tid < 32) { lcnt[F.tid] = 0; rbl[F.tid] = router_b[F.tid]; }
        __syncthreads();
        const int rows_per_wg = M / F.G;
        int myrank[4] = {0, 0, 0, 0}, mye[4] = {0, 0, 0, 0}; float myw[4] = {0.f, 0.f, 0.f, 0.f}; int mytok = -1; float myrstd = 0.f;
        {
            const int r32 = F.lane & 31, hh = F.lane >> 5, rt = F.wave & 3, kh = F.wave >> 2, row = F.vcu * rows_per_wg + rt * 32 + r32;
            const bf16* hrow = HB + (size_t)row * 1024 + kh * 512 + 8 * hh;
            unsigned char* hn16 = (unsigned char*)HN + (size_t)row * 1024 + kh * 512 + 16 * hh;
            unsigned hw0 = 0u, hw1 = 0u;
            const float* gfr = g_ffn + kh * 512 + 8 * hh;
            const unsigned short* rwgH = (const unsigned short*)rwg + ((size_t)(kh * 32) * 64 + F.lane) * 8; const unsigned short* rwgL = rwgH + 64 * 64 * 8;
            f32x16 acc = {0.f, 0.f, 0.f, 0.f, 0.f, 0.f, 0.f, 0.f, 0.f, 0.f, 0.f, 0.f, 0.f, 0.f, 0.f, 0.f}; float ss = 0.f;
#pragma unroll 4
            for (int st = 0; st < 32; ++st) {
                const v4u ah = *(const v4u*)(hrow + 16 * st);
                const f32x4 a0 = (f32x4){bf_lo(ah.x), bf_hi(ah.x), bf_lo(ah.y), bf_hi(ah.y)}, a1 = (f32x4){bf_lo(ah.z), bf_hi(ah.z), bf_lo(ah.w), bf_hi(ah.w)};
                const v4u bh = *(const v4u*)(rwgH + (size_t)st * 512), bl = *(const v4u*)(rwgL + (size_t)st * 512);
                ss += (a0.x * a0.x + a0.y * a0.y) + (a0.z * a0.z + a0.w * a0.w) + (a1.x * a1.x + a1.y * a1.y) + (a1.z * a1.z + a1.w * a1.w);
                { const f32x4 g0 = *(const f32x4*)(gfr + 16 * st), g1 = *(const f32x4*)(gfr + 16 * st + 4); int w0 = 0, w1 = 0;
                  w0 = __builtin_amdgcn_cvt_pk_fp8_f32(a0.x * g0.x, a0.y * g0.y, w0, false); w0 = __builtin_amdgcn_cvt_pk_fp8_f32(a0.z * g0.z, a0.w * g0.w, w0, true);
                  w1 = __builtin_amdgcn_cvt_pk_fp8_f32(a1.x * g1.x, a1.y * g1.y, w1, false); w1 = __builtin_amdgcn_cvt_pk_fp8_f32(a1.z * g1.z, a1.w * g1.w, w1, true);
                  if ((st & 1) == 0) { hw0 = (unsigned)w0; hw1 = (unsigned)w1; }
                  else { const auto rx = __builtin_amdgcn_permlane32_swap(hw0, (unsigned)w0, false, false), ry = __builtin_amdgcn_permlane32_swap(hw1, (unsigned)w1, false, false);
                      v4u w; w.x = rx[0]; w.y = ry[0]; w.z = rx[1]; w.w = ry[1]; *(GAS v4u*)(hn16 + 16 * (st - 1)) = w; } }
                const bf16x8_t fah = __builtin_bit_cast(bf16x8_t, ah), fbh = __builtin_bit_cast(bf16x8_t, bh), fbl = __builtin_bit_cast(bf16x8_t, bl);
                acc = __builtin_amdgcn_mfma_f32_32x32x16_bf16(fah, fbh, acc, 0, 0, 0);
                acc = __builtin_amdgcn_mfma_f32_32x32x16_bf16(fah, fbl, acc, 0, 0, 0);
            }
            LAS float* xch = (LAS float*)(F.lds + 32768 + rt * 8192);
            if (kh == 1) {
#pragma unroll
                for (int r = 0; r < 16; ++r) xch[r * 64 + F.lane] = acc[r];
                xch[16 * 64 + F.lane] = ss; }
            LDS_WAIT(); __syncthreads();
            if (kh == 0) {
#pragma unroll
                for (int r = 0; r < 16; ++r) acc[r] += xch[r * 64 + F.lane];
                ss += xch[16 * 64 + F.lane];
                ss += __shfl_xor(ss, 32);
                const float rstd = 1.0f / sqrtf(ss * (1.f / D) + EPS);
                LAS float* scr = (LAS float*)(F.lds + rt * 8192);
#pragma unroll
                for (int r = 0; r < 16; ++r) scr[crow(r, hh) * 33 + r32] = acc[r];
                LDS_WAIT(); asm volatile("" ::: "memory");
                if (hh == 0) {
                    float v0 = -INFINITY, v1 = -INFINITY, v2 = -INFINITY, v3 = -INFINITY; int i0 = 0, i1 = 0, i2 = 0, i3 = 0;
#pragma unroll 4
                    for (int e = 0; e < 32; ++e) { const float g = scr[r32 * 33 + e] * rstd + rbl[e];
                        if (g > v0) { v3 = v2; i3 = i2; v2 = v1; i2 = i1; v1 = v0; i1 = i0; v0 = g; i0 = e; }
                        else if (g > v1) { v3 = v2; i3 = i2; v2 = v1; i2 = i1; v1 = g; i1 = e; }
                        else if (g > v2) { v3 = v2; i3 = i2; v2 = g; i2 = e; }
                        else if (g > v3) { v3 = g; i3 = e; } }
                    const float e1 = __expf(v1 - v0), e2 = __expf(v2 - v0), e3 = __expf(v3 - v0), inv = 1.0f / (1.0f + e1 + e2 + e3);
                    mye[0] = i0; mye[1] = i1; mye[2] = i2; mye[3] = i3; myw[0] = inv; myw[1] = e1 * inv; myw[2] = e2 * inv; myw[3] = e3 * inv; mytok = row; myrstd = rstd;
#pragma unroll
                    for (int k = 0; k < 4; ++k) myrank[k] = __hip_atomic_fetch_add(&lcnt[mye[k]], 1, __ATOMIC_RELAXED, __HIP_MEMORY_SCOPE_WORKGROUP);
                }
            }
        }
        __syncthreads();
        if (F.tid < 32) gbase[F.tid] = (int)__hip_atomic_fetch_add((unsigned*)(F.ctl + CW_ECNT + 64 * F.tid), (unsigned)lcnt[F.tid], RLX_AGENT);
        __syncthreads();
        if (mytok >= 0) {
#pragma unroll
            for (int k = 0; k < 4; ++k) { const int e = mye[k], pos = gbase[e] + myrank[k]; etok[e * 32768 + pos] = mytok; ewt[e * 32768 + pos] = myw[k]; erstd[e * 32768 + pos] = myrstd; tokslot[mytok * 4 + k] = e * 32768 + pos; }
        }
    }
    SEAM(7);
    if (IN(8) || IN(9) || IN(10)) {
        __syncthreads();
        if (F.tid < 64) {
            const int e = F.tid & 31; const int c = (int)__hip_atomic_load(F.ctl + CW_ECNT + 64 * e, RLX_AGENT); const int t = (c + 255) >> 8;
            int inc = t;
#pragma unroll
            for (int o = 1; o < 32; o <<= 1) { const int v = __shfl_up(inc, o, 32); if (e >= o) inc += v; }
            if (F.tid < 32) { tab[e] = c; tab[32 + e] = inc - t; if (e == 31) { tab[64] = inc; tab[65] = inc; } }
        }
        __syncthreads();
    }
    if (IN(8)) {
        DECL_PTRS();
        LAS int* ul = (LAS int*)(F.lds + UMETA_OFF); __syncthreads(); const int nul = moe_unit_list(ul, tab, 8, F.G, (int)blockIdx.x, F.tid); __syncthreads();
        MoePol1 P{HN, Wgu_t, etok, tab, ul, nul}; EpiSwiglu E{b_gu, erstd, (unsigned char*)ACT};
        pg8::gemm_phase<EpiSwiglu, MoePol1, true, true>(F.lds, P, E);
    }
    SEAM(8);
    if (IN(9)) {
        DECL_PTRS();
        LAS int* ul = (LAS int*)(F.lds + UMETA_OFF); __syncthreads(); const int nul = moe_unit_list(ul, tab, 4, F.G, (int)blockIdx.x, F.tid); __syncthreads();
        MoePol2 P{ACT, Wd_t, ul, nul}; EpiDown E{b_d, ewt, (unsigned char*)Y};
        pg8::gemm_phase<EpiDown, MoePol2, true, true>(F.lds, P, E);
    }
    SEAM(9);
    if (IN(10)) {
        DECL_PTRS();
        const unsigned tmo = __hip_atomic_load(F.ctl + CW_BAR + XB_TMO, RLX_AGENT);
        f32x4 gfv[4];
#pragma unroll
        for (int j = 0; j < 4; ++j) gfv[j] = ((const GAS f32x4*)g_fin + F.lane)[64 * j];
        for (int m = gw; m < M; m += NGW) {
            GAS f32x4* hr = (GAS f32x4*)(out + (size_t)m * D) + F.lane; const GAS v2u* hb = (const GAS v2u*)(HB + (size_t)m * D) + F.lane; f32x4 v[4];
#pragma unroll
            for (int j = 0; j < 4; ++j) { const v2u hw = hb[64 * j]; v[j] = (f32x4){bf_lo(hw.x), bf_hi(hw.x), bf_lo(hw.y), bf_hi(hw.y)}; }
#pragma unroll
            for (int k = 0; k < 4; ++k) { const int ts = tokslot[m * 4 + k], e = ts >> 15, pos = ts & 32767; const size_t srow = (size_t)tab[32 + e] * 256 + pos;
                const GAS unsigned* yr = (const GAS unsigned*)((const unsigned char*)Y + srow * 1024) + F.lane;
#pragma unroll
                for (int j = 0; j < 4; ++j) { const unsigned w = yr[64 * j]; const pg8::f32x2 lo2 = __builtin_amdgcn_cvt_pk_f32_fp8((int)w, false), hi2 = __builtin_amdgcn_cvt_pk_f32_fp8((int)w, true);
                    v[j].x += lo2[0] * (1.0f / 16.0f); v[j].y += lo2[1] * (1.0f / 16.0f); v[j].z += hi2[0] * (1.0f / 16.0f); v[j].w += hi2[1] * (1.0f / 16.0f); } }
            float s = 0.f;
#pragma unroll
            for (int j = 0; j < 4; ++j) s += (v[j].x * v[j].x + v[j].y * v[j].y) + (v[j].z * v[j].z + v[j].w * v[j].w);
            float rstd = 1.0f / sqrtf(wave_sum(s) * (1.f / D) + EPS);
            if (tmo) rstd = __builtin_nanf("");
#pragma unroll
            for (int j = 0; j < 4; ++j) hr[64 * j] = v[j] * rstd * gfv[j];
        }
    }
#undef IN
#undef SEAM
}

extern "C" void kernel_launch(void* const* d_in, const int* in_sizes, int n_in, void* d_out, int out_size, void* d_ws, size_t ws_size, hipStream_t stream) {
    static int grid = 0;
    if (grid == 0) {
        if (n_in != 15 || out_size != M * D || ws_size < WS_END) { fprintf(stderr, "kernel_launch: unexpected shapes (n_in %d out %d ws %zu); nothing launched\n", n_in, out_size, ws_size); grid = -1; return; }
        int dev = 0, cus = 0, per_cu = 0;
        if (hipGetDevice(&dev) != hipSuccess || hipDeviceGetAttribute(&cus, hipDeviceAttributeMultiprocessorCount, dev) != hipSuccess) { grid = -1; return; }
        if (hipFuncSetAttribute((const void*)fwd_kernel, hipFuncAttributeMaxDynamicSharedMemorySize, LDS_BYTES) != hipSuccess) { fprintf(stderr, "kernel_launch: hipFuncSetAttribute failed\n"); grid = -1; return; }
        if (hipOccupancyMaxActiveBlocksPerMultiprocessor(&per_cu, (const void*)fwd_kernel, 512, LDS_BYTES) != hipSuccess || per_cu < 1) { fprintf(stderr, "kernel_launch: occupancy query reports %d blocks per CU; nothing launched\n", per_cu); (void)hipGetLastError(); grid = -1; return; }
        (void)hipGetLastError();
        grid = cus;
    }
    if (grid < 0) return;
    (void)hipMemsetAsync((char*)d_ws + WS_CTL, 0, CTL_ZERO_BYTES, stream);
    Args a{};
    for (int i = 0; i < 15; ++i) a.in[i] = (const float*)d_in[i];
    a.out = (float*)d_out; a.ws = (unsigned char*)d_ws;
    a.ph_lo = 0; a.ph_hi = NPHASE;
    hipLaunchKernelGGL(fwd_kernel, dim3(grid), dim3(512), LDS_BYTES, stream, a);
}
```
